# Optimizing an MI355X kernel written in HIP

```python
import jax, jax.numpy as jnp
from jax import lax
import numpy as np

D_MODEL = 2048
BATCH = 4
SEQ = 2048
DEPTH = 2

GRID_W = 64
CTX_LEN = 256
EPS = 1e-6
D_FF = (11 * D_MODEL) // 4
N_MOD = 9
BRANCH_W = D_MODEL // 2
N_BRANCH = 3
M_HEADS = 4
M_HEAD_DIM = BRANCH_W // M_HEADS
M_CHUNK = 64
ROPE_BASE = 10000.0
NA_HEADS = 8
NA_HEAD_DIM = BRANCH_W // NA_HEADS
NA_KH = 8
NA_KW = 16
LRU_BLOCKS = 8
LRU_BLOCK_DIM = BRANCH_W // LRU_BLOCKS
LRU_CONV = 4
LRU_C = 8.0
IN_SPLITS = (BRANCH_W, BRANCH_W, BRANCH_W, BRANCH_W, 4 * M_HEADS, BRANCH_W, BRANCH_W, BRANCH_W, BRANCH_W, BRANCH_W, N_BRANCH * D_MODEL)
P_IN = sum(IN_SPLITS)

kernel_name = "hybrid_mlstm_natten_rglru_dit_block"


def rmsnorm(x, g):
    xf = x.astype(jnp.float32)
    y = xf * lax.rsqrt(jnp.mean(xf * xf, axis=-1, keepdims=True) + EPS)
    return (y * g.astype(jnp.float32)).astype(x.dtype)


def adaln(x, g, shift, scale):
    return rmsnorm(x, g) * (1 + scale) + shift


def swiglu(h, w_in, w_out):
    gte, up = jnp.split(h @ w_in, 2, axis=-1)
    return (jax.nn.silu(gte) * up) @ w_out


def split_cols(p):
    idx, acc = [], 0
    for s in IN_SPLITS[:-1]:
        acc += s
        idx.append(acc)
    return jnp.split(p, idx, axis=-1)


def rope_2d(t, prow, pcol):
    half = t.shape[-1] // 2

    def rot(u, pos):
        nf = u.shape[-1] // 2
        inv = ROPE_BASE ** (-jnp.arange(nf, dtype=jnp.float32) / nf)
        ang = pos.astype(jnp.float32)[:, None] * inv[None, :]
        cos = jnp.cos(ang)[None, :, None, :]
        sin = jnp.sin(ang)[None, :, None, :]
        u1, u2 = u[..., :nf], u[..., nf:]
        return jnp.concatenate([u1 * cos - u2 * sin, u1 * sin + u2 * cos], axis=-1)

    return jnp.concatenate([rot(t[..., :half], prow), rot(t[..., half:], pcol)], axis=-1)


def _to_chunks(t):
    b, l, h = t.shape[:3]
    t = t.reshape((b, l // M_CHUNK, M_CHUNK, h) + t.shape[3:])
    return jnp.swapaxes(jnp.moveaxis(t, 1, 0), 2, 3)


def mlstm_scan(q, k, v, i_pre, f_pre, state, need_out):
    b, l, h, dh = q.shape
    tril = jnp.tril(jnp.ones((M_CHUNK, M_CHUNK), dtype=bool))

    def step(carry, inp):
        c_mem, n_mem, m_prev = carry
        qc, kc, vc, ic, lf = inp
        cum = jnp.cumsum(lf, axis=-1)
        logw = jnp.where(tril, cum[..., :, None] - cum[..., None, :] + ic[..., None, :], -jnp.inf)
        m_row = jnp.maximum(cum + m_prev[..., None], jnp.max(logw, axis=-1))
        m_new = m_row[..., -1]
        w_state = jnp.exp(cum[..., -1:] - cum + ic - m_new[..., None])
        decay = jnp.exp(cum[..., -1] + m_prev - m_new)
        c_new = decay[..., None, None] * c_mem + jnp.einsum('bhs,bhsv,bhsk->bhvk', w_state, vc, kc)
        n_new = decay[..., None] * n_mem + jnp.einsum('bhs,bhsk->bhk', w_state, kc)
        if not need_out:
            return (c_new, n_new, m_new), None
        inter = jnp.exp(cum + m_prev[..., None] - m_row)
        sc = jnp.einsum('bhtk,bhsk->bhts', qc, kc) * jnp.exp(logw - m_row[..., None])
        num = inter[..., None] * jnp.einsum('bhvk,bhtk->bhtv', c_mem, qc) + jnp.einsum('bhts,bhsv->bhtv', sc, vc)
        den = inter * jnp.einsum('bhk,bhtk->bht', n_mem, qc) + jnp.sum(sc, axis=-1)
        hid = num / jnp.maximum(jnp.abs(den), jnp.exp(-m_row))[..., None]
        return (c_new, n_new, m_new), hid

    xs = (_to_chunks(q), _to_chunks(k), _to_chunks(v), _to_chunks(i_pre), _to_chunks(jax.nn.log_sigmoid(f_pre)))
    state, hs = lax.scan(step, state, xs)
    if need_out:
        hs = jnp.transpose(hs, (1, 0, 3, 2, 4)).reshape(b, l, h, dh)
    return hs, state


def _flip(t):
    return jnp.flip(t, axis=1)


def mlstm_branch(q, k, v, o, g, qc, kc, vc, oc, gc, b_i, b_f, gn, prow, pcol, need_ctx_out):
    f32 = jnp.float32
    b, l = q.shape[:2]
    lc = qc.shape[1]
    heads = lambda t: t.reshape(t.shape[0], t.shape[1], M_HEADS, M_HEAD_DIM).astype(f32)
    kscale = M_HEAD_DIM ** -0.5
    q = rope_2d(heads(q), prow, pcol)
    k = rope_2d(heads(k), prow, pcol) * kscale
    v = heads(v)
    qc, kc, vc = heads(qc), heads(kc) * kscale, heads(vc)
    g = g.astype(f32).reshape(b, l, 2, 2, M_HEADS)
    gc = gc.astype(f32).reshape(b, lc, 2, 2, M_HEADS)
    zero = (jnp.zeros((b, M_HEADS, M_HEAD_DIM, M_HEAD_DIM), f32), jnp.zeros((b, M_HEADS, M_HEAD_DIM), f32),
            jnp.full((b, M_HEADS), -jnp.inf, f32))
    outs, outs_c = [], []
    for d in range(2):
        fl = _flip if d == 1 else (lambda t: t)
        hc_d, st = mlstm_scan(fl(qc), fl(kc), fl(vc), fl(gc[:, :, d, 0] + b_i[d]), fl(gc[:, :, d, 1] + b_f[d]), zero, need_ctx_out)
        hx_d, _ = mlstm_scan(fl(q), fl(k), fl(v), fl(g[:, :, d, 0] + b_i[d]), fl(g[:, :, d, 1] + b_f[d]), st, True)
        outs.append(fl(hx_d))
        if need_ctx_out:
            outs_c.append(fl(hc_d))

    def finish(hsum, og):
        hn = hsum * lax.rsqrt(jnp.mean(hsum * hsum, axis=-1, keepdims=True) + EPS)
        hn = hn.reshape(hn.shape[0], hn.shape[1], BRANCH_W) * gn.astype(f32)
        return (jax.nn.sigmoid(og.astype(f32)) * hn).astype(og.dtype)

    y = finish(outs[0] + outs[1], o)
    yc = finish(outs_c[0] + outs_c[1], oc) if need_ctx_out else None
    return y, yc


def na_branch(q, k, v, qc, kc, vc, rpb, need_ctx_out):
    f32 = jnp.float32
    b, l = q.shape[:2]
    rows = l // GRID_W
    kh = min(NA_KH, rows)
    scale = NA_HEAD_DIM ** -0.5
    grid = lambda t: t.reshape(b, rows, GRID_W, NA_HEADS, NA_HEAD_DIM)
    heads = lambda t: t.reshape(t.shape[0], t.shape[1], NA_HEADS, NA_HEAD_DIM)
    qg, kg, vg = grid(q), grid(k), grid(v)
    qc, kc, vc = heads(qc), heads(kc), heads(vc)
    r = jnp.arange(rows)
    row_idx = jnp.clip(r - kh // 2, 0, rows - kh)[:, None] + jnp.arange(kh)[None, :]
    k_win = kg[:, row_idx]
    v_win = vg[:, row_idx]
    col = jnp.arange(GRID_W)
    col_start = jnp.clip(col - NA_KW // 2, 0, GRID_W - NA_KW)
    col_ok = (col[None, :] >= col_start[:, None]) & (col[None, :] < col_start[:, None] + NA_KW)
    dr = row_idx - r[:, None] + (NA_KH - 1)
    dc = jnp.clip(col[None, :] - col[:, None], -(NA_KW - 1), NA_KW - 1) + (NA_KW - 1)
    bias = rpb[:, dr[:, None, :, None], dc[None, :, None, :]].astype(f32)
    bias = jnp.where(col_ok[None, None, :, None, :], bias, -jnp.inf)
    s_win = jnp.einsum('brqhd,brjkhd->bhrqjk', qg, k_win).astype(f32) * scale + bias
    s_ctx = jnp.einsum('brqhd,bchd->bhrqc', qg, kc).astype(f32) * scale
    nwin = kh * GRID_W
    s = jnp.concatenate([s_win.reshape(b, NA_HEADS, rows, GRID_W, nwin), s_ctx], axis=-1)
    p = jax.nn.softmax(s, axis=-1).astype(v.dtype)
    p_win = p[..., :nwin].reshape(b, NA_HEADS, rows, GRID_W, kh, GRID_W)
    out = jnp.einsum('bhrqjk,brjkhd->brqhd', p_win, v_win) + jnp.einsum('bhrqc,bchd->brqhd', p[..., nwin:], vc)
    out = out.reshape(b, l, BRANCH_W)
    if not need_ctx_out:
        return out, None
    sc = jnp.einsum('bqhd,bkhd->bhqk', qc, kc).astype(f32) * scale
    pc = jax.nn.softmax(sc, axis=-1).astype(vc.dtype)
    outc = jnp.einsum('bhqk,bkhd->bqhd', pc, vc).reshape(b, qc.shape[1], BRANCH_W)
    return out, outc


def dwconv(x, w, bias):
    l = x.shape[1]
    xp = jnp.pad(x, ((0, 0), ((LRU_CONV - 1) // 2, LRU_CONV // 2), (0, 0)))
    y = xp[:, 0:l] * w[0]
    for j in range(1, LRU_CONV):
        y = y + xp[:, j:j + l] * w[j]
    return y + bias


def rglru_coeffs(xb, w_a, b_a, w_x, b_x, lam):
    f32 = jnp.float32
    b, l = xb.shape[:2]
    xf = xb.astype(f32)
    xg = xf.reshape(b, l, LRU_BLOCKS, LRU_BLOCK_DIM)
    r = jax.nn.sigmoid(jnp.einsum('blgi,ngij->blngj', xg, w_a.astype(f32)).reshape(b, l, 2, BRANCH_W) + b_a.astype(f32))
    i = jax.nn.sigmoid(jnp.einsum('blgi,ngij->blngj', xg, w_x.astype(f32)).reshape(b, l, 2, BRANCH_W) + b_x.astype(f32))
    log_a = -LRU_C * r * jax.nn.softplus(-lam.astype(f32))
    a = jnp.exp(log_a)
    u = jnp.sqrt(-jnp.expm1(2.0 * log_a)) * i * xf[:, :, None, :]
    return a, u


def linear_scan(a, u, h0):
    acum, ucum = lax.associative_scan(lambda e1, e2: (e1[0] * e2[0], e2[0] * e1[1] + e2[1]), (a, u), axis=1)
    return ucum + acum * h0[:, None, :]


def lru_branch(xb, gate, xbc, gatec, conv_w, conv_b, w_a, b_a, w_x, b_x, lam, need_ctx_out):
    f32 = jnp.float32
    b = xb.shape[0]
    a, u = rglru_coeffs(dwconv(xb, conv_w, conv_b), w_a, b_a, w_x, b_x, lam)
    ac, uc = rglru_coeffs(dwconv(xbc, conv_w, conv_b), w_a, b_a, w_x, b_x, lam)
    zero = jnp.zeros((b, BRANCH_W), f32)
    hc_f = linear_scan(ac[:, :, 0], uc[:, :, 0], zero)
    hc_b = _flip(linear_scan(_flip(ac[:, :, 1]), _flip(uc[:, :, 1]), zero))
    h_f = linear_scan(a[:, :, 0], u[:, :, 0], hc_f[:, -1])
    h_b = _flip(linear_scan(_flip(a[:, :, 1]), _flip(u[:, :, 1]), hc_b[:, 0]))
    y = ((h_f + h_b) * jax.nn.gelu(gate.astype(f32))).astype(gate.dtype)
    yc = ((hc_f + hc_b) * jax.nn.gelu(gatec.astype(f32))).astype(gatec.dtype) if need_ctx_out else None
    return y, yc


def merge_branches(ys, gcols, w_branch, w_out):
    b, l = gcols.shape[:2]
    stacked = jnp.stack(ys, axis=2)
    proj = jnp.einsum('blnw,nwd->blnd', stacked, w_branch)
    gates = jax.nn.sigmoid(gcols.reshape(b, l, N_BRANCH, D_MODEL))
    return jnp.sum(gates * proj, axis=2) @ w_out


def mixer(hx, hc, w_in, b_i, b_f, gn, rpb, conv_w, conv_b, w_a, b_a, w_x, b_x, lam, w_branch, w_out, prow, pcol, need_ctx_out):
    mq, mk, mv, mo, mg, nq, nk, nv, lx, lg, gx = split_cols(hx @ w_in)
    mqc, mkc, mvc, moc, mgc, nqc, nkc, nvc, lxc, lgc, gxc = split_cols(hc @ w_in)
    y_m, yc_m = mlstm_branch(mq, mk, mv, mo, mg, mqc, mkc, mvc, moc, mgc, b_i, b_f, gn, prow, pcol, need_ctx_out)
    y_n, yc_n = na_branch(nq, nk, nv, nqc, nkc, nvc, rpb, need_ctx_out)
    y_l, yc_l = lru_branch(lx, lg, lxc, lgc, conv_w, conv_b, w_a, b_a, w_x, b_x, lam, need_ctx_out)
    y = merge_branches([y_m, y_n, y_l], gx, w_branch, w_out)
    yc = merge_branches([yc_m, yc_n, yc_l], gxc, w_branch, w_out) if need_ctx_out else None
    return y, yc


def setup_inputs(seed: int = 0) -> dict:
    key = jax.random.key(seed)
    ks = jax.random.split(key, 28)
    f32 = jnp.float32

    def nrm(k, shape, s):
        return jax.random.normal(k, shape, f32) * s

    def gain(k, shape):
        return 1.0 + nrm(k, shape, 0.1)

    a0 = jax.random.uniform(ks[26], (DEPTH, 2, BRANCH_W), f32, 0.9, 0.999)
    return {
        "x": nrm(ks[0], (BATCH, SEQ, D_MODEL), 1.0),
        "c": nrm(ks[1], (BATCH, D_MODEL), 1.0),
        "ctx": nrm(ks[2], (BATCH, CTX_LEN, D_MODEL), 1.0),
        "c_ctx": nrm(ks[3], (D_MODEL,), 1.0),
        "w_mod": nrm(ks[4], (DEPTH, D_MODEL, N_MOD * D_MODEL), 0.5 * D_MODEL ** -0.5),
        "b_mod": nrm(ks[5], (DEPTH, N_MOD * D_MODEL), 0.02),
        "norm_ffn1": gain(ks[6], (DEPTH, D_MODEL)),
        "norm_mix": gain(ks[7], (DEPTH, D_MODEL)),
        "norm_ffn2": gain(ks[8], (DEPTH, D_MODEL)),
        "ffn1_w_in": nrm(ks[9], (DEPTH, D_MODEL, 2 * D_FF), D_MODEL ** -0.5),
        "ffn1_w_out": nrm(ks[10], (DEPTH, D_FF, D_MODEL), D_FF ** -0.5),
        "ffn2_w_in": nrm(ks[11], (DEPTH, D_MODEL, 2 * D_FF), D_MODEL ** -0.5),
        "ffn2_w_out": nrm(ks[12], (DEPTH, D_FF, D_MODEL), D_FF ** -0.5),
        "w_in": nrm(ks[13], (DEPTH, D_MODEL, P_IN), D_MODEL ** -0.5),
        "mlstm_b_i": nrm(ks[14], (DEPTH, 2, M_HEADS), 0.1),
        "mlstm_b_f": jnp.linspace(3.0, 6.0, M_HEADS, dtype=f32) + nrm(ks[15], (DEPTH, 2, M_HEADS), 0.1),
        "mlstm_gn": gain(ks[16], (DEPTH, BRANCH_W)),
        "na_rpb": nrm(ks[17], (DEPTH, NA_HEADS, 2 * NA_KH - 1, 2 * NA_KW - 1), 0.5),
        "lru_conv_w": nrm(ks[18], (DEPTH, LRU_CONV, BRANCH_W), LRU_CONV ** -0.5),
        "lru_conv_b": nrm(ks[19], (DEPTH, BRANCH_W), 0.02),
        "lru_w_a": nrm(ks[20], (DEPTH, 2, LRU_BLOCKS, LRU_BLOCK_DIM, LRU_BLOCK_DIM), LRU_BLOCK_DIM ** -0.5),
        "lru_b_a": nrm(ks[21], (DEPTH, 2, BRANCH_W), 0.02),
        "lru_w_x": nrm(ks[22], (DEPTH, 2, LRU_BLOCKS, LRU_BLOCK_DIM, LRU_BLOCK_DIM), LRU_BLOCK_DIM ** -0.5),
        "lru_b_x": nrm(ks[23], (DEPTH, 2, BRANCH_W), 0.02),
        "lru_lambda": jnp.log(a0) - jnp.log1p(-a0),
        "w_branch": nrm(ks[24], (DEPTH, N_BRANCH, BRANCH_W, D_MODEL), BRANCH_W ** -0.5),
        "w_out": nrm(ks[25], (DEPTH, D_MODEL, D_MODEL), D_MODEL ** -0.5),
        "norm_final": gain(ks[27], (D_MODEL,)),
    }


def reference(x, c, ctx, c_ctx, w_mod, b_mod, norm_ffn1, norm_mix, norm_ffn2, ffn1_w_in, ffn1_w_out, ffn2_w_in, ffn2_w_out,
              w_in, mlstm_b_i, mlstm_b_f, mlstm_gn, na_rpb, lru_conv_w, lru_conv_b, lru_w_a, lru_b_a, lru_w_x, lru_b_x,
              lru_lambda, w_branch, w_out, norm_final):
    l = x.shape[1]
    pos = jnp.arange(l)
    prow, pcol = pos // GRID_W, pos % GRID_W
    c_act = jax.nn.silu(c)
    cc_act = jax.nn.silu(c_ctx)
    xc = ctx
    for li in range(DEPTH):
        last = li == DEPTH - 1
        mod = (c_act @ w_mod[li] + b_mod[li])[:, None, :]
        modc = (cc_act @ w_mod[li] + b_mod[li])[None, None, :]
        sh1, sc1, g1, sh2, sc2, g2, sh3, sc3, g3 = jnp.split(mod, N_MOD, axis=-1)
        csh1, csc1, cg1, csh2, csc2, cg2, csh3, csc3, cg3 = jnp.split(modc, N_MOD, axis=-1)
        x = x + 0.5 * g1 * swiglu(adaln(x, norm_ffn1[li], sh1, sc1), ffn1_w_in[li], ffn1_w_out[li])
        xc = xc + 0.5 * cg1 * swiglu(adaln(xc, norm_ffn1[li], csh1, csc1), ffn1_w_in[li], ffn1_w_out[li])
        y, yc = mixer(adaln(x, norm_mix[li], sh2, sc2), adaln(xc, norm_mix[li], csh2, csc2), w_in[li],
                      mlstm_b_i[li], mlstm_b_f[li], mlstm_gn[li], na_rpb[li], lru_conv_w[li], lru_conv_b[li],
                      lru_w_a[li], lru_b_a[li], lru_w_x[li], lru_b_x[li], lru_lambda[li], w_branch[li], w_out[li],
                      prow, pcol, not last)
        x = x + g2 * y
        x = x + 0.5 * g3 * swiglu(adaln(x, norm_ffn2[li], sh3, sc3), ffn2_w_in[li], ffn2_w_out[li])
        if not last:
            xc = xc + cg2 * yc
            xc = xc + 0.5 * cg3 * swiglu(adaln(xc, norm_ffn2[li], csh3, csc3), ffn2_w_in[li], ffn2_w_out[li])
    return rmsnorm(x, norm_final)
```

```cpp
#include <hip/hip_runtime.h>
#include <cstdio>
#include <cstdint>

#define LAS __attribute__((address_space(3)))
typedef _Float16 f16;
typedef _Float16 f16x8 __attribute__((ext_vector_type(8)));
typedef _Float16 f16x4 __attribute__((ext_vector_type(4)));
typedef _Float16 f16x2 __attribute__((ext_vector_type(2)));
typedef float f32x4 __attribute__((ext_vector_type(4)));
typedef float f32x2 __attribute__((ext_vector_type(2)));
typedef unsigned u32x4 __attribute__((ext_vector_type(4)));
typedef unsigned u32x2 __attribute__((ext_vector_type(2)));

#ifndef PHSEL
#define PHSEL 0xFFFFF
#endif
#ifndef MK_ONE_LAUNCH
#define MK_ONE_LAUNCH 0
#endif

constexpr int D = 2048, NB = 4, SEQ = 2048, CTXL = 256, DEPTH = 2, DFF = 5632, BW = 1024;
constexpr int ML = NB * SEQ, MC = NB * CTXL, MT = ML + MC;
constexpr int NMODC = 9 * D;
constexpr int PIN_SRC = 15376;
constexpr int NPIN = 15616;
constexpr int LDP = 15360;
constexpr int PQ = 0, PK = 1024, PV = 2048, PO = 3072, NQ = 4096, NK = 5120, NV = 6144, LX = 7168, LG = 8192, GX = 9216;
constexpr float EPS = 1e-6f;

constexpr size_t MiB = 1u << 20;
constexpr size_t WS_CTL = 0;
constexpr size_t WS_MOD = 1 * MiB;
constexpr size_t WS_ROPE = 2 * MiB;
constexpr size_t WS_G = 3 * MiB;
constexpr size_t WS_W = 4 * MiB;
constexpr size_t WL_W1 = 0, WL_W2 = 44 * MiB, WL_W3 = 66 * MiB, WL_W4 = 110 * MiB, WL_WIN = 132 * MiB, WL_WBR = 193 * MiB, WL_WOUT = 205 * MiB, WL_SIZE = 213 * MiB;
constexpr size_t WS_X = WS_W + 2 * WL_SIZE;
constexpr size_t WS_H = WS_X + 72 * MiB;
constexpr size_t WS_P = WS_H + 36 * MiB;
constexpr size_t WS_Y = WS_P + 270 * MiB;
constexpr size_t WS_HMD = WS_Y + 54 * MiB;
constexpr size_t WS_LA = WS_HMD + 72 * MiB;
constexpr size_t WS_LU = WS_LA + 72 * MiB;
constexpr size_t WS_HL = WS_LU + 72 * MiB;
constexpr size_t WS_MF = WS_LA;
constexpr size_t WS_MH = WS_LU;
constexpr size_t WS_END = WS_HL + 72 * MiB;

constexpr int LDS_BYTES = 147456;
constexpr int LDS_MISC = 131072 + 4096;

__device__ __forceinline__ unsigned pk_f16(float lo, float hi) { f32x2 v = {lo, hi}; f16x2 h = __builtin_convertvector(v, f16x2); return __builtin_bit_cast(unsigned, h); }
__device__ __forceinline__ float wave_sum(float v) {
#pragma unroll
    for (int o = 1; o < 64; o <<= 1) v += __shfl_xor(v, o);
    return v;
}
__device__ __forceinline__ float wave_max(float v) {
#pragma unroll
    for (int o = 1; o < 64; o <<= 1) v = fmaxf(v, __shfl_xor(v, o));
    return v;
}
__device__ __forceinline__ float sigmoidf_(float x) { return 1.0f / (1.0f + __expf(-x)); }
__device__ __forceinline__ float siluf_(float x) { return x / (1.0f + __expf(-x)); }
__device__ __forceinline__ float gelu_tanh_(float x) { const float z = 0.7978845608028654f * (x + 0.044715f * x * x * x); const float e = __expf(2.0f * z); return 0.5f * x * (1.0f + (1.0f - 2.0f / (e + 1.0f))); }
#define LDS_WAIT() asm volatile("s_waitcnt lgkmcnt(0)" ::: "memory")

#define XB_TMO      128
#define XB_XCNT(j)  (256  + 64 * (j))
#define XB_XSUB(j)  (1280 + 64 * (j))
#define XB_XGEN(j)  (2304 + 64 * (j))
#define XB_TOP      3328
#define XB_TOPGEN   3392
#define XCD_BAR_WORDS 3456
#define XB_SPIN_CAP (1u << 25)
__device__ __forceinline__ unsigned xb_ld(unsigned* p)              { return __hip_atomic_load(p, __ATOMIC_RELAXED, __HIP_MEMORY_SCOPE_AGENT); }
__device__ __forceinline__ unsigned xb_add(unsigned* p, unsigned v) { return __hip_atomic_fetch_add(p, v, __ATOMIC_RELAXED, __HIP_MEMORY_SCOPE_AGENT); }
__device__ __forceinline__ unsigned xb_xcc_id() { return (unsigned)__builtin_amdgcn_s_getreg((3 << 11) | 20) & 0xFu; }
#define XB_SPIN(cond, bar) do { unsigned _sp = 0; while (cond) { __builtin_amdgcn_s_sleep(1); \
    if ((++_sp & 255u) == 0u) { if (xb_ld(&(bar)[XB_TMO])) break; if (_sp > XB_SPIN_CAP) { atomicAdd(&(bar)[XB_TMO], 1u); break; } } } } while (0)
struct XcdBarrier { unsigned* bar; unsigned x; volatile LAS unsigned* st; };
__device__ __forceinline__ XcdBarrier xcd_barrier_post(unsigned* bar, volatile LAS unsigned* st) {
    XcdBarrier b; b.bar = bar; b.x = xb_xcc_id(); b.st = st;
    if (threadIdx.x == 0) (void)xb_add(&bar[XB_XCNT(b.x)], 1u);
    return b;
}
__device__ __forceinline__ void xcd_barrier_complete(unsigned* bar, unsigned x, unsigned& nloc, unsigned& nx) {
    const unsigned G = gridDim.x * gridDim.y * gridDim.z;
    unsigned sum, cnt, mine, sp = 0u;
    for (;;) {
        sum = 0u; cnt = 0u; mine = 0u;
#pragma unroll
        for (unsigned j = 0; j < 16; ++j) { const unsigned c = xb_ld(&bar[XB_XCNT(j)]); sum += c; cnt += (c > 0u) ? 1u : 0u; mine = (j == x) ? c : mine; }
        if (sum == G) break;
        __builtin_amdgcn_s_sleep(1);
        if ((++sp & 255u) == 0u) { if (xb_ld(&bar[XB_TMO])) break; if (sp > XB_SPIN_CAP) { atomicAdd(&bar[XB_TMO], 1u); break; } }
    }
    nloc = mine > 0u ? mine : 1u; nx = cnt > 0u ? cnt : 1u;
}
__device__ __forceinline__ void xcd_barrier(const XcdBarrier& b) {
    asm volatile("s_waitcnt vmcnt(0)" ::: "memory");
    __syncthreads();
    if (threadIdx.x == 0) {
        unsigned* bar = b.bar;
        __builtin_amdgcn_s_waitcnt(0);
        unsigned nloc = b.st[0], nx = b.st[1];
        if (nloc == 0u) { xcd_barrier_complete(bar, b.x, nloc, nx); b.st[0] = nloc; b.st[1] = nx; }
        const unsigned old = xb_add(&bar[XB_XSUB(b.x)], 1u);
        const unsigned gen = old / nloc;
        if (old + 1u == (gen + 1u) * nloc) {
            __builtin_amdgcn_fence(__ATOMIC_RELEASE, "agent");
            asm volatile("s_waitcnt vmcnt(0)" ::: "memory");
            const unsigned og = xb_add(&bar[XB_TOP], 1u);
            const unsigned tg = og / nx;
            if (og + 1u == (tg + 1u) * nx) xb_add(&bar[XB_TOPGEN], 1u);
            else XB_SPIN(xb_ld(&bar[XB_TOPGEN]) == tg, bar);
            __builtin_amdgcn_fence(__ATOMIC_ACQUIRE, "agent");
            xb_add(&bar[XB_XGEN(b.x)], 1u);
            asm volatile("s_waitcnt vmcnt(0)" ::: "memory");
        } else {
            XB_SPIN(xb_ld(&bar[XB_XGEN(b.x)]) == gen, bar);
            __builtin_amdgcn_fence(__ATOMIC_ACQUIRE, "agent");
            asm volatile("s_waitcnt vmcnt(0)" ::: "memory");
        }
    }
    __syncthreads();
}

namespace pg8 {
constexpr int BM = 256, BK = 64, HALF = 128, HTB = HALF * BK * 2, STAGE_BYTES = 8 * HTB, NXCD = 8, WGM = 8;
__host__ __device__ __forceinline__ int lds_byte(int r, int c) { const int st = (r >> 4) * 2 + (c >> 5), rr = r & 15, cc = c & 31, ob = rr * 64 + cc * 2; return st * 1024 + (ob ^ (((ob >> 9) & 1) << 5)); }
__host__ __device__ __forceinline__ void stage_rc(int b, int& R, int& C) { const int st = b / 1024, sb = b % 1024, swz = sb ^ (((sb >> 9) & 1) << 5); R = (st >> 1) * 16 + swz / 64; C = (st & 1) * 32 + (swz % 64) / 2; }
__host__ __device__ __forceinline__ int perm32(int rho) { const int n = rho >> 4, i = rho & 15; return 8 * (i >> 2) + 4 * n + (i & 3); }
struct Unit { int pm, pn; };
struct Gemm { const f16* A; const f16* Bt; int M, N, K; };
struct StaticOrder {
    int nM, nN, nwg, G, c;
    __host__ __device__ void init(int M, int N, int G_, int c_) { nM = M / BM; nN = N / BM; nwg = nM * nN; G = G_; c = c_; }
    __host__ __device__ bool next(int i, Unit& u) const {
        const long L = (long)i * G + c; if (L >= nwg) return false;
        int wgid = (int)L; { const int q = nwg / NXCD, r = nwg % NXCD, xcd = wgid % NXCD, off = wgid / NXCD; wgid = (xcd < r ? xcd * (q + 1) : r * (q + 1) + (xcd - r) * q) + off; }
        const int nig = WGM * nN, gid = wgid / nig, fm = gid * WGM, gsz = (nM - fm) < WGM ? (nM - fm) : WGM;
        u.pm = fm + ((wgid % nig) % gsz); u.pn = (wgid % nig) / gsz; return true;
    }
    __device__ __forceinline__ void a_ready(const Unit&) const {}
    __device__ __forceinline__ void done(const Unit&) const {}
};
template <class Epi, class Sched, bool ALIGN_EPI = false, bool SP2 = false>
__device__ __forceinline__ void gemm_phase(LAS unsigned char* lds, const Gemm g, const Sched& S, const Epi& E, const int tid) {
    const int wid = __builtin_amdgcn_readfirstlane(tid >> 6), lane = tid & 63, wr = wid >> 2, wc = wid & 3, fr = lane & 15, fq = lane >> 4;
    const int K = g.K, nt = K / BK;
    unsigned voffA[2], voffB[2];
#pragma unroll
    for (int i = 0; i < 2; ++i) { int R, C; stage_rc(tid * 16 + i * 8192, R, C); const int Rb = Epi::PERM ? ((R & ~31) + perm32(R & 31)) : R;
        voffA[i] = (unsigned)(R * K + C) * 2u; voffB[i] = (unsigned)(Rb * K + C) * 2u; }
    const size_t kstep = (size_t)(BK * 2);
    const size_t hstep = (size_t)HALF * K * 2;
    const size_t tstep = 2 * hstep;
    const unsigned ldsw = (unsigned)wid * 1024u;
    const int aoff = lds_byte(wr * 64 + fr, fq * 8), boff = lds_byte(wc * 32 + fr, fq * 8);
#define PG8_SA(b, h) (((b) * 2 + (h)) * HTB)
#define PG8_SB(b, h) ((4 + (b) * 2 + (h)) * HTB)
#define PG8_STAGE(bufoff, gbase, voff) do { _Pragma("unroll") for (int _i = 0; _i < 2; ++_i) \
        __builtin_amdgcn_global_load_lds((const unsigned*)((const char*)(gbase) + (voff)[_i]), (LAS unsigned*)(lds + (bufoff) + ldsw + _i * 8192), 16, 0, 0); } while (0)
#define PG8_LDA(dst, b, h) do { _Pragma("unroll") for (int m = 0; m < 4; ++m) _Pragma("unroll") for (int k = 0; k < 2; ++k) dst[m][k] = *(const LAS f16x8*)(lds + PG8_SA(b, h) + aoff + m * 2048 + k * 1024); } while (0)
#define PG8_LDB(dst, b, h) do { _Pragma("unroll") for (int n = 0; n < 2; ++n) _Pragma("unroll") for (int k = 0; k < 2; ++k) dst[n][k] = *(const LAS f16x8*)(lds + PG8_SB(b, h) + boff + n * 2048 + k * 1024); } while (0)
#define PG8_MMA(ai, bj, At, Bt) do { __builtin_amdgcn_s_setprio(1); _Pragma("unroll") for (int m = 0; m < 4; ++m) _Pragma("unroll") for (int n = 0; n < 2; ++n) _Pragma("unroll") for (int k = 0; k < 2; ++k) \
        acc[ai][bj][m][n] = __builtin_amdgcn_mfma_f32_16x16x32_f16(Bt[n][k], At[m][k], acc[ai][bj][m][n], 0, 0, 0); __builtin_amdgcn_s_setprio(0); } while (0)
#define PG8_WAIT_V(n) asm volatile("s_waitcnt vmcnt(" #n ")" ::: "memory")
#define PG8_WAIT_L(n) asm volatile("s_waitcnt lgkmcnt(" #n ")" ::: "memory")
#define PG8_BAR __builtin_amdgcn_s_barrier()
#define PG8_SCHED __builtin_amdgcn_sched_barrier(0)
    Unit cur, nxt; int ui = 0;
    if (!S.next(0, cur)) return;
    f32x4 acc[2][2][4][2];
#pragma unroll
    for (int a = 0; a < 2; ++a)
#pragma unroll
        for (int b = 0; b < 2; ++b)
#pragma unroll
            for (int m = 0; m < 4; ++m)
#pragma unroll
                for (int n = 0; n < 2; ++n) acc[a][b][m][n] = (f32x4){0.f, 0.f, 0.f, 0.f};
    f16x8 At[4][2], B0[2][2], B1[2][2];
    const char* cA = (const char*)g.A + (size_t)cur.pm * tstep; const char* cB = (const char*)g.Bt + (size_t)cur.pn * tstep;
    S.a_ready(cur);
    if constexpr (SP2) {
        PG8_STAGE(PG8_SB(0, 0), cB, voffB); PG8_STAGE(PG8_SB(0, 1), cB + hstep, voffB); PG8_STAGE(PG8_SA(0, 0), cA, voffA); PG8_STAGE(PG8_SA(0, 1), cA + hstep, voffA);
        if (wr == 1) PG8_BAR;
        PG8_WAIT_V(2); PG8_BAR;
        PG8_STAGE(PG8_SB(1, 0), cB + kstep, voffB); PG8_STAGE(PG8_SA(1, 0), cA + kstep, voffA); PG8_STAGE(PG8_SB(1, 1), cB + hstep + kstep, voffB);
        PG8_WAIT_V(6); PG8_BAR;
    } else {
        PG8_STAGE(PG8_SB(0, 0), cB, voffB); PG8_STAGE(PG8_SA(0, 0), cA, voffA); PG8_STAGE(PG8_SB(0, 1), cB + hstep, voffB); PG8_STAGE(PG8_SA(0, 1), cA + hstep, voffA);
        if (wr == 1) PG8_BAR;
        PG8_WAIT_V(4); PG8_BAR;
        PG8_STAGE(PG8_SB(1, 0), cB + kstep, voffB); PG8_STAGE(PG8_SA(1, 0), cA + kstep, voffA); PG8_STAGE(PG8_SB(1, 1), cB + hstep + kstep, voffB);
        PG8_WAIT_V(6); PG8_BAR;
    }
    for (;;) {
        const bool has_next = S.next(ui + 1, nxt);
        const char* nA = has_next ? (const char*)g.A + (size_t)nxt.pm * tstep : cA; const char* nB = has_next ? (const char*)g.Bt + (size_t)nxt.pn * tstep : cB;
        for (int t = 0; t < nt; t += 2) {
            const bool last = (t == nt - 2);
            const char* a1 = cA + (size_t)(t + 1) * kstep;
            const char* a2 = last ? nA : cA + (size_t)(t + 2) * kstep; const char* b2 = last ? nB : cB + (size_t)(t + 2) * kstep;
            const char* a3 = a2 + kstep; const char* b3 = b2 + kstep;
            if (last && has_next) S.a_ready(nxt);
            if constexpr (SP2) {
            PG8_LDB(B0, 0, 0); PG8_LDB(B1, 0, 1); PG8_SCHED; PG8_LDA(At, 0, 0); PG8_STAGE(PG8_SA(1, 1), a1 + hstep, voffA);
            PG8_WAIT_V(8); PG8_WAIT_L(0); PG8_BAR; PG8_MMA(0, 0, At, B0); PG8_MMA(0, 1, At, B1); PG8_BAR; PG8_SCHED;
            PG8_LDA(At, 0, 1); PG8_STAGE(PG8_SB(0, 0), b2, voffB); PG8_STAGE(PG8_SB(0, 1), b2 + hstep, voffB); PG8_STAGE(PG8_SA(0, 0), a2, voffA);
            PG8_WAIT_V(8); PG8_WAIT_L(0); PG8_BAR; PG8_MMA(1, 0, At, B0); PG8_MMA(1, 1, At, B1); PG8_BAR; PG8_SCHED;
            PG8_LDB(B0, 1, 0); PG8_LDB(B1, 1, 1); PG8_SCHED; PG8_LDA(At, 1, 0); PG8_STAGE(PG8_SA(0, 1), a2 + hstep, voffA);
            PG8_WAIT_V(8); PG8_WAIT_L(0); PG8_BAR; PG8_MMA(0, 0, At, B0); PG8_MMA(0, 1, At, B1); PG8_BAR; PG8_SCHED;
            PG8_LDA(At, 1, 1); PG8_STAGE(PG8_SB(1, 0), b3, voffB); PG8_STAGE(PG8_SB(1, 1), b3 + hstep, voffB); PG8_STAGE(PG8_SA(1, 0), a3, voffA);
            PG8_WAIT_V(8); PG8_WAIT_L(0); PG8_BAR; PG8_MMA(1, 0, At, B0); PG8_MMA(1, 1, At, B1); PG8_BAR; PG8_SCHED;
            } else {
            PG8_LDB(B0, 0, 0); PG8_SCHED; PG8_LDA(At, 0, 0); PG8_STAGE(PG8_SA(1, 1), a1 + hstep, voffA);
            PG8_WAIT_L(8); PG8_BAR; PG8_WAIT_L(0); PG8_MMA(0, 0, At, B0); PG8_BAR; PG8_SCHED;
            PG8_LDB(B1, 0, 1); PG8_STAGE(PG8_SB(0, 0), b2, voffB);
            PG8_BAR; PG8_WAIT_L(0); PG8_MMA(0, 1, At, B1); PG8_BAR;
            PG8_LDA(At, 0, 1); PG8_STAGE(PG8_SA(0, 0), a2, voffA);
            PG8_BAR; PG8_WAIT_L(0); PG8_MMA(1, 0, At, B0); PG8_BAR; PG8_SCHED;
            PG8_STAGE(PG8_SB(0, 1), b2 + hstep, voffB);
            PG8_WAIT_V(6); PG8_BAR; PG8_MMA(1, 1, At, B1); PG8_BAR;
            PG8_LDB(B0, 1, 0); PG8_SCHED; PG8_LDA(At, 1, 0); PG8_STAGE(PG8_SA(0, 1), a2 + hstep, voffA);
            PG8_WAIT_L(8); PG8_BAR; PG8_WAIT_L(0); PG8_MMA(0, 0, At, B0); PG8_BAR; PG8_SCHED;
            PG8_LDB(B1, 1, 1); PG8_STAGE(PG8_SB(1, 0), b3, voffB);
            PG8_BAR; PG8_WAIT_L(0); PG8_MMA(0, 1, At, B1); PG8_BAR;
            PG8_LDA(At, 1, 1); PG8_STAGE(PG8_SA(1, 0), a3, voffA);
            PG8_BAR; PG8_WAIT_L(0); PG8_MMA(1, 0, At, B0); PG8_BAR; PG8_SCHED;
            PG8_STAGE(PG8_SB(1, 1), b3 + hstep, voffB);
            PG8_WAIT_V(6); PG8_BAR; PG8_MMA(1, 1, At, B1); PG8_BAR;
            }
        }
        if constexpr (ALIGN_EPI) { if (wr == 0) PG8_BAR; }
        E(acc, cur, wr, wc, fr, fq); S.done(cur);
        if (!has_next) break;
#pragma unroll
        for (int a = 0; a < 2; ++a)
#pragma unroll
            for (int b = 0; b < 2; ++b)
#pragma unroll
                for (int m = 0; m < 4; ++m)
#pragma unroll
                    for (int n = 0; n < 2; ++n) acc[a][b][m][n] = (f32x4){0.f, 0.f, 0.f, 0.f};
        cur = nxt; cA = nA; cB = nB; ++ui;
        if constexpr (ALIGN_EPI) { if (wr == 1) PG8_BAR; }
    }
    PG8_WAIT_V(0);
    if constexpr (!ALIGN_EPI) { if (wr == 0) PG8_BAR; }
    PG8_BAR;
#undef PG8_SA
#undef PG8_SB
#undef PG8_STAGE
#undef PG8_LDA
#undef PG8_LDB
#undef PG8_MMA
#undef PG8_WAIT_V
#undef PG8_WAIT_L
#undef PG8_BAR
#undef PG8_SCHED
}
}
using pg8::Unit;
constexpr int HALF = pg8::HALF, BM = pg8::BM;

struct EpiSwiGLU {
    static constexpr bool PERM = true;
    f16* O;
    __device__ __forceinline__ void operator()(const f32x4 (&acc)[2][2][4][2], const Unit& u, int wr, int wc, int fr, int fq) const {
        asm volatile("" : "+v"(fr), "+v"(fq));
        const int row0 = u.pm * BM + wr * 64 + fr, col0 = u.pn * HALF + wc * 32 + 8 * fq;
#pragma unroll
        for (int ai = 0; ai < 2; ++ai)
#pragma unroll
            for (int m = 0; m < 4; ++m) {
                f16* rowp = O + (size_t)(row0 + ai * HALF + m * 16) * DFF + col0;
                const f32x4 g0 = acc[ai][0][m][0], g1 = acc[ai][0][m][1], u0 = acc[ai][1][m][0], u1 = acc[ai][1][m][1];
                u32x4 w;
                w.x = pk_f16(siluf_(g0[0]) * u0[0], siluf_(g0[1]) * u0[1]); w.y = pk_f16(siluf_(g0[2]) * u0[2], siluf_(g0[3]) * u0[3]);
                w.z = pk_f16(siluf_(g1[0]) * u1[0], siluf_(g1[1]) * u1[1]); w.w = pk_f16(siluf_(g1[2]) * u1[2], siluf_(g1[3]) * u1[3]);
                *(u32x4*)rowp = w;
            }
    }
};
struct EpiResid {
    static constexpr bool PERM = false;
    float* X; const float* modg;
    float coef;
    __device__ __forceinline__ void operator()(const f32x4 (&acc)[2][2][4][2], const Unit& u, int wr, int wc, int fr, int fq) const {
        asm volatile("" : "+v"(fr), "+v"(fq));
        const int row0 = u.pm * BM + wr * 64 + fr, col0 = u.pn * BM + wc * 32 + 4 * fq;
        const int bidx = u.pm < 32 ? (u.pm >> 3) : 4;
        const float* gp = modg + (size_t)bidx * NMODC + col0;
        f32x4 gv[2][2];
#pragma unroll
        for (int bj = 0; bj < 2; ++bj)
#pragma unroll
            for (int n = 0; n < 2; ++n) gv[bj][n] = *(const f32x4*)(gp + bj * HALF + n * 16) * coef;
#pragma unroll
        for (int ai = 0; ai < 2; ++ai)
#pragma unroll
            for (int m = 0; m < 4; ++m) { float* rowp = X + (size_t)(row0 + ai * HALF + m * 16) * D + col0;
#pragma unroll
                for (int bj = 0; bj < 2; ++bj)
#pragma unroll
                    for (int n = 0; n < 2; ++n) { f32x4* p = (f32x4*)(rowp + bj * HALF + n * 16); *p = *p + gv[bj][n] * acc[ai][bj][m][n]; } }
    }
};
struct EpiProj {
    static constexpr bool PERM = true;
    f16* P; float* G; const float* rope;
    __device__ __forceinline__ void operator()(const f32x4 (&acc)[2][2][4][2], const Unit& u, int wr, int wc, int fr, int fq) const {
        asm volatile("" : "+v"(fr), "+v"(fq));
        const int row0 = u.pm * BM + wr * 64 + fr; const int pn = u.pn;
        if (pn == 60) {
            if (wc == 0 && fq < 2) {
#pragma unroll
                for (int ai = 0; ai < 2; ++ai)
#pragma unroll
                    for (int m = 0; m < 4; ++m) { float* gp = G + (size_t)(row0 + ai * HALF + m * 16) * 16 + 8 * fq;
                        *(f32x4*)gp = acc[ai][0][m][0]; *(f32x4*)(gp + 4) = acc[ai][0][m][1]; }
            }
            return;
        }
        const int col0 = pn * BM + wc * 32 + 8 * fq;
        int mode = 0; float scl = 1.0f;
        if (pn < 8) { mode = (u.pm < 32) ? 1 : 2; scl = (pn >= 4) ? 0.0625f : 1.0f; }
        else if (pn >= 12 && pn < 16) mode = 3;
        else if (pn >= 16 && pn < 20) { mode = 2; scl = 0.08838834764831845f; }
        else if (pn >= 32 && pn < 36) mode = 4;
        else if (pn >= 36) mode = 3;
#pragma unroll
        for (int ai = 0; ai < 2; ++ai)
#pragma unroll
            for (int m = 0; m < 4; ++m) {
                const int row = row0 + ai * HALF + m * 16;
                f16* rowp = P + (size_t)row * LDP + col0;
#pragma unroll
                for (int bj = 0; bj < 2; ++bj) {
                    f32x4 v0 = acc[ai][bj][m][0], v1 = acc[ai][bj][m][1];
                    if (mode == 1) {
                        const int t = row & (SEQ - 1); const int pos = bj == 0 ? (t >> 6) : (t & 63);
                        const float* cp = rope + pos * 64 + 16 * wc + 4 * fq;
                        const f32x4 c = *(const f32x4*)cp, s = *(const f32x4*)(cp + 4096);
                        f32x4 o0, o1;
                        o0[0] = v0[0] * c[0] - v0[1] * s[0]; o0[1] = v0[0] * s[0] + v0[1] * c[0];
                        o0[2] = v0[2] * c[1] - v0[3] * s[1]; o0[3] = v0[2] * s[1] + v0[3] * c[1];
                        o1[0] = v1[0] * c[2] - v1[1] * s[2]; o1[1] = v1[0] * s[2] + v1[1] * c[2];
                        o1[2] = v1[2] * c[3] - v1[3] * s[3]; o1[3] = v1[2] * s[3] + v1[3] * c[3];
                        v0 = o0 * scl; v1 = o1 * scl;
                    } else if (mode == 2) { v0 = v0 * scl; v1 = v1 * scl; }
                    else if (mode == 3) {
#pragma unroll
                        for (int e = 0; e < 4; ++e) { v0[e] = sigmoidf_(v0[e]); v1[e] = sigmoidf_(v1[e]); }
                    } else if (mode == 4) {
#pragma unroll
                        for (int e = 0; e < 4; ++e) { v0[e] = gelu_tanh_(v0[e]); v1[e] = gelu_tanh_(v1[e]); }
                    }
                    u32x4 w; w.x = pk_f16(v0[0], v0[1]); w.y = pk_f16(v0[2], v0[3]); w.z = pk_f16(v1[0], v1[1]); w.w = pk_f16(v1[2], v1[3]);
                    *(u32x4*)(rowp + bj * HALF) = w;
                }
            }
    }
};
template <int MODE> struct EpiGate {
    static constexpr bool PERM = true;
    const f16* gate;
    float* MF; f16* MH;
    __device__ __forceinline__ void operator()(const f32x4 (&acc)[2][2][4][2], const Unit& u, int wr, int wc, int fr, int fq) const {
        asm volatile("" : "+v"(fr), "+v"(fq));
        const int row0 = u.pm * BM + wr * 64 + fr, col0 = u.pn * BM + wc * 32 + 8 * fq;
#pragma unroll
        for (int ai = 0; ai < 2; ++ai)
#pragma unroll
            for (int m = 0; m < 4; ++m) {
                const int row = row0 + ai * HALF + m * 16;
#pragma unroll
                for (int bj = 0; bj < 2; ++bj) {
                    const f16x8 gh = *(const f16x8*)(gate + (size_t)row * LDP + col0 + bj * HALF);
                    float* mp = MF + (size_t)row * D + col0 + bj * HALF;
                    f32x4 v0 = acc[ai][bj][m][0], v1 = acc[ai][bj][m][1];
#pragma unroll
                    for (int e = 0; e < 4; ++e) { v0[e] *= (float)gh[e]; v1[e] *= (float)gh[4 + e]; }
                    if (MODE >= 1) { v0 = v0 + *(const f32x4*)mp; v1 = v1 + *(const f32x4*)(mp + 4); }
                    if (MODE <= 1) { *(f32x4*)mp = v0; *(f32x4*)(mp + 4) = v1; }
                    else { u32x4 w; w.x = pk_f16(v0[0], v0[1]); w.y = pk_f16(v0[2], v0[3]); w.z = pk_f16(v1[0], v1[1]); w.w = pk_f16(v1[2], v1[3]);
                        *(u32x4*)(MH + (size_t)row * D + col0 + bj * HALF) = w; }
                }
            }
    }
};

struct Args { const float* in[28]; float* out; unsigned char* ws; int ph_lo, ph_hi; };
struct Frame {
    LAS unsigned char* lds; int tid, lane, wave, G, bid;
    float* out; unsigned char* ws;
};
typedef const Args __attribute__((address_space(4)))* KArgs;
__device__ __forceinline__ KArgs kargs() { return (KArgs)__builtin_amdgcn_kernarg_segment_ptr(); }
__device__ __forceinline__ const float* inp(int k) { return kargs()->in[k]; }
extern __shared__ __attribute__((aligned(16))) unsigned char lds_raw[];
__device__ __forceinline__ Frame make_frame() {
    Frame F; F.lds = (LAS unsigned char*)lds_raw; int t = threadIdx.x; asm volatile("" : "+v"(t));
    F.tid = t; F.lane = F.tid & 63; F.wave = __builtin_amdgcn_readfirstlane(F.tid >> 6);
    int g = gridDim.x, b = blockIdx.x; asm volatile("" : "+s"(g), "+s"(b)); F.G = g; F.bid = b;
    KArgs ka = kargs(); asm volatile("" : "+s"(ka)); F.out = ka->out; F.ws = ka->ws; return F;
}
#define UNI(x) __builtin_amdgcn_readfirstlane(x)
#define WSP(T, off) ((T*)(F.ws + (off)))

__device__ __forceinline__ void transpose_item(const float* W, int ldw, int k0, int srccol, f16* WT, int Kdim, int drow0, LAS float* scr, int lane) {
#pragma unroll 8
    for (int i = 0; i < 32; ++i) { const int kk = 2 * i + (lane >> 5); scr[kk * 33 + (lane & 31)] = srccol >= 0 ? W[(size_t)(k0 + kk) * ldw + srccol] : 0.0f; }
    LDS_WAIT();
    const int c = lane & 7;
#pragma unroll
    for (int j = 0; j < 4; ++j) { const int n = (lane >> 3) + 8 * j; const LAS float* s = scr + (8 * c) * 33 + n;
        u32x4 o; o.x = pk_f16(s[0 * 33], s[1 * 33]); o.y = pk_f16(s[2 * 33], s[3 * 33]); o.z = pk_f16(s[4 * 33], s[5 * 33]); o.w = pk_f16(s[6 * 33], s[7 * 33]);
        *(u32x4*)(WT + (size_t)(drow0 + n) * Kdim + k0 + 8 * c) = o; }
    LDS_WAIT();
}
__device__ __forceinline__ int win_src(int dr) {
    if (dr < 2048) { const int base = dr < 1024 ? 0 : 1024, w = dr & 1023, h = w >> 8, x = w & 255, bj = x >> 7, within = x & 127, i = within >> 1, e = within & 1; return base + h * 256 + bj * 128 + e * 64 + i; }
    if (dr < 4096) return dr;
    if (dr < 15360) return dr + 16;
    const int w = dr - 15360; return w < 16 ? 4096 + w : -1;
}
__device__ __forceinline__ void phase_prologue() {
    Frame F = make_frame();
    const int gw = F.bid * 8 + F.wave, NGW = F.G * 8;
    const int gt = F.bid * 512 + F.tid, NGT = F.G * 512;
    { const f32x4* xs = (const f32x4*)inp(0); const f32x4* cs = (const f32x4*)inp(2); f32x4* X = WSP(f32x4, WS_X);
      const int n1 = ML * D / 4, n2 = MC * D / 4;
      for (int i = gt; i < n1; i += NGT) X[i] = xs[i];
      for (int i = gt; i < n2; i += NGT) X[n1 + i] = cs[i]; }
    { float* rope = WSP(float, WS_ROPE);
      for (int i = gt; i < 4096; i += NGT) { const int pos = i >> 6, j = i & 63; const float inv = powf(10000.0f, -(float)j / 64.0f); const float a = (float)pos * inv; rope[i] = cosf(a); rope[4096 + i] = sinf(a); } }
    { LAS float* sact = (LAS float*)F.lds;
      LAS float* red = (LAS float*)(F.lds + 5 * 2048 * 4);
      for (int i = F.tid; i < 5 * D; i += 512) { const int bi = i / D, k = i % D; const float c = bi < 4 ? inp(1)[bi * D + k] : inp(3)[k]; sact[i] = siluf_(c); }
      __syncthreads();
      for (int it = F.bid; it < DEPTH * 144; it += F.G) {
          const int l = it / 144, n0 = (it % 144) * 128;
          const float* Wm = inp(4) + (size_t)l * D * NMODC + n0 + 2 * F.lane;
          float acc[5][2];
#pragma unroll
          for (int bi = 0; bi < 5; ++bi) { acc[bi][0] = 0.f; acc[bi][1] = 0.f; }
          const int k0 = F.wave * 256;
#pragma unroll 8
          for (int kk = 0; kk < 256; ++kk) { const f32x2 w = *(const f32x2*)(Wm + (size_t)(k0 + kk) * NMODC);
#pragma unroll
              for (int bi = 0; bi < 5; ++bi) { const float a = sact[bi * D + k0 + kk]; acc[bi][0] += a * w.x; acc[bi][1] += a * w.y; } }
#pragma unroll
          for (int bi = 0; bi < 5; ++bi) { red[(F.wave * 5 + bi) * 128 + 2 * F.lane] = acc[bi][0]; red[(F.wave * 5 + bi) * 128 + 2 * F.lane + 1] = acc[bi][1]; }
          __syncthreads();
          for (int i = F.tid; i < 640; i += 512) { const int bi = i / 128, j = i % 128; float s = 0.f;
#pragma unroll
              for (int w = 0; w < 8; ++w) s += red[(w * 5 + bi) * 128 + j];
              WSP(float, WS_MOD)[((size_t)l * 5 + bi) * NMODC + n0 + j] = s + inp(5)[(size_t)l * NMODC + n0 + j]; }
          __syncthreads();
      }
    }
    __syncthreads();
    { LAS float* scr = (LAS float*)(F.lds + F.wave * 16384);
      constexpr int I_W1 = 32 * 352, I_W2 = 88 * 64, I_WIN = 32 * 488, I_WBR = 3 * 16 * 64, I_WOUT = 32 * 64;
      constexpr int PER_L = 2 * I_W1 + 2 * I_W2 + I_WIN + I_WBR + I_WOUT;
      for (int it = gw; it < DEPTH * PER_L; it += NGW) {
          const int l = it / PER_L; int r = it % PER_L;
          unsigned char* wl = F.ws + WS_W + (size_t)l * WL_SIZE;
          const int ln = F.lane & 31;
          if (r < 2 * I_W1) {
              const int which = r / I_W1; r %= I_W1; const int kb = r / 352, nb = r % 352, dr = nb * 32 + ln;
              const int pn = dr >> 8, bj = (dr >> 7) & 1, jj = dr & 127;
              transpose_item(inp(which ? 11 : 9) + (size_t)l * D * 2 * DFF, 2 * DFF, kb * 64, bj * DFF + pn * 128 + jj, (f16*)(wl + (which ? WL_W3 : WL_W1)), D, nb * 32, scr, F.lane); continue; }
          r -= 2 * I_W1;
          if (r < 2 * I_W2) {
              const int which = r / I_W2; r %= I_W2; const int kb = r / 64, nb = r % 64;
              transpose_item(inp(which ? 12 : 10) + (size_t)l * DFF * D, D, kb * 64, nb * 32 + ln, (f16*)(wl + (which ? WL_W4 : WL_W2)), DFF, nb * 32, scr, F.lane); continue; }
          r -= 2 * I_W2;
          if (r < I_WIN) {
              const int kb = r / 488, nb = r % 488;
              transpose_item(inp(13) + (size_t)l * D * PIN_SRC, PIN_SRC, kb * 64, win_src(nb * 32 + ln), (f16*)(wl + WL_WIN), D, nb * 32, scr, F.lane); continue; }
          r -= I_WIN;
          if (r < I_WBR) {
              const int n = r / 1024; r %= 1024; const int kb = r / 64, nb = r % 64;
              transpose_item(inp(25) + ((size_t)l * 3 + n) * BW * D, D, kb * 64, nb * 32 + ln, (f16*)(wl + WL_WBR) + (size_t)n * D * BW, BW, nb * 32, scr, F.lane); continue; }
          r -= I_WBR;
          { const int kb = r / 64, nb = r % 64;
            transpose_item(inp(26) + (size_t)l * D * D, D, kb * 64, nb * 32 + ln, (f16*)(wl + WL_WOUT), D, nb * 32, scr, F.lane); }
      }
    }
}

__device__ __forceinline__ void phase_adaln(int li_v, int which_v) {
    Frame F = make_frame(); const int li = UNI(li_v), which = UNI(which_v);
    const float* gain = inp(6 + which) + (size_t)li * D; const int chunk_shift = 3 * which; const int M = (which == 2 && li == DEPTH - 1) ? ML : MT;
    const int gw = F.bid * 8 + F.wave, NGW = F.G * 8;
    const float* X = WSP(float, WS_X); f16* H = WSP(f16, WS_H);
    for (int row = gw; row < M; row += NGW) {
        const int bidx = row < ML ? row / SEQ : 4;
        const float* modb = WSP(float, WS_MOD) + ((size_t)li * 5 + bidx) * NMODC + chunk_shift * D;
        const f32x4* xr = (const f32x4*)(X + (size_t)row * D) + F.lane;
        f32x4 v[8]; float ss = 0.f;
#pragma unroll
        for (int j = 0; j < 8; ++j) { v[j] = xr[64 * j]; ss += (v[j].x * v[j].x + v[j].y * v[j].y) + (v[j].z * v[j].z + v[j].w * v[j].w); }
        const float rstd = rsqrtf(wave_sum(ss) * (1.0f / D) + EPS);
        u32x2* o = (u32x2*)(H + (size_t)row * D) + F.lane;
#pragma unroll
        for (int j = 0; j < 8; ++j) { const int c = (64 * j + F.lane) * 4;
            const f32x4 g = *(const f32x4*)(gain + c), sh = *(const f32x4*)(modb + c), sc = *(const f32x4*)(modb + D + c);
            const f32x4 y = v[j] * rstd * g * (sc + 1.0f) + sh;
            u32x2 w; w.x = pk_f16(y.x, y.y); w.y = pk_f16(y.z, y.w); o[64 * j] = w; }
    }
}
__device__ __forceinline__ void phase_final() {
    Frame F = make_frame();
    const int gw = F.bid * 8 + F.wave, NGW = F.G * 8;
    const float* X = WSP(float, WS_X); const float* gain = inp(27);
    for (int row = gw; row < ML; row += NGW) {
        const f32x4* xr = (const f32x4*)(X + (size_t)row * D) + F.lane;
        f32x4 v[8]; float ss = 0.f;
#pragma unroll
        for (int j = 0; j < 8; ++j) { v[j] = xr[64 * j]; ss += (v[j].x * v[j].x + v[j].y * v[j].y) + (v[j].z * v[j].z + v[j].w * v[j].w); }
        const float rstd = rsqrtf(wave_sum(ss) * (1.0f / D) + EPS);
        f32x4* o = (f32x4*)(F.out + (size_t)row * D) + F.lane;
#pragma unroll
        for (int j = 0; j < 8; ++j) { const int c = (64 * j + F.lane) * 4; o[64 * j] = v[j] * rstd * *(const f32x4*)(gain + c); }
    }
}

__device__ __forceinline__ void phase_lru_a(int li_v) {
    Frame F = make_frame(); const int li = UNI(li_v);
    LAS float* xc = (LAS float*)F.lds;
    const f16* P = WSP(f16, WS_P); float* LA = WSP(float, WS_LA); float* LU = WSP(float, WS_LU);
    const float* cw = inp(18) + (size_t)li * 4 * BW; const float* cb = inp(19) + (size_t)li * BW;
    const float* wa = inp(20) + (size_t)li * 2 * 8 * 128 * 128; const float* ba = inp(21) + (size_t)li * 2 * BW;
    const float* wx = inp(22) + (size_t)li * 2 * 8 * 128 * 128; const float* bx = inp(23) + (size_t)li * 2 * BW;
    const float* lam = inp(24) + (size_t)li * 2 * BW;
    for (int it = F.bid; it < MT / 8; it += F.G) {
        const int row0 = it * 8;
        int sbeg, send; if (row0 < ML) { sbeg = (row0 / SEQ) * SEQ; send = sbeg + SEQ; } else { sbeg = ML + ((row0 - ML) / CTXL) * CTXL; send = sbeg + CTXL; }
        for (int i = F.tid; i < 8 * BW; i += 512) { const int tt = i >> 10, ch = i & 1023, row = row0 + tt;
            float y = cb[ch];
#pragma unroll
            for (int j = 0; j < 4; ++j) { const int rr = row + j - 1; if (rr >= sbeg && rr < send) y += cw[j * BW + ch] * (float)P[(size_t)rr * LDP + LX + ch]; }
            xc[i] = y; }
        __syncthreads();
#pragma unroll 1
        for (int q = 0; q < 4; ++q) {
            const int o = q * 512 + F.tid, n = o >> 10, ch = o & 1023, g = ch >> 7, j = ch & 127;
            const float* wap = wa + ((size_t)(n * 8 + g) * 128) * 128 + j; const float* wxp = wx + ((size_t)(n * 8 + g) * 128) * 128 + j;
            float aa[8], ax[8];
#pragma unroll
            for (int t = 0; t < 8; ++t) { aa[t] = 0.f; ax[t] = 0.f; }
#pragma unroll 4
            for (int i = 0; i < 128; ++i) { const float w1 = wap[i * 128], w2 = wxp[i * 128];
#pragma unroll
                for (int t = 0; t < 8; ++t) { const float xv = xc[t * 1024 + g * 128 + i]; aa[t] += xv * w1; ax[t] += xv * w2; } }
            const float bav = ba[n * BW + ch], bxv = bx[n * BW + ch]; const float lm = lam[n * BW + ch];
            const float sp = log1pf(expf(-lm));
#pragma unroll
            for (int t = 0; t < 8; ++t) { const float r = sigmoidf_(aa[t] + bav), ig = sigmoidf_(ax[t] + bxv);
                const float log_a = -8.0f * r * sp; const float a = expf(log_a); const float uu = sqrtf(-expm1f(2.0f * log_a)) * ig * xc[t * 1024 + ch];
                LA[((size_t)(row0 + t) * 2 + n) * BW + ch] = a; LU[((size_t)(row0 + t) * 2 + n) * BW + ch] = uu; }
        }
        __syncthreads();
    }
}
__device__ __forceinline__ void lru_scan_item(Frame& F, int item) {
    const int idx = item * 512 + F.tid;
    const int ch = idx & 1023, dir = (idx >> 10) & 1, b = idx >> 11;
    const float* LA = WSP(float, WS_LA); const float* LU = WSP(float, WS_LU); float* HL = WSP(float, WS_HL);
    float h = 0.f;
#pragma unroll 1
    for (int seg = 0; seg < 2; ++seg) {
        const int base = seg == 0 ? ML + b * CTXL : b * SEQ, len = seg == 0 ? CTXL : SEQ;
#pragma unroll 8
        for (int s = 0; s < len; ++s) { const int row = base + (dir ? len - 1 - s : s); const size_t o = ((size_t)row * 2 + dir) * BW + ch;
            h = LA[o] * h + LU[o]; HL[((size_t)dir * MT + row) * BW + ch] = h; }
    }
}

__device__ __forceinline__ void na_unit(Frame& F, int li, int unit) {
    const bool lat = unit < 1024; const int uu = lat ? unit : unit - 1024;
    const int h = uu & 7, rr = (uu >> 3) & (lat ? 31 : 3), b = uu >> (lat ? 8 : 5);
    const f16* P = WSP(f16, WS_P); f16* Y = WSP(f16, WS_Y) + (size_t)1 * MT * BW;
    const float* rpb = inp(17) + ((size_t)li * 8 + h) * 15 * 31;
    LAS float* qf = (LAS float*)(F.lds + F.wave * 4096);
    LAS float* pj = qf + 128;
    const int npass = lat ? 6 : 4; const int rs = lat ? min(max(rr - 4, 0), 24) : 0;
    for (int qi = 0; qi < 8; ++qi) {
        const int qc = F.wave * 8 + qi;
        const int rowq = lat ? b * SEQ + rr * 64 + qc : ML + b * CTXL + rr * 64 + qc;
        { const f16x2 qv = *(const f16x2*)(P + (size_t)rowq * LDP + NQ + h * 128 + 2 * F.lane); qf[2 * F.lane] = (float)qv[0]; qf[2 * F.lane + 1] = (float)qv[1]; }
        LDS_WAIT();
        const int cs = min(max(qc - 8, 0), 48);
        float sc[6];
#pragma unroll
        for (int p = 0; p < 6; ++p) {
            sc[p] = -INFINITY;
            if (p < npass) {
                int krow_g; float bias = 0.f;
                if (lat && p < 2) { const int jrow = (F.lane >> 4) + 4 * p, kc = cs + (F.lane & 15), kr = rs + jrow; krow_g = b * SEQ + kr * 64 + kc;
                    bias = rpb[(kr - rr + 7) * 31 + (min(max(kc - qc, -15), 15) + 15)]; }
                else { const int ci = (lat ? p - 2 : p) * 64 + F.lane; krow_g = ML + b * CTXL + ci; }
                const f16x8* kp = (const f16x8*)(P + (size_t)krow_g * LDP + NK + h * 128);
                float d = 0.f;
#pragma unroll 4
                for (int i = 0; i < 16; ++i) { const f16x8 kv = kp[i];
#pragma unroll
                    for (int e = 0; e < 8; ++e) d += (float)kv[e] * qf[8 * i + e]; }
                sc[p] = d + bias;
            }
        }
        float mx = sc[0];
#pragma unroll
        for (int p = 1; p < 6; ++p) mx = fmaxf(mx, sc[p]);
        mx = wave_max(mx);
        float sm = 0.f;
#pragma unroll
        for (int p = 0; p < 6; ++p) { sc[p] = p < npass ? __expf(sc[p] - mx) : 0.f; sm += sc[p]; }
        sm = wave_sum(sm); const float inv = 1.0f / sm;
#pragma unroll
        for (int p = 0; p < 6; ++p) if (p < npass) pj[p * 64 + F.lane] = sc[p] * inv;
        LDS_WAIT();
        float a0 = 0.f, a1 = 0.f;
        for (int j = 0; j < npass * 64; ++j) {
            const int p = j >> 6, l = j & 63; int krow_g;
            if (lat && p < 2) { const int jrow = (l >> 4) + 4 * p, kc = cs + (l & 15); krow_g = b * SEQ + (rs + jrow) * 64 + kc; }
            else krow_g = ML + b * CTXL + (lat ? p - 2 : p) * 64 + l;
            const f16x2 vv = *(const f16x2*)(P + (size_t)krow_g * LDP + NV + h * 128 + 2 * F.lane);
            const float pv = pj[j]; a0 += pv * (float)vv[0]; a1 += pv * (float)vv[1];
        }
        *(unsigned*)(Y + (size_t)rowq * BW + h * 128 + 2 * F.lane) = pk_f16(a0, a1);
        LDS_WAIT();
    }
}

__device__ __forceinline__ void mlstm_unit(Frame& F, int li, int unit, bool ctx_out) {
    const int vs = unit & 7, dir = (unit >> 3) & 1, h = (unit >> 4) & 3, b = unit >> 6;
    LAS float* Cs = (LAS float*)F.lds;
    LAS float* ns = Cs + 32 * 257;
    LAS float* Vs = ns + 256;
    LAS float* Ss = Vs + 64 * 33;
    LAS float* cum = Ss + 64 * 65;
    LAS float* mrow = cum + 64; LAS float* ig = mrow + 64; LAS float* lf = ig + 64; LAS float* inter = lf + 64; LAS float* wst = inter + 64; LAS float* den = wst + 64; LAS float* misc = den + 64;
    LAS f16* Qs = (LAS f16*)(misc + 64);
    LAS f16* Ks = Qs + 64 * 264;
    const f16* P = WSP(f16, WS_P); const float* G = WSP(float, WS_G); float* HMD = WSP(float, WS_HMD) + (size_t)dir * MT * BW;
    const float bi_ = inp(14)[(li * 2 + dir) * 4 + h], bf_ = inp(15)[(li * 2 + dir) * 4 + h];
    for (int i = F.tid; i < 32 * 257 + 256; i += 512) Cs[i] = 0.f;
    if (F.tid == 0) misc[0] = -INFINITY;
    __syncthreads();
    for (int j = 0; j < 36; ++j) {
        const bool isctx = j < 4; const int base = isctx ? ML + b * CTXL : b * SEQ, len = isctx ? CTXL : SEQ, off = isctx ? j * 64 : (j - 4) * 64;
#define MROW(s) (base + (dir ? len - 1 - (off + (s)) : off + (s)))
        for (int i = F.tid; i < 2048; i += 512) { const int s = i >> 5, c8 = i & 31; const size_t ro = (size_t)MROW(s) * LDP + h * 256 + c8 * 8;
            *(LAS f16x8*)(Qs + s * 264 + c8 * 8) = *(const f16x8*)(P + ro + PQ); *(LAS f16x8*)(Ks + s * 264 + c8 * 8) = *(const f16x8*)(P + ro + PK); }
        if (F.tid < 256) { const int s = F.tid >> 2, c8 = F.tid & 3; const f16x8 v = *(const f16x8*)(P + (size_t)MROW(s) * LDP + PV + h * 256 + vs * 32 + c8 * 8);
#pragma unroll
            for (int e = 0; e < 8; ++e) Vs[s * 33 + c8 * 8 + e] = (float)v[e]; }
        if (F.tid < 64) { const int row = MROW(F.tid); ig[F.tid] = G[(size_t)row * 16 + dir * 8 + h] + bi_; const float fp = G[(size_t)row * 16 + dir * 8 + 4 + h] + bf_;
            lf[F.tid] = fminf(fp, 0.f) - log1pf(expf(-fabsf(fp))); }
        __syncthreads();
        if (F.tid == 0) { const float mp = misc[0]; float c = 0.f, R = mp;
            for (int s = 0; s < 64; ++s) { c += lf[s]; cum[s] = c; R = fmaxf(R, ig[s] - c); mrow[s] = c + R; inter[s] = expf(c + mp - (c + R)); }
            const float mn = mrow[63], cl = cum[63];
            for (int s = 0; s < 64; ++s) wst[s] = expf(cl - cum[s] + ig[s] - mn);
            misc[1] = expf(cl + mp - mn); misc[0] = mn; }
        __syncthreads();
        const bool need_out = !isctx || ctx_out;
        if (need_out) {
            for (int i = F.tid; i < 4096; i += 512) { const int t = i >> 6, s = i & 63; float v = 0.f;
                if (s <= t) { float d = 0.f;
#pragma unroll 8
                    for (int k = 0; k < 256; ++k) d += (float)Qs[t * 264 + k] * (float)Ks[s * 264 + k];
                    v = d * expf(cum[t] - cum[s] + ig[s] - mrow[t]); }
                Ss[t * 65 + s] = v; }
            __syncthreads();
            float num[4];
#pragma unroll
            for (int q = 0; q < 4; ++q) { const int i = q * 512 + F.tid, t = i >> 5, v = i & 31; float a = 0.f, bs = 0.f;
#pragma unroll 8
                for (int k = 0; k < 256; ++k) a += Cs[v * 257 + k] * (float)Qs[t * 264 + k];
#pragma unroll 8
                for (int s = 0; s < 64; ++s) bs += Ss[t * 65 + s] * Vs[s * 33 + v];
                num[q] = inter[t] * a + bs; }
            if (F.tid < 64) { const int t = F.tid; float a = 0.f, bs = 0.f;
                for (int k = 0; k < 256; ++k) a += ns[k] * (float)Qs[t * 264 + k];
                for (int s = 0; s < 64; ++s) bs += Ss[t * 65 + s];
                den[t] = inter[t] * a + bs; }
            __syncthreads();
#pragma unroll
            for (int q = 0; q < 4; ++q) { const int i = q * 512 + F.tid, t = i >> 5, v = i & 31;
                HMD[(size_t)MROW(t) * BW + h * 256 + vs * 32 + v] = num[q] / fmaxf(fabsf(den[t]), expf(-mrow[t])); }
        }
        __syncthreads();
        { const float decay = misc[1];
          for (int i = F.tid; i < 8192; i += 512) { const int v = i >> 8, k = i & 255; float a = 0.f;
#pragma unroll 8
              for (int s = 0; s < 64; ++s) a += wst[s] * Vs[s * 33 + v] * (float)Ks[s * 264 + k];
              Cs[v * 257 + k] = decay * Cs[v * 257 + k] + a; }
          if (F.tid < 256) { const int k = F.tid; float a = 0.f;
              for (int s = 0; s < 64; ++s) a += wst[s] * (float)Ks[s * 264 + k];
              ns[k] = decay * ns[k] + a; } }
        __syncthreads();
#undef MROW
    }
}

__device__ __forceinline__ void phase_finish(int li_v) {
    Frame F = make_frame(); const int li = UNI(li_v); const int M = li == DEPTH - 1 ? ML : MT;
    const int gw = F.bid * 8 + F.wave, NGW = F.G * 8;
    const f16* P = WSP(f16, WS_P); const float* HMD = WSP(float, WS_HMD); const float* HL = WSP(float, WS_HL); f16* Y = WSP(f16, WS_Y);
    const float* gn = inp(16) + (size_t)li * BW;
    for (int row = gw; row < M; row += NGW) {
#pragma unroll
        for (int hh = 0; hh < 4; ++hh) { const int c = hh * 256 + 4 * F.lane;
            const f32x4 a = *(const f32x4*)(HMD + (size_t)row * BW + c), bq = *(const f32x4*)(HMD + ((size_t)MT + row) * BW + c);
            const f32x4 s = a + bq; const float ss = wave_sum((s.x * s.x + s.y * s.y) + (s.z * s.z + s.w * s.w));
            const float rstd = rsqrtf(ss * (1.0f / 256.0f) + EPS);
            const f16x4 og = *(const f16x4*)(P + (size_t)row * LDP + PO + c); const f32x4 g = *(const f32x4*)(gn + c);
            u32x2 w; w.x = pk_f16((float)og[0] * s.x * rstd * g.x, (float)og[1] * s.y * rstd * g.y); w.y = pk_f16((float)og[2] * s.z * rstd * g.z, (float)og[3] * s.w * rstd * g.w);
            *(u32x2*)(Y + (size_t)row * BW + c) = w; }
#pragma unroll
        for (int hh = 0; hh < 4; ++hh) { const int c = hh * 256 + 4 * F.lane;
            const f32x4 a = *(const f32x4*)(HL + (size_t)row * BW + c), bq = *(const f32x4*)(HL + ((size_t)MT + row) * BW + c);
            const f16x4 gg = *(const f16x4*)(P + (size_t)row * LDP + LG + c);
            u32x2 w; w.x = pk_f16((a.x + bq.x) * (float)gg[0], (a.y + bq.y) * (float)gg[1]); w.y = pk_f16((a.z + bq.z) * (float)gg[2], (a.w + bq.w) * (float)gg[3]);
            *(u32x2*)(Y + ((size_t)2 * MT + row) * BW + c) = w; }
    }
}

constexpr int NPL = 13, PH_FINAL = 1 + DEPTH * NPL, NPHASE = PH_FINAL + 1;
__device__ __forceinline__ void ph_gemm_swiglu(int li_v, int which_v) {
    Frame F = make_frame(); const int li = UNI(li_v), which = UNI(which_v);
    unsigned char* wl = F.ws + WS_W + (size_t)li * WL_SIZE; const int M = (which == 1 && li == DEPTH - 1) ? ML : MT;
    pg8::Gemm g{WSP(f16, WS_H), (const f16*)(wl + (which ? WL_W3 : WL_W1)), M, 2 * DFF, D}; pg8::StaticOrder S; S.init(M, 2 * DFF, F.G, F.bid);
    EpiSwiGLU E{WSP(f16, WS_P)}; pg8::gemm_phase<EpiSwiGLU, pg8::StaticOrder, true, true>(F.lds, g, S, E, F.tid);
}
__device__ __forceinline__ void ph_gemm_resid(int li_v, int which_v) {
    Frame F = make_frame(); const int li = UNI(li_v), which = UNI(which_v);
    unsigned char* wl = F.ws + WS_W + (size_t)li * WL_SIZE; const int M = (which >= 1 && li == DEPTH - 1) ? ML : MT;
    const float* modl = WSP(float, WS_MOD) + (size_t)li * 5 * NMODC + (2 + 3 * which) * D;
    const f16* A = which == 1 ? WSP(f16, WS_MH) : WSP(f16, WS_P); const f16* Bt = (const f16*)(wl + (which == 0 ? WL_W2 : which == 1 ? WL_WOUT : WL_W4));
    const int K = which == 1 ? D : DFF;
    pg8::Gemm g{A, Bt, M, D, K}; pg8::StaticOrder S; S.init(M, D, F.G, F.bid);
    EpiResid E{WSP(float, WS_X), modl, which == 1 ? 1.0f : 0.5f}; pg8::gemm_phase<EpiResid, pg8::StaticOrder, true, true>(F.lds, g, S, E, F.tid);
}
__device__ __forceinline__ void ph_gemm_proj(int li_v) {
    Frame F = make_frame(); const int li = UNI(li_v);
    unsigned char* wl = F.ws + WS_W + (size_t)li * WL_SIZE;
    pg8::Gemm g{WSP(f16, WS_H), (const f16*)(wl + WL_WIN), MT, NPIN, D}; pg8::StaticOrder S; S.init(MT, NPIN, F.G, F.bid);
    EpiProj E{WSP(f16, WS_P), WSP(float, WS_G), WSP(float, WS_ROPE)}; pg8::gemm_phase<EpiProj, pg8::StaticOrder, true, true>(F.lds, g, S, E, F.tid);
}
template <int MODE> __device__ __forceinline__ void ph_gemm_gate(int li_v) {
    Frame F = make_frame(); const int li = UNI(li_v);
    unsigned char* wl = F.ws + WS_W + (size_t)li * WL_SIZE; const int M = li == DEPTH - 1 ? ML : MT;
    const f16* Y = WSP(f16, WS_Y) + (size_t)MODE * MT * BW; const f16* wbr = (const f16*)(wl + WL_WBR) + (size_t)MODE * D * BW; const f16* gate = WSP(f16, WS_P) + GX + MODE * D;
    pg8::Gemm g{Y, wbr, M, D, BW}; pg8::StaticOrder S; S.init(M, D, F.G, F.bid);
    EpiGate<MODE> E{gate, WSP(float, WS_MF), WSP(f16, WS_MH)}; pg8::gemm_phase<EpiGate<MODE>, pg8::StaticOrder, true, true>(F.lds, g, S, E, F.tid);
}
__device__ __forceinline__ void ph_mixers(int li_v) {
    Frame F = make_frame(); const int li = UNI(li_v); const bool last = li == DEPTH - 1;
    for (int u = F.bid; u < 256; u += F.G) { mlstm_unit(F, li, u, !last); __syncthreads(); }
    const int nna = last ? 1024 : 1152;
    for (int u = F.bid; u < nna; u += F.G) na_unit(F, li, u);
    for (int u = F.bid; u < 16; u += F.G) lru_scan_item(F, u);
}

__global__ void __launch_bounds__(512, 2) mega_fwd(Args args) {
    LAS unsigned char* lds = (LAS unsigned char*)lds_raw;
    const int tid = threadIdx.x;
    volatile LAS unsigned* MISC = (volatile LAS unsigned*)(lds + LDS_MISC);
    if (tid < 64) MISC[tid] = 0u;
    __syncthreads();
    unsigned* barw = (unsigned*)(args.ws + WS_CTL) + 4096;
    XcdBarrier bar; bar.bar = barw; bar.x = 0; bar.st = nullptr;
    const int lo = args.ph_lo, hi = args.ph_hi;
    if (hi - lo > 1) bar = xcd_barrier_post(barw, MISC + 8);
#define IN(k) (lo <= (k) && (k) < hi && ((PHSEL >> ((k) == 0 ? 16 : (k) == PH_FINAL ? 17 : ((k) - 1) % NPL)) & 1))
#define SEAM(k) do { if (lo <= (k) && (k) + 1 < hi) xcd_barrier(bar); } while (0)
    if (IN(0)) phase_prologue();
    SEAM(0);
#pragma unroll 1
    for (int li = 0; li < DEPTH; ++li) {
        const int p0 = 1 + li * NPL;
        if (IN(p0 + 0)) phase_adaln(li, 0);
        SEAM(p0 + 0);
        if (IN(p0 + 1)) ph_gemm_swiglu(li, 0);
        SEAM(p0 + 1);
        if (IN(p0 + 2)) ph_gemm_resid(li, 0);
        SEAM(p0 + 2);
        if (IN(p0 + 3)) phase_adaln(li, 1);
        SEAM(p0 + 3);
        if (IN(p0 + 4)) ph_gemm_proj(li);
        SEAM(p0 + 4);
        if (IN(p0 + 5)) phase_lru_a(li);
        SEAM(p0 + 5);
        if (IN(p0 + 6)) ph_mixers(li);
        SEAM(p0 + 6);
        if (IN(p0 + 7)) phase_finish(li);
        SEAM(p0 + 7);
        if (IN(p0 + 8)) { ph_gemm_gate<0>(li); ph_gemm_gate<1>(li); ph_gemm_gate<2>(li); }
        SEAM(p0 + 8);
        if (IN(p0 + 9)) ph_gemm_resid(li, 1);
        SEAM(p0 + 9);
        if (IN(p0 + 10)) phase_adaln(li, 2);
        SEAM(p0 + 10);
        if (IN(p0 + 11)) ph_gemm_swiglu(li, 1);
        SEAM(p0 + 11);
        if (IN(p0 + 12)) ph_gemm_resid(li, 2);
        SEAM(p0 + 12);
    }
    if (IN(PH_FINAL)) phase_final();
#undef IN
#undef SEAM
}

extern "C" void kernel_launch(void* const* d_in, const int* in_sizes, int n_in, void* d_out, int out_size, void* d_ws, size_t ws_size, hipStream_t stream) {
    static int grid = 0;
    if (grid == 0) {
        if (n_in != 28 || ws_size < WS_END) { fprintf(stderr, "kernel_launch: unexpected n_in %d or ws_size %zu (< %zu)\n", n_in, ws_size, (size_t)WS_END); grid = -1; return; }
        int dev = 0, cus = 0, per_cu = 0;
        if (hipGetDevice(&dev) != hipSuccess || hipDeviceGetAttribute(&cus, hipDeviceAttributeMultiprocessorCount, dev) != hipSuccess) { grid = -1; return; }
        if (hipFuncSetAttribute((const void*)mega_fwd, hipFuncAttributeMaxDynamicSharedMemorySize, LDS_BYTES) != hipSuccess) { fprintf(stderr, "kernel_launch: hipFuncSetAttribute failed\n"); grid = -1; return; }
        if (hipOccupancyMaxActiveBlocksPerMultiprocessor(&per_cu, (const void*)mega_fwd, 512, LDS_BYTES) != hipSuccess || per_cu < 1) fprintf(stderr, "kernel_launch: occupancy query says %d\n", per_cu);
        (void)hipGetLastError();
        grid = cus;
    }
    if (grid < 0) return;
    (void)hipMemsetAsync((char*)d_ws + WS_CTL, 0, 1 * MiB, stream);
    Args a{};
    for (int i = 0; i < 28; ++i) a.in[i] = (const float*)d_in[i];
    a.out = (float*)d_out; a.ws = (unsigned char*)d_ws;
#if MK_ONE_LAUNCH
    a.ph_lo = 0; a.ph_hi = NPHASE;
    hipLaunchKernelGGL(mega_fwd, dim3(grid), dim3(512), LDS_BYTES, stream, a);
#else
    for (int p = 0; p < NPHASE; ++p) { a.ph_lo = p; a.ph_hi = p + 1; hipLaunchKernelGGL(mega_fwd, dim3(grid), dim3(512), LDS_BYTES, stream, a); }
#endif
}
```

```cpp
#include <hip/hip_runtime.h>
#include <cstdio>
#include <cstdint>

#define LAS __attribute__((address_space(3)))
typedef _Float16 f16;
typedef _Float16 f16x8 __attribute__((ext_vector_type(8)));
typedef _Float16 f16x4 __attribute__((ext_vector_type(4)));
typedef _Float16 f16x2 __attribute__((ext_vector_type(2)));
typedef float f32x4 __attribute__((ext_vector_type(4)));
typedef float f32x2 __attribute__((ext_vector_type(2)));
typedef unsigned u32x4 __attribute__((ext_vector_type(4)));
typedef unsigned u32x2 __attribute__((ext_vector_type(2)));

#ifndef PHSEL
#define PHSEL 0xFFFFF
#endif
#ifndef MK_ONE_LAUNCH
#define MK_ONE_LAUNCH 1
#endif

constexpr int D = 2048, NB = 4, SEQ = 2048, CTXL = 256, DEPTH = 2, DFF = 5632, BW = 1024;
constexpr int ML = NB * SEQ, MC = NB * CTXL, MT = ML + MC;
constexpr int NMODC = 9 * D;
constexpr int PIN_SRC = 15376;
constexpr int NPIN = 15616;
constexpr int LDP = 15360;
constexpr int PQ = 0, PK = 1024, PV = 2048, PO = 3072, NQ = 4096, NK = 5120, NV = 6144, LX = 7168, LG = 8192, GX = 9216;
constexpr float EPS = 1e-6f;

constexpr size_t MiB = 1u << 20;
constexpr size_t WS_CTL = 0;
constexpr size_t WS_MOD = 1 * MiB;
constexpr size_t WS_ROPE = 2 * MiB;
constexpr size_t WS_G = 3 * MiB;
constexpr size_t WS_W = 4 * MiB;
constexpr size_t WL_W1 = 0, WL_W2 = 44 * MiB, WL_W3 = 66 * MiB, WL_W4 = 110 * MiB, WL_WIN = 132 * MiB, WL_WBR = 193 * MiB, WL_WOUT = 205 * MiB, WL_SIZE = 213 * MiB;
constexpr size_t WS_X = WS_W + 2 * WL_SIZE;
constexpr size_t WS_H = WS_X + 72 * MiB;
constexpr size_t WS_P = WS_H + 36 * MiB;
constexpr size_t WS_Y = WS_P + 270 * MiB;
constexpr size_t WS_HMD = WS_Y + 54 * MiB;
constexpr size_t WS_LA = WS_HMD + 72 * MiB;
constexpr size_t WS_LU = WS_LA + 72 * MiB;
constexpr size_t WS_HL = WS_LU + 72 * MiB;
constexpr size_t WS_MF = WS_LA;
constexpr size_t WS_MH = WS_LU;
constexpr size_t WS_END = WS_HL + 72 * MiB;

constexpr int LDS_BYTES = 147456;
constexpr int LDS_MISC = 131072 + 4096;

__device__ __forceinline__ unsigned pk_f16(float lo, float hi) { f32x2 v = {lo, hi}; f16x2 h = __builtin_convertvector(v, f16x2); return __builtin_bit_cast(unsigned, h); }
__device__ __forceinline__ float wave_sum(float v) {
#pragma unroll
    for (int o = 1; o < 64; o <<= 1) v += __shfl_xor(v, o);
    return v;
}
__device__ __forceinline__ float wave_max(float v) {
#pragma unroll
    for (int o = 1; o < 64; o <<= 1) v = fmaxf(v, __shfl_xor(v, o));
    return v;
}
__device__ __forceinline__ float sigmoidf_(float x) { return 1.0f / (1.0f + __expf(-x)); }
__device__ __forceinline__ float siluf_(float x) { return x / (1.0f + __expf(-x)); }
__device__ __forceinline__ float gelu_tanh_(float x) { const float z = 0.7978845608028654f * (x + 0.044715f * x * x * x); const float e = __expf(2.0f * z); return 0.5f * x * (1.0f + (1.0f - 2.0f / (e + 1.0f))); }
#define LDS_WAIT() asm volatile("s_waitcnt lgkmcnt(0)" ::: "memory")

#define XB_TMO      128
#define XB_XCNT(j)  (256  + 64 * (j))
#define XB_XSUB(j)  (1280 + 64 * (j))
#define XB_XGEN(j)  (2304 + 64 * (j))
#define XB_TOP      3328
#define XB_TOPGEN   3392
#define XCD_BAR_WORDS 3456
#define XB_SPIN_CAP (1u << 25)
__device__ __forceinline__ unsigned xb_ld(unsigned* p)              { return __hip_atomic_load(p, __ATOMIC_RELAXED, __HIP_MEMORY_SCOPE_AGENT); }
__device__ __forceinline__ unsigned xb_add(unsigned* p, unsigned v) { return __hip_atomic_fetch_add(p, v, __ATOMIC_RELAXED, __HIP_MEMORY_SCOPE_AGENT); }
__device__ __forceinline__ unsigned xb_xcc_id() { return (unsigned)__builtin_amdgcn_s_getreg((3 << 11) | 20) & 0xFu; }
#define XB_SPIN(cond, bar) do { unsigned _sp = 0; while (cond) { __builtin_amdgcn_s_sleep(1); \
    if ((++_sp & 255u) == 0u) { if (xb_ld(&(bar)[XB_TMO])) break; if (_sp > XB_SPIN_CAP) { atomicAdd(&(bar)[XB_TMO], 1u); break; } } } } while (0)
struct XcdBarrier { unsigned* bar; unsigned x; volatile LAS unsigned* st; };
__device__ __forceinline__ XcdBarrier xcd_barrier_post(unsigned* bar, volatile LAS unsigned* st) {
    XcdBarrier b; b.bar = bar; b.x = xb_xcc_id(); b.st = st;
    if (threadIdx.x == 0) (void)xb_add(&bar[XB_XCNT(b.x)], 1u);
    return b;
}
__device__ __forceinline__ void xcd_barrier_complete(unsigned* bar, unsigned x, unsigned& nloc, unsigned& nx) {
    const unsigned G = gridDim.x * gridDim.y * gridDim.z;
    unsigned sum, cnt, mine, sp = 0u;
    for (;;) {
        sum = 0u; cnt = 0u; mine = 0u;
#pragma unroll
        for (unsigned j = 0; j < 16; ++j) { const unsigned c = xb_ld(&bar[XB_XCNT(j)]); sum += c; cnt += (c > 0u) ? 1u : 0u; mine = (j == x) ? c : mine; }
        if (sum == G) break;
        __builtin_amdgcn_s_sleep(1);
        if ((++sp & 255u) == 0u) { if (xb_ld(&bar[XB_TMO])) break; if (sp > XB_SPIN_CAP) { atomicAdd(&bar[XB_TMO], 1u); break; } }
    }
    nloc = mine > 0u ? mine : 1u; nx = cnt > 0u ? cnt : 1u;
}
__device__ __forceinline__ void xcd_barrier(const XcdBarrier& b) {
    asm volatile("s_waitcnt vmcnt(0)" ::: "memory");
    __syncthreads();
    if (threadIdx.x == 0) {
        unsigned* bar = b.bar;
        __builtin_amdgcn_s_waitcnt(0);
        unsigned nloc = b.st[0], nx = b.st[1];
        if (nloc == 0u) { xcd_barrier_complete(bar, b.x, nloc, nx); b.st[0] = nloc; b.st[1] = nx; }
        const unsigned old = xb_add(&bar[XB_XSUB(b.x)], 1u);
        const unsigned gen = old / nloc;
        if (old + 1u == (gen + 1u) * nloc) {
            __builtin_amdgcn_fence(__ATOMIC_RELEASE, "agent");
            asm volatile("s_waitcnt vmcnt(0)" ::: "memory");
            const unsigned og = xb_add(&bar[XB_TOP], 1u);
            const unsigned tg = og / nx;
            if (og + 1u == (tg + 1u) * nx) xb_add(&bar[XB_TOPGEN], 1u);
            else XB_SPIN(xb_ld(&bar[XB_TOPGEN]) == tg, bar);
            __builtin_amdgcn_fence(__ATOMIC_ACQUIRE, "agent");
            xb_add(&bar[XB_XGEN(b.x)], 1u);
            asm volatile("s_waitcnt vmcnt(0)" ::: "memory");
        } else {
            XB_SPIN(xb_ld(&bar[XB_XGEN(b.x)]) == gen, bar);
            __builtin_amdgcn_fence(__ATOMIC_ACQUIRE, "agent");
            asm volatile("s_waitcnt vmcnt(0)" ::: "memory");
        }
    }
    __syncthreads();
}

namespace pg8 {
constexpr int BM = 256, BK = 64, HALF = 128, HTB = HALF * BK * 2, STAGE_BYTES = 8 * HTB, NXCD = 8, WGM = 8;
__host__ __device__ __forceinline__ int lds_byte(int r, int c) { const int st = (r >> 4) * 2 + (c >> 5), rr = r & 15, cc = c & 31, ob = rr * 64 + cc * 2; return st * 1024 + (ob ^ (((ob >> 9) & 1) << 5)); }
__host__ __device__ __forceinline__ void stage_rc(int b, int& R, int& C) { const int st = b / 1024, sb = b % 1024, swz = sb ^ (((sb >> 9) & 1) << 5); R = (st >> 1) * 16 + swz / 64; C = (st & 1) * 32 + (swz % 64) / 2; }
__host__ __device__ __forceinline__ int perm32(int rho) { const int n = rho >> 4, i = rho & 15; return 8 * (i >> 2) + 4 * n + (i & 3); }
struct Unit { int pm, pn; };
struct Gemm { const f16* A; const f16* Bt; int M, N, K; };
struct StaticOrder {
    int nM, nN, nwg, G, c;
    __host__ __device__ void init(int M, int N, int G_, int c_) { nM = M / BM; nN = N / BM; nwg = nM * nN; G = G_; c = c_; }
    __host__ __device__ bool next(int i, Unit& u) const {
        const long L = (long)i * G + c; if (L >= nwg) return false;
        int wgid = (int)L; { const int q = nwg / NXCD, r = nwg % NXCD, xcd = wgid % NXCD, off = wgid / NXCD; wgid = (xcd < r ? xcd * (q + 1) : r * (q + 1) + (xcd - r) * q) + off; }
        const int nig = WGM * nN, gid = wgid / nig, fm = gid * WGM, gsz = (nM - fm) < WGM ? (nM - fm) : WGM;
        u.pm = fm + ((wgid % nig) % gsz); u.pn = (wgid % nig) / gsz; return true;
    }
    __device__ __forceinline__ void a_ready(const Unit&) const {}
    __device__ __forceinline__ void done(const Unit&) const {}
};
template <class Epi, class Sched, bool ALIGN_EPI = false, bool SP2 = false>
__device__ __forceinline__ void gemm_phase(LAS unsigned char* lds, const Gemm g, const Sched& S, const Epi& E, const int tid) {
    const int wid = __builtin_amdgcn_readfirstlane(tid >> 6), lane = tid & 63, wr = wid >> 2, wc = wid & 3, fr = lane & 15, fq = lane >> 4;
    const int K = g.K, nt = K / BK;
    unsigned voffA[2], voffB[2];
#pragma unroll
    for (int i = 0; i < 2; ++i) { int R, C; stage_rc(tid * 16 + i * 8192, R, C); const int Rb = Epi::PERM ? ((R & ~31) + perm32(R & 31)) : R;
        voffA[i] = (unsigned)(R * K + C) * 2u; voffB[i] = (unsigned)(Rb * K + C) * 2u; }
    const size_t kstep = (size_t)(BK * 2);
    const size_t hstep = (size_t)HALF * K * 2;
    const size_t tstep = 2 * hstep;
    const unsigned ldsw = (unsigned)wid * 1024u;
    const int aoff = lds_byte(wr * 64 + fr, fq * 8), boff = lds_byte(wc * 32 + fr, fq * 8);
#define PG8_SA(b, h) (((b) * 2 + (h)) * HTB)
#define PG8_SB(b, h) ((4 + (b) * 2 + (h)) * HTB)
#define PG8_STAGE(bufoff, gbase, voff) do { _Pragma("unroll") for (int _i = 0; _i < 2; ++_i) \
        __builtin_amdgcn_global_load_lds((const unsigned*)((const char*)(gbase) + (voff)[_i]), (LAS unsigned*)(lds + (bufoff) + ldsw + _i * 8192), 16, 0, 0); } while (0)
#define PG8_LDA(dst, b, h) do { _Pragma("unroll") for (int m = 0; m < 4; ++m) _Pragma("unroll") for (int k = 0; k < 2; ++k) dst[m][k] = *(const LAS f16x8*)(lds + PG8_SA(b, h) + aoff + m * 2048 + k * 1024); } while (0)
#define PG8_LDB(dst, b, h) do { _Pragma("unroll") for (int n = 0; n < 2; ++n) _Pragma("unroll") for (int k = 0; k < 2; ++k) dst[n][k] = *(const LAS f16x8*)(lds + PG8_SB(b, h) + boff + n * 2048 + k * 1024); } while (0)
#define PG8_MMA(ai, bj, At, Bt) do { __builtin_amdgcn_s_setprio(1); _Pragma("unroll") for (int m = 0; m < 4; ++m) _Pragma("unroll") for (int n = 0; n < 2; ++n) _Pragma("unroll") for (int k = 0; k < 2; ++k) \
        acc[ai][bj][m][n] = __builtin_amdgcn_mfma_f32_16x16x32_f16(Bt[n][k], At[m][k], acc[ai][bj][m][n], 0, 0, 0); __builtin_amdgcn_s_setprio(0); } while (0)
#define PG8_WAIT_V(n) asm volatile("s_waitcnt vmcnt(" #n ")" ::: "memory")
#define PG8_WAIT_L(n) asm volatile("s_waitcnt lgkmcnt(" #n ")" ::: "memory")
#define PG8_BAR __builtin_amdgcn_s_barrier()
#define PG8_SCHED __builtin_amdgcn_sched_barrier(0)
    Unit cur, nxt; int ui = 0;
    if (!S.next(0, cur)) return;
    f32x4 acc[2][2][4][2];
#pragma unroll
    for (int a = 0; a < 2; ++a)
#pragma unroll
        for (int b = 0; b < 2; ++b)
#pragma unroll
            for (int m = 0; m < 4; ++m)
#pragma unroll
                for (int n = 0; n < 2; ++n) acc[a][b][m][n] = (f32x4){0.f, 0.f, 0.f, 0.f};
    f16x8 At[4][2], B0[2][2], B1[2][2];
    const char* cA = (const char*)g.A + (size_t)cur.pm * tstep; const char* cB = (const char*)g.Bt + (size_t)cur.pn * tstep;
    S.a_ready(cur);
    if constexpr (SP2) {
        PG8_STAGE(PG8_SB(0, 0), cB, voffB); PG8_STAGE(PG8_SB(0, 1), cB + hstep, voffB); PG8_STAGE(PG8_SA(0, 0), cA, voffA); PG8_STAGE(PG8_SA(0, 1), cA + hstep, voffA);
        if (wr == 1) PG8_BAR;
        PG8_WAIT_V(2); PG8_BAR;
        PG8_STAGE(PG8_SB(1, 0), cB + kstep, voffB); PG8_STAGE(PG8_SA(1, 0), cA + kstep, voffA); PG8_STAGE(PG8_SB(1, 1), cB + hstep + kstep, voffB);
        PG8_WAIT_V(6); PG8_BAR;
    } else {
        PG8_STAGE(PG8_SB(0, 0), cB, voffB); PG8_STAGE(PG8_SA(0, 0), cA, voffA); PG8_STAGE(PG8_SB(0, 1), cB + hstep, voffB); PG8_STAGE(PG8_SA(0, 1), cA + hstep, voffA);
        if (wr == 1) PG8_BAR;
        PG8_WAIT_V(4); PG8_BAR;
        PG8_STAGE(PG8_SB(1, 0), cB + kstep, voffB); PG8_STAGE(PG8_SA(1, 0), cA + kstep, voffA); PG8_STAGE(PG8_SB(1, 1), cB + hstep + kstep, voffB);
        PG8_WAIT_V(6); PG8_BAR;
    }
    for (;;) {
        const bool has_next = S.next(ui + 1, nxt);
        const char* nA = has_next ? (const char*)g.A + (size_t)nxt.pm * tstep : cA; const char* nB = has_next ? (const char*)g.Bt + (size_t)nxt.pn * tstep : cB;
        for (int t = 0; t < nt; t += 2) {
            const bool last = (t == nt - 2);
            const char* a1 = cA + (size_t)(t + 1) * kstep;
            const char* a2 = last ? nA : cA + (size_t)(t + 2) * kstep; const char* b2 = last ? nB : cB + (size_t)(t + 2) * kstep;
            const char* a3 = a2 + kstep; const char* b3 = b2 + kstep;
            if (last && has_next) S.a_ready(nxt);
            if constexpr (SP2) {
            PG8_LDB(B0, 0, 0); PG8_LDB(B1, 0, 1); PG8_SCHED; PG8_LDA(At, 0, 0); PG8_STAGE(PG8_SA(1, 1), a1 + hstep, voffA);
            PG8_WAIT_V(8); PG8_WAIT_L(0); PG8_BAR; PG8_MMA(0, 0, At, B0); PG8_MMA(0, 1, At, B1); PG8_BAR; PG8_SCHED;
            PG8_LDA(At, 0, 1); PG8_STAGE(PG8_SB(0, 0), b2, voffB); PG8_STAGE(PG8_SB(0, 1), b2 + hstep, voffB); PG8_STAGE(PG8_SA(0, 0), a2, voffA);
            PG8_WAIT_V(8); PG8_WAIT_L(0); PG8_BAR; PG8_MMA(1, 0, At, B0); PG8_MMA(1, 1, At, B1); PG8_BAR; PG8_SCHED;
            PG8_LDB(B0, 1, 0); PG8_LDB(B1, 1, 1); PG8_SCHED; PG8_LDA(At, 1, 0); PG8_STAGE(PG8_SA(0, 1), a2 + hstep, voffA);
            PG8_WAIT_V(8); PG8_WAIT_L(0); PG8_BAR; PG8_MMA(0, 0, At, B0); PG8_MMA(0, 1, At, B1); PG8_BAR; PG8_SCHED;
            PG8_LDA(At, 1, 1); PG8_STAGE(PG8_SB(1, 0), b3, voffB); PG8_STAGE(PG8_SB(1, 1), b3 + hstep, voffB); PG8_STAGE(PG8_SA(1, 0), a3, voffA);
            PG8_WAIT_V(8); PG8_WAIT_L(0); PG8_BAR; PG8_MMA(1, 0, At, B0); PG8_MMA(1, 1, At, B1); PG8_BAR; PG8_SCHED;
            } else {
            PG8_LDB(B0, 0, 0); PG8_SCHED; PG8_LDA(At, 0, 0); PG8_STAGE(PG8_SA(1, 1), a1 + hstep, voffA);
            PG8_WAIT_L(8); PG8_BAR; PG8_WAIT_L(0); PG8_MMA(0, 0, At, B0); PG8_BAR; PG8_SCHED;
            PG8_LDB(B1, 0, 1); PG8_STAGE(PG8_SB(0, 0), b2, voffB);
            PG8_BAR; PG8_WAIT_L(0); PG8_MMA(0, 1, At, B1); PG8_BAR;
            PG8_LDA(At, 0, 1); PG8_STAGE(PG8_SA(0, 0), a2, voffA);
            PG8_BAR; PG8_WAIT_L(0); PG8_MMA(1, 0, At, B0); PG8_BAR; PG8_SCHED;
            PG8_STAGE(PG8_SB(0, 1), b2 + hstep, voffB);
            PG8_WAIT_V(6); PG8_BAR; PG8_MMA(1, 1, At, B1); PG8_BAR;
            PG8_LDB(B0, 1, 0); PG8_SCHED; PG8_LDA(At, 1, 0); PG8_STAGE(PG8_SA(0, 1), a2 + hstep, voffA);
            PG8_WAIT_L(8); PG8_BAR; PG8_WAIT_L(0); PG8_MMA(0, 0, At, B0); PG8_BAR; PG8_SCHED;
            PG8_LDB(B1, 1, 1); PG8_STAGE(PG8_SB(1, 0), b3, voffB);
            PG8_BAR; PG8_WAIT_L(0); PG8_MMA(0, 1, At, B1); PG8_BAR;
            PG8_LDA(At, 1, 1); PG8_STAGE(PG8_SA(1, 0), a3, voffA);
            PG8_BAR; PG8_WAIT_L(0); PG8_MMA(1, 0, At, B0); PG8_BAR; PG8_SCHED;
            PG8_STAGE(PG8_SB(1, 1), b3 + hstep, voffB);
            PG8_WAIT_V(6); PG8_BAR; PG8_MMA(1, 1, At, B1); PG8_BAR;
            }
        }
        if constexpr (ALIGN_EPI) { if (wr == 0) PG8_BAR; }
        E(acc, cur, wr, wc, fr, fq); S.done(cur);
        if (!has_next) break;
#pragma unroll
        for (int a = 0; a < 2; ++a)
#pragma unroll
            for (int b = 0; b < 2; ++b)
#pragma unroll
                for (int m = 0; m < 4; ++m)
#pragma unroll
                    for (int n = 0; n < 2; ++n) acc[a][b][m][n] = (f32x4){0.f, 0.f, 0.f, 0.f};
        cur = nxt; cA = nA; cB = nB; ++ui;
        if constexpr (ALIGN_EPI) { if (wr == 1) PG8_BAR; }
    }
    PG8_WAIT_V(0);
    if constexpr (!ALIGN_EPI) { if (wr == 0) PG8_BAR; }
    PG8_BAR;
#undef PG8_SA
#undef PG8_SB
#undef PG8_STAGE
#undef PG8_LDA
#undef PG8_LDB
#undef PG8_MMA
#undef PG8_WAIT_V
#undef PG8_WAIT_L
#undef PG8_BAR
#undef PG8_SCHED
}
}
using pg8::Unit;
constexpr int HALF = pg8::HALF, BM = pg8::BM;

struct EpiSwiGLU {
    static constexpr bool PERM = true;
    f16* O;
    __device__ __forceinline__ void operator()(const f32x4 (&acc)[2][2][4][2], const Unit& u, int wr, int wc, int fr, int fq) const {
        asm volatile("" : "+v"(fr), "+v"(fq));
        const int row0 = u.pm * BM + wr * 64 + fr, col0 = u.pn * HALF + wc * 32 + 8 * fq;
#pragma unroll
        for (int ai = 0; ai < 2; ++ai)
#pragma unroll
            for (int m = 0; m < 4; ++m) {
                f16* rowp = O + (size_t)(row0 + ai * HALF + m * 16) * DFF + col0;
                const f32x4 g0 = acc[ai][0][m][0], g1 = acc[ai][0][m][1], u0 = acc[ai][1][m][0], u1 = acc[ai][1][m][1];
                u32x4 w;
                w.x = pk_f16(siluf_(g0[0]) * u0[0], siluf_(g0[1]) * u0[1]); w.y = pk_f16(siluf_(g0[2]) * u0[2], siluf_(g0[3]) * u0[3]);
                w.z = pk_f16(siluf_(g1[0]) * u1[0], siluf_(g1[1]) * u1[1]); w.w = pk_f16(siluf_(g1[2]) * u1[2], siluf_(g1[3]) * u1[3]);
                *(u32x4*)rowp = w;
            }
    }
};
struct EpiResid {
    static constexpr bool PERM = false;
    float* X; const float* modg;
    float coef;
    __device__ __forceinline__ void operator()(const f32x4 (&acc)[2][2][4][2], const Unit& u, int wr, int wc, int fr, int fq) const {
        asm volatile("" : "+v"(fr), "+v"(fq));
        const int row0 = u.pm * BM + wr * 64 + fr, col0 = u.pn * BM + wc * 32 + 4 * fq;
        const int bidx = u.pm < 32 ? (u.pm >> 3) : 4;
        const float* gp = modg + (size_t)bidx * NMODC + col0;
        f32x4 gv[2][2];
#pragma unroll
        for (int bj = 0; bj < 2; ++bj)
#pragma unroll
            for (int n = 0; n < 2; ++n) gv[bj][n] = *(const f32x4*)(gp + bj * HALF + n * 16) * coef;
#pragma unroll
        for (int ai = 0; ai < 2; ++ai)
#pragma unroll
            for (int m = 0; m < 4; ++m) { float* rowp = X + (size_t)(row0 + ai * HALF + m * 16) * D + col0;
#pragma unroll
                for (int bj = 0; bj < 2; ++bj)
#pragma unroll
                    for (int n = 0; n < 2; ++n) { f32x4* p = (f32x4*)(rowp + bj * HALF + n * 16); *p = *p + gv[bj][n] * acc[ai][bj][m][n]; } }
    }
};
struct EpiProj {
    static constexpr bool PERM = true;
    f16* P; float* G; const float* rope;
    __device__ __forceinline__ void operator()(const f32x4 (&acc)[2][2][4][2], const Unit& u, int wr, int wc, int fr, int fq) const {
        asm volatile("" : "+v"(fr), "+v"(fq));
        const int row0 = u.pm * BM + wr * 64 + fr; const int pn = u.pn;
        if (pn == 60) {
            if (wc == 0 && fq < 2) {
#pragma unroll
                for (int ai = 0; ai < 2; ++ai)
#pragma unroll
                    for (int m = 0; m < 4; ++m) { float* gp = G + (size_t)(row0 + ai * HALF + m * 16) * 16 + 8 * fq;
                        *(f32x4*)gp = acc[ai][0][m][0]; *(f32x4*)(gp + 4) = acc[ai][0][m][1]; }
            }
            return;
        }
        const int col0 = pn * BM + wc * 32 + 8 * fq;
        int mode = 0; float scl = 1.0f;
        if (pn < 8) { mode = (u.pm < 32) ? 1 : 2; scl = (pn >= 4) ? 0.0625f : 1.0f; }
        else if (pn >= 12 && pn < 16) mode = 3;
        else if (pn >= 16 && pn < 20) { mode = 2; scl = 0.08838834764831845f; }
        else if (pn >= 32 && pn < 36) mode = 4;
        else if (pn >= 36) mode = 3;
#pragma unroll
        for (int ai = 0; ai < 2; ++ai)
#pragma unroll
            for (int m = 0; m < 4; ++m) {
                const int row = row0 + ai * HALF + m * 16;
                f16* rowp = P + (size_t)row * LDP + col0;
#pragma unroll
                for (int bj = 0; bj < 2; ++bj) {
                    f32x4 v0 = acc[ai][bj][m][0], v1 = acc[ai][bj][m][1];
                    if (mode == 1) {
                        const int t = row & (SEQ - 1); const int pos = bj == 0 ? (t >> 6) : (t & 63);
                        const float* cp = rope + pos * 64 + 16 * wc + 4 * fq;
                        const f32x4 c = *(const f32x4*)cp, s = *(const f32x4*)(cp + 4096);
                        f32x4 o0, o1;
                        o0[0] = v0[0] * c[0] - v0[1] * s[0]; o0[1] = v0[0] * s[0] + v0[1] * c[0];
                        o0[2] = v0[2] * c[1] - v0[3] * s[1]; o0[3] = v0[2] * s[1] + v0[3] * c[1];
                        o1[0] = v1[0] * c[2] - v1[1] * s[2]; o1[1] = v1[0] * s[2] + v1[1] * c[2];
                        o1[2] = v1[2] * c[3] - v1[3] * s[3]; o1[3] = v1[2] * s[3] + v1[3] * c[3];
                        v0 = o0 * scl; v1 = o1 * scl;
                    } else if (mode == 2) { v0 = v0 * scl; v1 = v1 * scl; }
                    else if (mode == 3) {
#pragma unroll
                        for (int e = 0; e < 4; ++e) { v0[e] = sigmoidf_(v0[e]); v1[e] = sigmoidf_(v1[e]); }
                    } else if (mode == 4) {
#pragma unroll
                        for (int e = 0; e < 4; ++e) { v0[e] = gelu_tanh_(v0[e]); v1[e] = gelu_tanh_(v1[e]); }
                    }
                    u32x4 w; w.x = pk_f16(v0[0], v0[1]); w.y = pk_f16(v0[2], v0[3]); w.z = pk_f16(v1[0], v1[1]); w.w = pk_f16(v1[2], v1[3]);
                    *(u32x4*)(rowp + bj * HALF) = w;
                }
            }
    }
};
template <int MODE> struct EpiGate {
    static constexpr bool PERM = true;
    const f16* gate;
    float* MF; f16* MH;
    __device__ __forceinline__ void operator()(const f32x4 (&acc)[2][2][4][2], const Unit& u, int wr, int wc, int fr, int fq) const {
        asm volatile("" : "+v"(fr), "+v"(fq));
        const int row0 = u.pm * BM + wr * 64 + fr, col0 = u.pn * BM + wc * 32 + 8 * fq;
#pragma unroll
        for (int ai = 0; ai < 2; ++ai)
#pragma unroll
            for (int m = 0; m < 4; ++m) {
                const int row = row0 + ai * HALF + m * 16;
#pragma unroll
                for (int bj = 0; bj < 2; ++bj) {
                    const f16x8 gh = *(const f16x8*)(gate + (size_t)row * LDP + col0 + bj * HALF);
                    float* mp = MF + (size_t)row * D + col0 + bj * HALF;
                    f32x4 v0 = acc[ai][bj][m][0], v1 = acc[ai][bj][m][1];
#pragma unroll
                    for (int e = 0; e < 4; ++e) { v0[e] *= (float)gh[e]; v1[e] *= (float)gh[4 + e]; }
                    if (MODE >= 1) { v0 = v0 + *(const f32x4*)mp; v1 = v1 + *(const f32x4*)(mp + 4); }
                    if (MODE <= 1) { *(f32x4*)mp = v0; *(f32x4*)(mp + 4) = v1; }
                    else { u32x4 w; w.x = pk_f16(v0[0], v0[1]); w.y = pk_f16(v0[2], v0[3]); w.z = pk_f16(v1[0], v1[1]); w.w = pk_f16(v1[2], v1[3]);
                        *(u32x4*)(MH + (size_t)row * D + col0 + bj * HALF) = w; }
                }
            }
    }
};

struct Args { const float* in[28]; float* out; unsigned char* ws; int ph_lo, ph_hi; };
struct Frame {
    LAS unsigned char* lds; int tid, lane, wave, G, bid;
    float* out; unsigned char* ws;
};
typedef const Args __attribute__((address_space(4)))* KArgs;
__device__ __forceinline__ KArgs kargs() { return (KArgs)__builtin_amdgcn_kernarg_segment_ptr(); }
__device__ __forceinline__ const float* inp(int k) { return kargs()->in[k]; }
extern __shared__ __attribute__((aligned(16))) unsigned char lds_raw[];
__device__ __forceinline__ Frame make_frame() {
    Frame F; F.lds = (LAS unsigned char*)lds_raw; int t = threadIdx.x; asm volatile("" : "+v"(t));
    F.tid = t; F.lane = F.tid & 63; F.wave = __builtin_amdgcn_readfirstlane(F.tid >> 6);
    int g = gridDim.x, b = blockIdx.x; asm volatile("" : "+s"(g), "+s"(b)); F.G = g; F.bid = b;
    KArgs ka = kargs(); asm volatile("" : "+s"(ka)); F.out = ka->out; F.ws = ka->ws; return F;
}
#define UNI(x) __builtin_amdgcn_readfirstlane(x)
#define WSP(T, off) ((T*)(F.ws + (off)))

__device__ __forceinline__ void transpose_item(const float* W, int ldw, int k0, int srccol, f16* WT, int Kdim, int drow0, LAS float* scr, int lane) {
#pragma unroll 8
    for (int i = 0; i < 32; ++i) { const int kk = 2 * i + (lane >> 5); scr[kk * 33 + (lane & 31)] = srccol >= 0 ? W[(size_t)(k0 + kk) * ldw + srccol] : 0.0f; }
    LDS_WAIT();
    const int c = lane & 7;
#pragma unroll
    for (int j = 0; j < 4; ++j) { const int n = (lane >> 3) + 8 * j; const LAS float* s = scr + (8 * c) * 33 + n;
        u32x4 o; o.x = pk_f16(s[0 * 33], s[1 * 33]); o.y = pk_f16(s[2 * 33], s[3 * 33]); o.z = pk_f16(s[4 * 33], s[5 * 33]); o.w = pk_f16(s[6 * 33], s[7 * 33]);
        *(u32x4*)(WT + (size_t)(drow0 + n) * Kdim + k0 + 8 * c) = o; }
    LDS_WAIT();
}
__device__ __forceinline__ int win_src(int dr) {
    if (dr < 2048) { const int base = dr < 1024 ? 0 : 1024, w = dr & 1023, h = w >> 8, x = w & 255, bj = x >> 7, within = x & 127, i = within >> 1, e = within & 1; return base + h * 256 + bj * 128 + e * 64 + i; }
    if (dr < 4096) return dr;
    if (dr < 15360) return dr + 16;
    const int w = dr - 15360; return w < 16 ? 4096 + w : -1;
}
__device__ __forceinline__ void phase_prologue() {
    Frame F = make_frame();
    const int gw = F.bid * 8 + F.wave, NGW = F.G * 8;
    const int gt = F.bid * 512 + F.tid, NGT = F.G * 512;
    { const f32x4* xs = (const f32x4*)inp(0); const f32x4* cs = (const f32x4*)inp(2); f32x4* X = WSP(f32x4, WS_X);
      const int n1 = ML * D / 4, n2 = MC * D / 4;
      for (int i = gt; i < n1; i += NGT) X[i] = xs[i];
      for (int i = gt; i < n2; i += NGT) X[n1 + i] = cs[i]; }
    { float* rope = WSP(float, WS_ROPE);
      for (int i = gt; i < 4096; i += NGT) { const int pos = i >> 6, j = i & 63; const float inv = powf(10000.0f, -(float)j / 64.0f); const float a = (float)pos * inv; rope[i] = cosf(a); rope[4096 + i] = sinf(a); } }
    { LAS float* sact = (LAS float*)F.lds;
      LAS float* red = (LAS float*)(F.lds + 5 * 2048 * 4);
      for (int i = F.tid; i < 5 * D; i += 512) { const int bi = i / D, k = i % D; const float c = bi < 4 ? inp(1)[bi * D + k] : inp(3)[k]; sact[i] = siluf_(c); }
      __syncthreads();
      for (int it = F.bid; it < DEPTH * 144; it += F.G) {
          const int l = it / 144, n0 = (it % 144) * 128;
          const float* Wm = inp(4) + (size_t)l * D * NMODC + n0 + 2 * F.lane;
          float acc[5][2];
#pragma unroll
          for (int bi = 0; bi < 5; ++bi) { acc[bi][0] = 0.f; acc[bi][1] = 0.f; }
          const int k0 = F.wave * 256;
#pragma unroll 8
          for (int kk = 0; kk < 256; ++kk) { const f32x2 w = *(const f32x2*)(Wm + (size_t)(k0 + kk) * NMODC);
#pragma unroll
              for (int bi = 0; bi < 5; ++bi) { const float a = sact[bi * D + k0 + kk]; acc[bi][0] += a * w.x; acc[bi][1] += a * w.y; } }
#pragma unroll
          for (int bi = 0; bi < 5; ++bi) { red[(F.wave * 5 + bi) * 128 + 2 * F.lane] = acc[bi][0]; red[(F.wave * 5 + bi) * 128 + 2 * F.lane + 1] = acc[bi][1]; }
          __syncthreads();
          for (int i = F.tid; i < 640; i += 512) { const int bi = i / 128, j = i % 128; float s = 0.f;
#pragma unroll
              for (int w = 0; w < 8; ++w) s += red[(w * 5 + bi) * 128 + j];
              WSP(float, WS_MOD)[((size_t)l * 5 + bi) * NMODC + n0 + j] = s + inp(5)[(size_t)l * NMODC + n0 + j]; }
          __syncthreads();
      }
    }
    __syncthreads();
    { LAS float* scr = (LAS float*)(F.lds + F.wave * 16384);
      constexpr int I_W1 = 32 * 352, I_W2 = 88 * 64, I_WIN = 32 * 488, I_WBR = 3 * 16 * 64, I_WOUT = 32 * 64;
      constexpr int PER_L = 2 * I_W1 + 2 * I_W2 + I_WIN + I_WBR + I_WOUT;
      for (int it = gw; it < DEPTH * PER_L; it += NGW) {
          const int l = it / PER_L; int r = it % PER_L;
          unsigned char* wl = F.ws + WS_W + (size_t)l * WL_SIZE;
          const int ln = F.lane & 31;
          if (r < 2 * I_W1) {
              const int which = r / I_W1; r %= I_W1; const int kb = r / 352, nb = r % 352, dr = nb * 32 + ln;
              const int pn = dr >> 8, bj = (dr >> 7) & 1, jj = dr & 127;
              transpose_item(inp(which ? 11 : 9) + (size_t)l * D * 2 * DFF, 2 * DFF, kb * 64, bj * DFF + pn * 128 + jj, (f16*)(wl + (which ? WL_W3 : WL_W1)), D, nb * 32, scr, F.lane); continue; }
          r -= 2 * I_W1;
          if (r < 2 * I_W2) {
              const int which = r / I_W2; r %= I_W2; const int kb = r / 64, nb = r % 64;
              transpose_item(inp(which ? 12 : 10) + (size_t)l * DFF * D, D, kb * 64, nb * 32 + ln, (f16*)(wl + (which ? WL_W4 : WL_W2)), DFF, nb * 32, scr, F.lane); continue; }
          r -= 2 * I_W2;
          if (r < I_WIN) {
              const int kb = r / 488, nb = r % 488;
              transpose_item(inp(13) + (size_t)l * D * PIN_SRC, PIN_SRC, kb * 64, win_src(nb * 32 + ln), (f16*)(wl + WL_WIN), D, nb * 32, scr, F.lane); continue; }
          r -= I_WIN;
          if (r < I_WBR) {
              const int n = r / 1024; r %= 1024; const int kb = r / 64, nb = r % 64;
              transpose_item(inp(25) + ((size_t)l * 3 + n) * BW * D, D, kb * 64, nb * 32 + ln, (f16*)(wl + WL_WBR) + (size_t)n * D * BW, BW, nb * 32, scr, F.lane); continue; }
          r -= I_WBR;
          { const int kb = r / 64, nb = r % 64;
            transpose_item(inp(26) + (size_t)l * D * D, D, kb * 64, nb * 32 + ln, (f16*)(wl + WL_WOUT), D, nb * 32, scr, F.lane); }
      }
    }
}

__device__ __forceinline__ void phase_adaln(int li_v, int which_v) {
    Frame F = make_frame(); const int li = UNI(li_v), which = UNI(which_v);
    const float* gain = inp(6 + which) + (size_t)li * D; const int chunk_shift = 3 * which; const int M = (which == 2 && li == DEPTH - 1) ? ML : MT;
    const int gw = F.bid * 8 + F.wave, NGW = F.G * 8;
    const float* X = WSP(float, WS_X); f16* H = WSP(f16, WS_H);
    for (int row = gw; row < M; row += NGW) {
        const int bidx = row < ML ? row / SEQ : 4;
        const float* modb = WSP(float, WS_MOD) + ((size_t)li * 5 + bidx) * NMODC + chunk_shift * D;
        const f32x4* xr = (const f32x4*)(X + (size_t)row * D) + F.lane;
        f32x4 v[8]; float ss = 0.f;
#pragma unroll
        for (int j = 0; j < 8; ++j) { v[j] = xr[64 * j]; ss += (v[j].x * v[j].x + v[j].y * v[j].y) + (v[j].z * v[j].z + v[j].w * v[j].w); }
        const float rstd = rsqrtf(wave_sum(ss) * (1.0f / D) + EPS);
        u32x2* o = (u32x2*)(H + (size_t)row * D) + F.lane;
#pragma unroll
        for (int j = 0; j < 8; ++j) { const int c = (64 * j + F.lane) * 4;
            const f32x4 g = *(const f32x4*)(gain + c), sh = *(const f32x4*)(modb + c), sc = *(const f32x4*)(modb + D + c);
            const f32x4 y = v[j] * rstd * g * (sc + 1.0f) + sh;
            u32x2 w; w.x = pk_f16(y.x, y.y); w.y = pk_f16(y.z, y.w); o[64 * j] = w; }
    }
}
__device__ __forceinline__ void phase_final() {
    Frame F = make_frame();
    const int gw = F.bid * 8 + F.wave, NGW = F.G * 8;
    const float* X = WSP(float, WS_X); const float* gain = inp(27);
    for (int row = gw; row < ML; row += NGW) {
        const f32x4* xr = (const f32x4*)(X + (size_t)row * D) + F.lane;
        f32x4 v[8]; float ss = 0.f;
#pragma unroll
        for (int j = 0; j < 8; ++j) { v[j] = xr[64 * j]; ss += (v[j].x * v[j].x + v[j].y * v[j].y) + (v[j].z * v[j].z + v[j].w * v[j].w); }
        const float rstd = rsqrtf(wave_sum(ss) * (1.0f / D) + EPS);
        f32x4* o = (f32x4*)(F.out + (size_t)row * D) + F.lane;
#pragma unroll
        for (int j = 0; j < 8; ++j) { const int c = (64 * j + F.lane) * 4; o[64 * j] = v[j] * rstd * *(const f32x4*)(gain + c); }
    }
}

__device__ __forceinline__ void phase_lru_a(int li_v) {
    Frame F = make_frame(); const int li = UNI(li_v);
    LAS float* xc = (LAS float*)F.lds;
    const f16* P = WSP(f16, WS_P); float* LA = WSP(float, WS_LA); float* LU = WSP(float, WS_LU);
    const float* cw = inp(18) + (size_t)li * 4 * BW; const float* cb = inp(19) + (size_t)li * BW;
    const float* wa = inp(20) + (size_t)li * 2 * 8 * 128 * 128; const float* ba = inp(21) + (size_t)li * 2 * BW;
    const float* wx = inp(22) + (size_t)li * 2 * 8 * 128 * 128; const float* bx = inp(23) + (size_t)li * 2 * BW;
    const float* lam = inp(24) + (size_t)li * 2 * BW;
    for (int it = F.bid; it < MT / 8; it += F.G) {
        const int row0 = it * 8;
        int sbeg, send; if (row0 < ML) { sbeg = (row0 / SEQ) * SEQ; send = sbeg + SEQ; } else { sbeg = ML + ((row0 - ML) / CTXL) * CTXL; send = sbeg + CTXL; }
        for (int i = F.tid; i < 8 * BW; i += 512) { const int tt = i >> 10, ch = i & 1023, row = row0 + tt;
            float y = cb[ch];
#pragma unroll
            for (int j = 0; j < 4; ++j) { const int rr = row + j - 1; if (rr >= sbeg && rr < send) y += cw[j * BW + ch] * (float)P[(size_t)rr * LDP + LX + ch]; }
            xc[i] = y; }
        __syncthreads();
#pragma unroll 1
        for (int q = 0; q < 4; ++q) {
            const int o = q * 512 + F.tid, n = o >> 10, ch = o & 1023, g = ch >> 7, j = ch & 127;
            const float* wap = wa + ((size_t)(n * 8 + g) * 128) * 128 + j; const float* wxp = wx + ((size_t)(n * 8 + g) * 128) * 128 + j;
            float aa[8], ax[8];
#pragma unroll
            for (int t = 0; t < 8; ++t) { aa[t] = 0.f; ax[t] = 0.f; }
#pragma unroll 4
            for (int i = 0; i < 128; ++i) { const float w1 = wap[i * 128], w2 = wxp[i * 128];
#pragma unroll
                for (int t = 0; t < 8; ++t) { const float xv = xc[t * 1024 + g * 128 + i]; aa[t] += xv * w1; ax[t] += xv * w2; } }
            const float bav = ba[n * BW + ch], bxv = bx[n * BW + ch]; const float lm = lam[n * BW + ch];
            const float sp = log1pf(expf(-lm));
#pragma unroll
            for (int t = 0; t < 8; ++t) { const float r = sigmoidf_(aa[t] + bav), ig = sigmoidf_(ax[t] + bxv);
                const float log_a = -8.0f * r * sp; const float a = expf(log_a); const float uu = sqrtf(-expm1f(2.0f * log_a)) * ig * xc[t * 1024 + ch];
                LA[((size_t)(row0 + t) * 2 + n) * BW + ch] = a; LU[((size_t)(row0 + t) * 2 + n) * BW + ch] = uu; }
        }
        __syncthreads();
    }
}
__device__ __forceinline__ void lru_scan_item(Frame& F, int item) {
    const int idx = item * 512 + F.tid;
    const int ch = idx & 1023, dir = (idx >> 10) & 1, b = idx >> 11;
    const float* LA = WSP(float, WS_LA); const float* LU = WSP(float, WS_LU); float* HL = WSP(float, WS_HL);
    float h = 0.f;
#pragma unroll 1
    for (int seg = 0; seg < 2; ++seg) {
        const int base = seg == 0 ? ML + b * CTXL : b * SEQ, len = seg == 0 ? CTXL : SEQ;
#pragma unroll 8
        for (int s = 0; s < len; ++s) { const int row = base + (dir ? len - 1 - s : s); const size_t o = ((size_t)row * 2 + dir) * BW + ch;
            h = LA[o] * h + LU[o]; HL[((size_t)dir * MT + row) * BW + ch] = h; }
    }
}

__device__ __forceinline__ void na_unit(Frame& F, int li, int unit) {
    const bool lat = unit < 1024; const int uu = lat ? unit : unit - 1024;
    const int h = uu & 7, rr = (uu >> 3) & (lat ? 31 : 3), b = uu >> (lat ? 8 : 5);
    const f16* P = WSP(f16, WS_P); f16* Y = WSP(f16, WS_Y) + (size_t)1 * MT * BW;
    const float* rpb = inp(17) + ((size_t)li * 8 + h) * 15 * 31;
    LAS float* qf = (LAS float*)(F.lds + F.wave * 4096);
    LAS float* pj = qf + 128;
    const int npass = lat ? 6 : 4; const int rs = lat ? min(max(rr - 4, 0), 24) : 0;
    for (int qi = 0; qi < 8; ++qi) {
        const int qc = F.wave * 8 + qi;
        const int rowq = lat ? b * SEQ + rr * 64 + qc : ML + b * CTXL + rr * 64 + qc;
        { const f16x2 qv = *(const f16x2*)(P + (size_t)rowq * LDP + NQ + h * 128 + 2 * F.lane); qf[2 * F.lane] = (float)qv[0]; qf[2 * F.lane + 1] = (float)qv[1]; }
        LDS_WAIT();
        const int cs = min(max(qc - 8, 0), 48);
        float sc[6];
#pragma unroll
        for (int p = 0; p < 6; ++p) {
            sc[p] = -INFINITY;
            if (p < npass) {
                int krow_g; float bias = 0.f;
                if (lat && p < 2) { const int jrow = (F.lane >> 4) + 4 * p, kc = cs + (F.lane & 15), kr = rs + jrow; krow_g = b * SEQ + kr * 64 + kc;
                    bias = rpb[(kr - rr + 7) * 31 + (min(max(kc - qc, -15), 15) + 15)]; }
                else { const int ci = (lat ? p - 2 : p) * 64 + F.lane; krow_g = ML + b * CTXL + ci; }
                const f16x8* kp = (const f16x8*)(P + (size_t)krow_g * LDP + NK + h * 128);
                float d = 0.f;
#pragma unroll 4
                for (int i = 0; i < 16; ++i) { const f16x8 kv = kp[i];
#pragma unroll
                    for (int e = 0; e < 8; ++e) d += (float)kv[e] * qf[8 * i + e]; }
                sc[p] = d + bias;
            }
        }
        float mx = sc[0];
#pragma unroll
        for (int p = 1; p < 6; ++p) mx = fmaxf(mx, sc[p]);
        mx = wave_max(mx);
        float sm = 0.f;
#pragma unroll
        for (int p = 0; p < 6; ++p) { sc[p] = p < npass ? __expf(sc[p] - mx) : 0.f; sm += sc[p]; }
        sm = wave_sum(sm); const float inv = 1.0f / sm;
#pragma unroll
        for (int p = 0; p < 6; ++p) if (p < npass) pj[p * 64 + F.lane] = sc[p] * inv;
        LDS_WAIT();
        float a0 = 0.f, a1 = 0.f;
        for (int j = 0; j < npass * 64; ++j) {
            const int p = j >> 6, l = j & 63; int krow_g;
            if (lat && p < 2) { const int jrow = (l >> 4) + 4 * p, kc = cs + (l & 15); krow_g = b * SEQ + (rs + jrow) * 64 + kc; }
            else krow_g = ML + b * CTXL + (lat ? p - 2 : p) * 64 + l;
            const f16x2 vv = *(const f16x2*)(P + (size_t)krow_g * LDP + NV + h * 128 + 2 * F.lane);
            const float pv = pj[j]; a0 += pv * (float)vv[0]; a1 += pv * (float)vv[1];
        }
        *(unsigned*)(Y + (size_t)rowq * BW + h * 128 + 2 * F.lane) = pk_f16(a0, a1);
        LDS_WAIT();
    }
}

__device__ __forceinline__ void mlstm_unit(Frame& F, int li, int unit, bool ctx_out) {
    const int vs = unit & 7, dir = (unit >> 3) & 1, h = (unit >> 4) & 3, b = unit >> 6;
    LAS float* Cs = (LAS float*)F.lds;
    LAS float* ns = Cs + 32 * 257;
    LAS float* Vs = ns + 256;
    LAS float* Ss = Vs + 64 * 33;
    LAS float* cum = Ss + 64 * 65;
    LAS float* mrow = cum + 64; LAS float* ig = mrow + 64; LAS float* lf = ig + 64; LAS float* inter = lf + 64; LAS float* wst = inter + 64; LAS float* den = wst + 64; LAS float* misc = den + 64;
    LAS f16* Qs = (LAS f16*)(misc + 64);
    LAS f16* Ks = Qs + 64 * 264;
    const f16* P = WSP(f16, WS_P); const float* G = WSP(float, WS_G); float* HMD = WSP(float, WS_HMD) + (size_t)dir * MT * BW;
    const float bi_ = inp(14)[(li * 2 + dir) * 4 + h], bf_ = inp(15)[(li * 2 + dir) * 4 + h];
    for (int i = F.tid; i < 32 * 257 + 256; i += 512) Cs[i] = 0.f;
    if (F.tid == 0) misc[0] = -INFINITY;
    __syncthreads();
    for (int j = 0; j < 36; ++j) {
        const bool isctx = j < 4; const int base = isctx ? ML + b * CTXL : b * SEQ, len = isctx ? CTXL : SEQ, off = isctx ? j * 64 : (j - 4) * 64;
#define MROW(s) (base + (dir ? len - 1 - (off + (s)) : off + (s)))
        for (int i = F.tid; i < 2048; i += 512) { const int s = i >> 5, c8 = i & 31; const size_t ro = (size_t)MROW(s) * LDP + h * 256 + c8 * 8;
            *(LAS f16x8*)(Qs + s * 264 + c8 * 8) = *(const f16x8*)(P + ro + PQ); *(LAS f16x8*)(Ks + s * 264 + c8 * 8) = *(const f16x8*)(P + ro + PK); }
        if (F.tid < 256) { const int s = F.tid >> 2, c8 = F.tid & 3; const f16x8 v = *(const f16x8*)(P + (size_t)MROW(s) * LDP + PV + h * 256 + vs * 32 + c8 * 8);
#pragma unroll
            for (int e = 0; e < 8; ++e) Vs[s * 33 + c8 * 8 + e] = (float)v[e]; }
        if (F.tid < 64) { const int row = MROW(F.tid); ig[F.tid] = G[(size_t)row * 16 + dir * 8 + h] + bi_; const float fp = G[(size_t)row * 16 + dir * 8 + 4 + h] + bf_;
            lf[F.tid] = fminf(fp, 0.f) - log1pf(expf(-fabsf(fp))); }
        __syncthreads();
        if (F.tid == 0) { const float mp = misc[0]; float c = 0.f, R = mp;
            for (int s = 0; s < 64; ++s) { c += lf[s]; cum[s] = c; R = fmaxf(R, ig[s] - c); mrow[s] = c + R; inter[s] = expf(c + mp - (c + R)); }
            const float mn = mrow[63], cl = cum[63];
            for (int s = 0; s < 64; ++s) wst[s] = expf(cl - cum[s] + ig[s] - mn);
            misc[1] = expf(cl + mp - mn); misc[0] = mn; }
        __syncthreads();
        const bool need_out = !isctx || ctx_out;
        if (need_out) {
            for (int i = F.tid; i < 4096; i += 512) { const int t = i >> 6, s = i & 63; float v = 0.f;
                if (s <= t) { float d = 0.f;
#pragma unroll 8
                    for (int k = 0; k < 256; ++k) d += (float)Qs[t * 264 + k] * (float)Ks[s * 264 + k];
                    v = d * expf(cum[t] - cum[s] + ig[s] - mrow[t]); }
                Ss[t * 65 + s] = v; }
            __syncthreads();
            float num[4];
#pragma unroll
            for (int q = 0; q < 4; ++q) { const int i = q * 512 + F.tid, t = i >> 5, v = i & 31; float a = 0.f, bs = 0.f;
#pragma unroll 8
                for (int k = 0; k < 256; ++k) a += Cs[v * 257 + k] * (float)Qs[t * 264 + k];
#pragma unroll 8
                for (int s = 0; s < 64; ++s) bs += Ss[t * 65 + s] * Vs[s * 33 + v];
                num[q] = inter[t] * a + bs; }
            if (F.tid < 64) { const int t = F.tid; float a = 0.f, bs = 0.f;
                for (int k = 0; k < 256; ++k) a += ns[k] * (float)Qs[t * 264 + k];
                for (int s = 0; s < 64; ++s) bs += Ss[t * 65 + s];
                den[t] = inter[t] * a + bs; }
            __syncthreads();
#pragma unroll
            for (int q = 0; q < 4; ++q) { const int i = q * 512 + F.tid, t = i >> 5, v = i & 31;
                HMD[(size_t)MROW(t) * BW + h * 256 + vs * 32 + v] = num[q] / fmaxf(fabsf(den[t]), expf(-mrow[t])); }
        }
        __syncthreads();
        { const float decay = misc[1];
          for (int i = F.tid; i < 8192; i += 512) { const int v = i >> 8, k = i & 255; float a = 0.f;
#pragma unroll 8
              for (int s = 0; s < 64; ++s) a += wst[s] * Vs[s * 33 + v] * (float)Ks[s * 264 + k];
              Cs[v * 257 + k] = decay * Cs[v * 257 + k] + a; }
          if (F.tid < 256) { const int k = F.tid; float a = 0.f;
              for (int s = 0; s < 64; ++s) a += wst[s] * (float)Ks[s * 264 + k];
              ns[k] = decay * ns[k] + a; } }
        __syncthreads();
#undef MROW
    }
}

__device__ __forceinline__ void phase_finish(int li_v) {
    Frame F = make_frame(); const int li = UNI(li_v); const int M = li == DEPTH - 1 ? ML : MT;
    const int gw = F.bid * 8 + F.wave, NGW = F.G * 8;
    const f16* P = WSP(f16, WS_P); const float* HMD = WSP(float, WS_HMD); const float* HL = WSP(float, WS_HL); f16* Y = WSP(f16, WS_Y);
    const float* gn = inp(16) + (size_t)li * BW;
    for (int row = gw; row < M; row += NGW) {
#pragma unroll
        for (int hh = 0; hh < 4; ++hh) { const int c = hh * 256 + 4 * F.lane;
            const f32x4 a = *(const f32x4*)(HMD + (size_t)row * BW + c), bq = *(const f32x4*)(HMD + ((size_t)MT + row) * BW + c);
            const f32x4 s = a + bq; const float ss = wave_sum((s.x * s.x + s.y * s.y) + (s.z * s.z + s.w * s.w));
            const float rstd = rsqrtf(ss * (1.0f / 256.0f) + EPS);
            const f16x4 og = *(const f16x4*)(P + (size_t)row * LDP + PO + c); const f32x4 g = *(const f32x4*)(gn + c);
            u32x2 w; w.x = pk_f16((float)og[0] * s.x * rstd * g.x, (float)og[1] * s.y * rstd * g.y); w.y = pk_f16((float)og[2] * s.z * rstd * g.z, (float)og[3] * s.w * rstd * g.w);
            *(u32x2*)(Y + (size_t)row * BW + c) = w; }
#pragma unroll
        for (int hh = 0; hh < 4; ++hh) { const int c = hh * 256 + 4 * F.lane;
            const f32x4 a = *(const f32x4*)(HL + (size_t)row * BW + c), bq = *(const f32x4*)(HL + ((size_t)MT + row) * BW + c);
            const f16x4 gg = *(const f16x4*)(P + (size_t)row * LDP + LG + c);
            u32x2 w; w.x = pk_f16((a.x + bq.x) * (float)gg[0], (a.y + bq.y) * (float)gg[1]); w.y = pk_f16((a.z + bq.z) * (float)gg[2], (a.w + bq.w) * (float)gg[3]);
            *(u32x2*)(Y + ((size_t)2 * MT + row) * BW + c) = w; }
    }
}

constexpr int NPL = 13, PH_FINAL = 1 + DEPTH * NPL, NPHASE = PH_FINAL + 1;
__device__ __forceinline__ void ph_gemm_swiglu(int li_v, int which_v) {
    Frame F = make_frame(); const int li = UNI(li_v), which = UNI(which_v);
    unsigned char* wl = F.ws + WS_W + (size_t)li * WL_SIZE; const int M = (which == 1 && li == DEPTH - 1) ? ML : MT;
    pg8::Gemm g{WSP(f16, WS_H), (const f16*)(wl + (which ? WL_W3 : WL_W1)), M, 2 * DFF, D}; pg8::StaticOrder S; S.init(M, 2 * DFF, F.G, F.bid);
    EpiSwiGLU E{WSP(f16, WS_P)}; pg8::gemm_phase<EpiSwiGLU, pg8::StaticOrder, true, true>(F.lds, g, S, E, F.tid);
}
__device__ __forceinline__ void ph_gemm_resid(int li_v, int which_v) {
    Frame F = make_frame(); const int li = UNI(li_v), which = UNI(which_v);
    unsigned char* wl = F.ws + WS_W + (size_t)li * WL_SIZE; const int M = (which >= 1 && li == DEPTH - 1) ? ML : MT;
    const float* modl = WSP(float, WS_MOD) + (size_t)li * 5 * NMODC + (2 + 3 * which) * D;
    const f16* A = which == 1 ? WSP(f16, WS_MH) : WSP(f16, WS_P); const f16* Bt = (const f16*)(wl + (which == 0 ? WL_W2 : which == 1 ? WL_WOUT : WL_W4));
    const int K = which == 1 ? D : DFF;
    pg8::Gemm g{A, Bt, M, D, K}; pg8::StaticOrder S; S.init(M, D, F.G, F.bid);
    EpiResid E{WSP(float, WS_X), modl, which == 1 ? 1.0f : 0.5f}; pg8::gemm_phase<EpiResid, pg8::StaticOrder, true, true>(F.lds, g, S, E, F.tid);
}
__device__ __forceinline__ void ph_gemm_proj(int li_v) {
    Frame F = make_frame(); const int li = UNI(li_v);
    unsigned char* wl = F.ws + WS_W + (size_t)li * WL_SIZE;
    pg8::Gemm g{WSP(f16, WS_H), (const f16*)(wl + WL_WIN), MT, NPIN, D}; pg8::StaticOrder S; S.init(MT, NPIN, F.G, F.bid);
    EpiProj E{WSP(f16, WS_P), WSP(float, WS_G), WSP(float, WS_ROPE)}; pg8::gemm_phase<EpiProj, pg8::StaticOrder, true, true>(F.lds, g, S, E, F.tid);
}
template <int MODE> __device__ __forceinline__ void ph_gemm_gate(int li_v) {
    Frame F = make_frame(); const int li = UNI(li_v);
    unsigned char* wl = F.ws + WS_W + (size_t)li * WL_SIZE; const int M = li == DEPTH - 1 ? ML : MT;
    const f16* Y = WSP(f16, WS_Y) + (size_t)MODE * MT * BW; const f16* wbr = (const f16*)(wl + WL_WBR) + (size_t)MODE * D * BW; const f16* gate = WSP(f16, WS_P) + GX + MODE * D;
    pg8::Gemm g{Y, wbr, M, D, BW}; pg8::StaticOrder S; S.init(M, D, F.G, F.bid);
    EpiGate<MODE> E{gate, WSP(float, WS_MF), WSP(f16, WS_MH)}; pg8::gemm_phase<EpiGate<MODE>, pg8::StaticOrder, true, true>(F.lds, g, S, E, F.tid);
}
__device__ __forceinline__ void ph_mixers(int li_v) {
    Frame F = make_frame(); const int li = UNI(li_v); const bool last = li == DEPTH - 1;
    for (int u = F.bid; u < 256; u += F.G) { mlstm_unit(F, li, u, !last); __syncthreads(); }
    const int nna = last ? 1024 : 1152;
    for (int u = F.bid; u < nna; u += F.G) na_unit(F, li, u);
    for (int u = F.bid; u < 16; u += F.G) lru_scan_item(F, u);
}

__global__ void __launch_bounds__(512, 2) mega_fwd(Args args) {
    LAS unsigned char* lds = (LAS unsigned char*)lds_raw;
    const int tid = threadIdx.x;
    volatile LAS unsigned* MISC = (volatile LAS unsigned*)(lds + LDS_MISC);
    if (tid < 64) MISC[tid] = 0u;
    __syncthreads();
    unsigned* barw = (unsigned*)(args.ws + WS_CTL) + 4096;
    XcdBarrier bar; bar.bar = barw; bar.x = 0; bar.st = nullptr;
    const int lo = args.ph_lo, hi = args.ph_hi;
    if (hi - lo > 1) bar = xcd_barrier_post(barw, MISC + 8);
#define IN(k) (lo <= (k) && (k) < hi && ((PHSEL >> ((k) == 0 ? 16 : (k) == PH_FINAL ? 17 : ((k) - 1) % NPL)) & 1))
#define SEAM(k) do { if (lo <= (k) && (k) + 1 < hi) xcd_barrier(bar); } while (0)
    if (IN(0)) phase_prologue();
    SEAM(0);
#pragma unroll 1
    for (int li = 0; li < DEPTH; ++li) {
        const int p0 = 1 + li * NPL;
        if (IN(p0 + 0)) phase_adaln(li, 0);
        SEAM(p0 + 0);
        if (IN(p0 + 1)) ph_gemm_swiglu(li, 0);
        SEAM(p0 + 1);
        if (IN(p0 + 2)) ph_gemm_resid(li, 0);
        SEAM(p0 + 2);
        if (IN(p0 + 3)) phase_adaln(li, 1);
        SEAM(p0 + 3);
        if (IN(p0 + 4)) ph_gemm_proj(li);
        SEAM(p0 + 4);
        if (IN(p0 + 5)) phase_lru_a(li);
        SEAM(p0 + 5);
        if (IN(p0 + 6)) ph_mixers(li);
        SEAM(p0 + 6);
        if (IN(p0 + 7)) phase_finish(li);
        SEAM(p0 + 7);
        if (IN(p0 + 8)) { ph_gemm_gate<0>(li); ph_gemm_gate<1>(li); ph_gemm_gate<2>(li); }
        SEAM(p0 + 8);
        if (IN(p0 + 9)) ph_gemm_resid(li, 1);
        SEAM(p0 + 9);
        if (IN(p0 + 10)) phase_adaln(li, 2);
        SEAM(p0 + 10);
        if (IN(p0 + 11)) ph_gemm_swiglu(li, 1);
        SEAM(p0 + 11);
        if (IN(p0 + 12)) ph_gemm_resid(li, 2);
        SEAM(p0 + 12);
    }
    if (IN(PH_FINAL)) phase_final();
#undef IN
#undef SEAM
}

extern "C" void kernel_launch(void* const* d_in, const int* in_sizes, int n_in, void* d_out, int out_size, void* d_ws, size_t ws_size, hipStream_t stream) {
    static int grid = 0;
    if (grid == 0) {
        if (n_in != 28 || ws_size < WS_END) { fprintf(stderr, "kernel_launch: unexpected n_in %d or ws_size %zu (< %zu)\n", n_in, ws_size, (size_t)WS_END); grid = -1; return; }
        int dev = 0, cus = 0, per_cu = 0;
        if (hipGetDevice(&dev) != hipSuccess || hipDeviceGetAttribute(&cus, hipDeviceAttributeMultiprocessorCount, dev) != hipSuccess) { grid = -1; return; }
        if (hipFuncSetAttribute((const void*)mega_fwd, hipFuncAttributeMaxDynamicSharedMemorySize, LDS_BYTES) != hipSuccess) { fprintf(stderr, "kernel_launch: hipFuncSetAttribute failed\n"); grid = -1; return; }
        if (hipOccupancyMaxActiveBlocksPerMultiprocessor(&per_cu, (const void*)mega_fwd, 512, LDS_BYTES) != hipSuccess || per_cu < 1) fprintf(stderr, "kernel_launch: occupancy query says %d\n", per_cu);
        (void)hipGetLastError();
        grid = cus;
    }
    if (grid < 0) return;
    (void)hipMemsetAsync((char*)d_ws + WS_CTL, 0, 1 * MiB, stream);
    Args a{};
    for (int i = 0; i < 28; ++i) a.in[i] = (const float*)d_in[i];
    a.out = (float*)d_out; a.ws = (unsigned char*)d_ws;
#if MK_ONE_LAUNCH
    a.ph_lo = 0; a.ph_hi = NPHASE;
    hipLaunchKernelGGL(mega_fwd, dim3(grid), dim3(512), LDS_BYTES, stream, a);
#else
    for (int p = 0; p < NPHASE; ++p) { a.ph_lo = p; a.ph_hi = p + 1; hipLaunchKernelGGL(mega_fwd, dim3(grid), dim3(512), LDS_BYTES, stream, a); }
#endif
}
```

```cpp
#include <hip/hip_runtime.h>
#include <cstdio>
#include <cstdint>

#define LAS __attribute__((address_space(3)))
typedef _Float16 f16;
typedef _Float16 f16x8 __attribute__((ext_vector_type(8)));
typedef _Float16 f16x4 __attribute__((ext_vector_type(4)));
typedef _Float16 f16x2 __attribute__((ext_vector_type(2)));
typedef float f32x4 __attribute__((ext_vector_type(4)));
typedef float f32x2 __attribute__((ext_vector_type(2)));
typedef unsigned u32x4 __attribute__((ext_vector_type(4)));
typedef unsigned u32x2 __attribute__((ext_vector_type(2)));

#ifndef PHSEL
#define PHSEL 0xFFFFF
#endif
#ifndef MK_ONE_LAUNCH
#define MK_ONE_LAUNCH 1
#endif

constexpr int D = 2048, NB = 4, SEQ = 2048, CTXL = 256, DEPTH = 2, DFF = 5632, BW = 1024;
constexpr int ML = NB * SEQ, MC = NB * CTXL, MT = ML + MC;
constexpr int NMODC = 9 * D;
constexpr int PIN_SRC = 15376;
constexpr int NPIN = 15616;
constexpr int LDP = 15360;
constexpr int PQ = 0, PK = 1024, PV = 2048, PO = 3072, NQ = 4096, NK = 5120, NV = 6144, LX = 7168, LG = 8192, GX = 9216;
constexpr float EPS = 1e-6f;

constexpr size_t MiB = 1u << 20;
constexpr size_t WS_CTL = 0;
constexpr size_t WS_MOD = 1 * MiB;
constexpr size_t WS_ROPE = 2 * MiB;
constexpr size_t WS_G = 3 * MiB;
constexpr size_t WS_W = 4 * MiB;
constexpr size_t WL_W1 = 0, WL_W2 = 44 * MiB, WL_W3 = 66 * MiB, WL_W4 = 110 * MiB, WL_WIN = 132 * MiB, WL_WBR = 193 * MiB, WL_WOUT = 205 * MiB, WL_SIZE = 213 * MiB;
constexpr size_t WS_X = WS_W + 2 * WL_SIZE;
constexpr size_t WS_H = WS_X + 72 * MiB;
constexpr size_t WS_P = WS_H + 36 * MiB;
constexpr size_t WS_Y = WS_P + 270 * MiB;
constexpr size_t WS_HMD = WS_Y + 54 * MiB;
constexpr size_t WS_LA = WS_HMD + 72 * MiB;
constexpr size_t WS_LU = WS_LA + 72 * MiB;
constexpr size_t WS_HL = WS_LU + 72 * MiB;
constexpr size_t WS_MF = WS_LA;
constexpr size_t WS_MH = WS_LU;
constexpr size_t WS_WLRU = WS_HL + 72 * MiB;
constexpr size_t WS_LSUM = WS_WLRU + 2 * MiB;
constexpr size_t WS_GS = WS_LSUM + 3 * MiB;
constexpr size_t WS_END = WS_GS + 2 * MiB;

constexpr int LDS_BYTES = 147456;
constexpr int LDS_MISC = 147200;

__device__ __forceinline__ unsigned pk_f16(float lo, float hi) { f32x2 v = {lo, hi}; f16x2 h = __builtin_convertvector(v, f16x2); return __builtin_bit_cast(unsigned, h); }
__device__ __forceinline__ float wave_sum(float v) {
#pragma unroll
    for (int o = 1; o < 64; o <<= 1) v += __shfl_xor(v, o);
    return v;
}
__device__ __forceinline__ float wave_max(float v) {
#pragma unroll
    for (int o = 1; o < 64; o <<= 1) v = fmaxf(v, __shfl_xor(v, o));
    return v;
}
__device__ __forceinline__ float sigmoidf_(float x) { return 1.0f / (1.0f + __expf(-x)); }
__device__ __forceinline__ float siluf_(float x) { return x / (1.0f + __expf(-x)); }
__device__ __forceinline__ float gelu_tanh_(float x) { const float z = 0.7978845608028654f * (x + 0.044715f * x * x * x); const float e = __expf(2.0f * z); return 0.5f * x * (1.0f + (1.0f - 2.0f / (e + 1.0f))); }
#define LDS_WAIT() asm volatile("s_waitcnt lgkmcnt(0)" ::: "memory")
__device__ __forceinline__ f32x4 mfma16(f16x8 a, f16x8 b, f32x4 c) { return __builtin_amdgcn_mfma_f32_16x16x32_f16(a, b, c, 0, 0, 0); }

typedef __fp16 fp16x4v __attribute__((__vector_size__(8)));
__device__ __forceinline__ f16x4 lds_tr4(const LAS f16* p) { return __builtin_bit_cast(f16x4, __builtin_amdgcn_ds_read_tr16_b64_v4f16((LAS fp16x4v*)p)); }

#define XB_TMO      128
#define XB_XCNT(j)  (256  + 64 * (j))
#define XB_XSUB(j)  (1280 + 64 * (j))
#define XB_XGEN(j)  (2304 + 64 * (j))
#define XB_TOP      3328
#define XB_TOPGEN   3392
#define XCD_BAR_WORDS 3456
#define XB_SPIN_CAP (1u << 25)
__device__ __forceinline__ unsigned xb_ld(unsigned* p)              { return __hip_atomic_load(p, __ATOMIC_RELAXED, __HIP_MEMORY_SCOPE_AGENT); }
__device__ __forceinline__ unsigned xb_add(unsigned* p, unsigned v) { return __hip_atomic_fetch_add(p, v, __ATOMIC_RELAXED, __HIP_MEMORY_SCOPE_AGENT); }
__device__ __forceinline__ unsigned xb_xcc_id() { return (unsigned)__builtin_amdgcn_s_getreg((3 << 11) | 20) & 0xFu; }
#define XB_SPIN(cond, bar) do { unsigned _sp = 0; while (cond) { __builtin_amdgcn_s_sleep(1); \
    if ((++_sp & 255u) == 0u) { if (xb_ld(&(bar)[XB_TMO])) break; if (_sp > XB_SPIN_CAP) { atomicAdd(&(bar)[XB_TMO], 1u); break; } } } } while (0)
struct XcdBarrier { unsigned* bar; unsigned x; volatile LAS unsigned* st; };
__device__ __forceinline__ XcdBarrier xcd_barrier_post(unsigned* bar, volatile LAS unsigned* st) {
    XcdBarrier b; b.bar = bar; b.x = xb_xcc_id(); b.st = st;
    if (threadIdx.x == 0) (void)xb_add(&bar[XB_XCNT(b.x)], 1u);
    return b;
}
__device__ __forceinline__ void xcd_barrier_complete(unsigned* bar, unsigned x, unsigned& nloc, unsigned& nx) {
    const unsigned G = gridDim.x * gridDim.y * gridDim.z;
    unsigned sum, cnt, mine, sp = 0u;
    for (;;) {
        sum = 0u; cnt = 0u; mine = 0u;
#pragma unroll
        for (unsigned j = 0; j < 16; ++j) { const unsigned c = xb_ld(&bar[XB_XCNT(j)]); sum += c; cnt += (c > 0u) ? 1u : 0u; mine = (j == x) ? c : mine; }
        if (sum == G) break;
        __builtin_amdgcn_s_sleep(1);
        if ((++sp & 255u) == 0u) { if (xb_ld(&bar[XB_TMO])) break; if (sp > XB_SPIN_CAP) { atomicAdd(&bar[XB_TMO], 1u); break; } }
    }
    nloc = mine > 0u ? mine : 1u; nx = cnt > 0u ? cnt : 1u;
}
__device__ __forceinline__ void xcd_barrier(const XcdBarrier& b) {
    asm volatile("s_waitcnt vmcnt(0)" ::: "memory");
    __syncthreads();
    if (threadIdx.x == 0) {
        unsigned* bar = b.bar;
        __builtin_amdgcn_s_waitcnt(0);
        unsigned nloc = b.st[0], nx = b.st[1];
        if (nloc == 0u) { xcd_barrier_complete(bar, b.x, nloc, nx); b.st[0] = nloc; b.st[1] = nx; }
        const unsigned old = xb_add(&bar[XB_XSUB(b.x)], 1u);
        const unsigned gen = old / nloc;
        if (old + 1u == (gen + 1u) * nloc) {
            __builtin_amdgcn_fence(__ATOMIC_RELEASE, "agent");
            asm volatile("s_waitcnt vmcnt(0)" ::: "memory");
            const unsigned og = xb_add(&bar[XB_TOP], 1u);
            const unsigned tg = og / nx;
            if (og + 1u == (tg + 1u) * nx) xb_add(&bar[XB_TOPGEN], 1u);
            else XB_SPIN(xb_ld(&bar[XB_TOPGEN]) == tg, bar);
            __builtin_amdgcn_fence(__ATOMIC_ACQUIRE, "agent");
            xb_add(&bar[XB_XGEN(b.x)], 1u);
            asm volatile("s_waitcnt vmcnt(0)" ::: "memory");
        } else {
            XB_SPIN(xb_ld(&bar[XB_XGEN(b.x)]) == gen, bar);
            __builtin_amdgcn_fence(__ATOMIC_ACQUIRE, "agent");
            asm volatile("s_waitcnt vmcnt(0)" ::: "memory");
        }
    }
    __syncthreads();
}

namespace pg8 {
constexpr int BM = 256, BK = 64, HALF = 128, HTB = HALF * BK * 2, STAGE_BYTES = 8 * HTB, NXCD = 8, WGM = 8;
__host__ __device__ __forceinline__ int lds_byte(int r, int c) { const int st = (r >> 4) * 2 + (c >> 5), rr = r & 15, cc = c & 31, ob = rr * 64 + cc * 2; return st * 1024 + (ob ^ (((ob >> 9) & 1) << 5)); }
__host__ __device__ __forceinline__ void stage_rc(int b, int& R, int& C) { const int st = b / 1024, sb = b % 1024, swz = sb ^ (((sb >> 9) & 1) << 5); R = (st >> 1) * 16 + swz / 64; C = (st & 1) * 32 + (swz % 64) / 2; }
__host__ __device__ __forceinline__ int perm32(int rho) { const int n = rho >> 4, i = rho & 15; return 8 * (i >> 2) + 4 * n + (i & 3); }
struct Unit { int pm, pn; };
struct Gemm { const f16* A; const f16* Bt; int M, N, K; };
struct StaticOrder {
    int nM, nN, nwg, G, c;
    __host__ __device__ void init(int M, int N, int G_, int c_) { nM = M / BM; nN = N / BM; nwg = nM * nN; G = G_; c = c_; }
    __host__ __device__ bool next(int i, Unit& u) const {
        const long L = (long)i * G + c; if (L >= nwg) return false;
        int wgid = (int)L; { const int q = nwg / NXCD, r = nwg % NXCD, xcd = wgid % NXCD, off = wgid / NXCD; wgid = (xcd < r ? xcd * (q + 1) : r * (q + 1) + (xcd - r) * q) + off; }
        const int nig = WGM * nN, gid = wgid / nig, fm = gid * WGM, gsz = (nM - fm) < WGM ? (nM - fm) : WGM;
        u.pm = fm + ((wgid % nig) % gsz); u.pn = (wgid % nig) / gsz; return true;
    }
    __device__ __forceinline__ void a_ready(const Unit&) const {}
    __device__ __forceinline__ void done(const Unit&) const {}
};
template <class Epi, class Sched, bool ALIGN_EPI = false, bool SP2 = false>
__device__ __forceinline__ void gemm_phase(LAS unsigned char* lds, const Gemm g, const Sched& S, const Epi& E, const int tid) {
    const int wid = __builtin_amdgcn_readfirstlane(tid >> 6), lane = tid & 63, wr = wid >> 2, wc = wid & 3, fr = lane & 15, fq = lane >> 4;
    const int K = g.K, nt = K / BK;
    unsigned voffA[2], voffB[2];
#pragma unroll
    for (int i = 0; i < 2; ++i) { int R, C; stage_rc(tid * 16 + i * 8192, R, C); const int Rb = Epi::PERM ? ((R & ~31) + perm32(R & 31)) : R;
        voffA[i] = (unsigned)(R * K + C) * 2u; voffB[i] = (unsigned)(Rb * K + C) * 2u; }
    const size_t kstep = (size_t)(BK * 2);
    const size_t hstep = (size_t)HALF * K * 2;
    const size_t tstep = 2 * hstep;
    const unsigned ldsw = (unsigned)wid * 1024u;
    const int aoff = lds_byte(wr * 64 + fr, fq * 8), boff = lds_byte(wc * 32 + fr, fq * 8);
#define PG8_SA(b, h) (((b) * 2 + (h)) * HTB)
#define PG8_SB(b, h) ((4 + (b) * 2 + (h)) * HTB)
#define PG8_STAGE(bufoff, gbase, voff) do { _Pragma("unroll") for (int _i = 0; _i < 2; ++_i) \
        __builtin_amdgcn_global_load_lds((const unsigned*)((const char*)(gbase) + (voff)[_i]), (LAS unsigned*)(lds + (bufoff) + ldsw + _i * 8192), 16, 0, 0); } while (0)
#define PG8_LDA(dst, b, h) do { _Pragma("unroll") for (int m = 0; m < 4; ++m) _Pragma("unroll") for (int k = 0; k < 2; ++k) dst[m][k] = *(const LAS f16x8*)(lds + PG8_SA(b, h) + aoff + m * 2048 + k * 1024); } while (0)
#define PG8_LDB(dst, b, h) do { _Pragma("unroll") for (int n = 0; n < 2; ++n) _Pragma("unroll") for (int k = 0; k < 2; ++k) dst[n][k] = *(const LAS f16x8*)(lds + PG8_SB(b, h) + boff + n * 2048 + k * 1024); } while (0)
#define PG8_MMA(ai, bj, At, Bt) do { __builtin_amdgcn_s_setprio(1); _Pragma("unroll") for (int m = 0; m < 4; ++m) _Pragma("unroll") for (int n = 0; n < 2; ++n) _Pragma("unroll") for (int k = 0; k < 2; ++k) \
        acc[ai][bj][m][n] = __builtin_amdgcn_mfma_f32_16x16x32_f16(Bt[n][k], At[m][k], acc[ai][bj][m][n], 0, 0, 0); __builtin_amdgcn_s_setprio(0); } while (0)
#define PG8_WAIT_V(n) asm volatile("s_waitcnt vmcnt(" #n ")" ::: "memory")
#define PG8_WAIT_L(n) asm volatile("s_waitcnt lgkmcnt(" #n ")" ::: "memory")
#define PG8_BAR __builtin_amdgcn_s_barrier()
#define PG8_SCHED __builtin_amdgcn_sched_barrier(0)
    Unit cur, nxt; int ui = 0;
    if (!S.next(0, cur)) return;
    f32x4 acc[2][2][4][2];
#pragma unroll
    for (int a = 0; a < 2; ++a)
#pragma unroll
        for (int b = 0; b < 2; ++b)
#pragma unroll
            for (int m = 0; m < 4; ++m)
#pragma unroll
                for (int n = 0; n < 2; ++n) acc[a][b][m][n] = (f32x4){0.f, 0.f, 0.f, 0.f};
    f16x8 At[4][2], B0[2][2], B1[2][2];
    const char* cA = (const char*)g.A + (size_t)cur.pm * tstep; const char* cB = (const char*)g.Bt + (size_t)cur.pn * tstep;
    S.a_ready(cur);
    if constexpr (SP2) {
        PG8_STAGE(PG8_SB(0, 0), cB, voffB); PG8_STAGE(PG8_SB(0, 1), cB + hstep, voffB); PG8_STAGE(PG8_SA(0, 0), cA, voffA); PG8_STAGE(PG8_SA(0, 1), cA + hstep, voffA);
        if (wr == 1) PG8_BAR;
        PG8_WAIT_V(2); PG8_BAR;
        PG8_STAGE(PG8_SB(1, 0), cB + kstep, voffB); PG8_STAGE(PG8_SA(1, 0), cA + kstep, voffA); PG8_STAGE(PG8_SB(1, 1), cB + hstep + kstep, voffB);
        PG8_WAIT_V(6); PG8_BAR;
    } else {
        PG8_STAGE(PG8_SB(0, 0), cB, voffB); PG8_STAGE(PG8_SA(0, 0), cA, voffA); PG8_STAGE(PG8_SB(0, 1), cB + hstep, voffB); PG8_STAGE(PG8_SA(0, 1), cA + hstep, voffA);
        if (wr == 1) PG8_BAR;
        PG8_WAIT_V(4); PG8_BAR;
        PG8_STAGE(PG8_SB(1, 0), cB + kstep, voffB); PG8_STAGE(PG8_SA(1, 0), cA + kstep, voffA); PG8_STAGE(PG8_SB(1, 1), cB + hstep + kstep, voffB);
        PG8_WAIT_V(6); PG8_BAR;
    }
    for (;;) {
        const bool has_next = S.next(ui + 1, nxt);
        const char* nA = has_next ? (const char*)g.A + (size_t)nxt.pm * tstep : cA; const char* nB = has_next ? (const char*)g.Bt + (size_t)nxt.pn * tstep : cB;
        for (int t = 0; t < nt; t += 2) {
            const bool last = (t == nt - 2);
            const char* a1 = cA + (size_t)(t + 1) * kstep;
            const char* a2 = last ? nA : cA + (size_t)(t + 2) * kstep; const char* b2 = last ? nB : cB + (size_t)(t + 2) * kstep;
            const char* a3 = a2 + kstep; const char* b3 = b2 + kstep;
            if (last && has_next) S.a_ready(nxt);
            if constexpr (SP2) {
            PG8_LDB(B0, 0, 0); PG8_LDB(B1, 0, 1); PG8_SCHED; PG8_LDA(At, 0, 0); PG8_STAGE(PG8_SA(1, 1), a1 + hstep, voffA);
            PG8_WAIT_V(8); PG8_WAIT_L(0); PG8_BAR; PG8_MMA(0, 0, At, B0); PG8_MMA(0, 1, At, B1); PG8_BAR; PG8_SCHED;
            PG8_LDA(At, 0, 1); PG8_STAGE(PG8_SB(0, 0), b2, voffB); PG8_STAGE(PG8_SB(0, 1), b2 + hstep, voffB); PG8_STAGE(PG8_SA(0, 0), a2, voffA);
            PG8_WAIT_V(8); PG8_WAIT_L(0); PG8_BAR; PG8_MMA(1, 0, At, B0); PG8_MMA(1, 1, At, B1); PG8_BAR; PG8_SCHED;
            PG8_LDB(B0, 1, 0); PG8_LDB(B1, 1, 1); PG8_SCHED; PG8_LDA(At, 1, 0); PG8_STAGE(PG8_SA(0, 1), a2 + hstep, voffA);
            PG8_WAIT_V(8); PG8_WAIT_L(0); PG8_BAR; PG8_MMA(0, 0, At, B0); PG8_MMA(0, 1, At, B1); PG8_BAR; PG8_SCHED;
            PG8_LDA(At, 1, 1); PG8_STAGE(PG8_SB(1, 0), b3, voffB); PG8_STAGE(PG8_SB(1, 1), b3 + hstep, voffB); PG8_STAGE(PG8_SA(1, 0), a3, voffA);
            PG8_WAIT_V(8); PG8_WAIT_L(0); PG8_BAR; PG8_MMA(1, 0, At, B0); PG8_MMA(1, 1, At, B1); PG8_BAR; PG8_SCHED;
            } else {
            PG8_LDB(B0, 0, 0); PG8_SCHED; PG8_LDA(At, 0, 0); PG8_STAGE(PG8_SA(1, 1), a1 + hstep, voffA);
            PG8_WAIT_L(8); PG8_BAR; PG8_WAIT_L(0); PG8_MMA(0, 0, At, B0); PG8_BAR; PG8_SCHED;
            PG8_LDB(B1, 0, 1); PG8_STAGE(PG8_SB(0, 0), b2, voffB);
            PG8_BAR; PG8_WAIT_L(0); PG8_MMA(0, 1, At, B1); PG8_BAR;
            PG8_LDA(At, 0, 1); PG8_STAGE(PG8_SA(0, 0), a2, voffA);
            PG8_BAR; PG8_WAIT_L(0); PG8_MMA(1, 0, At, B0); PG8_BAR; PG8_SCHED;
            PG8_STAGE(PG8_SB(0, 1), b2 + hstep, voffB);
            PG8_WAIT_V(6); PG8_BAR; PG8_MMA(1, 1, At, B1); PG8_BAR;
            PG8_LDB(B0, 1, 0); PG8_SCHED; PG8_LDA(At, 1, 0); PG8_STAGE(PG8_SA(0, 1), a2 + hstep, voffA);
            PG8_WAIT_L(8); PG8_BAR; PG8_WAIT_L(0); PG8_MMA(0, 0, At, B0); PG8_BAR; PG8_SCHED;
            PG8_LDB(B1, 1, 1); PG8_STAGE(PG8_SB(1, 0), b3, voffB);
            PG8_BAR; PG8_WAIT_L(0); PG8_MMA(0, 1, At, B1); PG8_BAR;
            PG8_LDA(At, 1, 1); PG8_STAGE(PG8_SA(1, 0), a3, voffA);
            PG8_BAR; PG8_WAIT_L(0); PG8_MMA(1, 0, At, B0); PG8_BAR; PG8_SCHED;
            PG8_STAGE(PG8_SB(1, 1), b3 + hstep, voffB);
            PG8_WAIT_V(6); PG8_BAR; PG8_MMA(1, 1, At, B1); PG8_BAR;
            }
        }
        if constexpr (ALIGN_EPI) { if (wr == 0) PG8_BAR; }
        E(acc, cur, wr, wc, fr, fq); S.done(cur);
        if (!has_next) break;
#pragma unroll
        for (int a = 0; a < 2; ++a)
#pragma unroll
            for (int b = 0; b < 2; ++b)
#pragma unroll
                for (int m = 0; m < 4; ++m)
#pragma unroll
                    for (int n = 0; n < 2; ++n) acc[a][b][m][n] = (f32x4){0.f, 0.f, 0.f, 0.f};
        cur = nxt; cA = nA; cB = nB; ++ui;
        if constexpr (ALIGN_EPI) { if (wr == 1) PG8_BAR; }
    }
    PG8_WAIT_V(0);
    if constexpr (!ALIGN_EPI) { if (wr == 0) PG8_BAR; }
    PG8_BAR;
#undef PG8_SA
#undef PG8_SB
#undef PG8_STAGE
#undef PG8_LDA
#undef PG8_LDB
#undef PG8_MMA
#undef PG8_WAIT_V
#undef PG8_WAIT_L
#undef PG8_BAR
#undef PG8_SCHED
}
}
using pg8::Unit;
constexpr int HALF = pg8::HALF, BM = pg8::BM;

struct EpiSwiGLU {
    static constexpr bool PERM = true;
    f16* O;
    __device__ __forceinline__ void operator()(const f32x4 (&acc)[2][2][4][2], const Unit& u, int wr, int wc, int fr, int fq) const {
        asm volatile("" : "+v"(fr), "+v"(fq));
        const int row0 = u.pm * BM + wr * 64 + fr, col0 = u.pn * HALF + wc * 32 + 8 * fq;
#pragma unroll
        for (int ai = 0; ai < 2; ++ai)
#pragma unroll
            for (int m = 0; m < 4; ++m) {
                f16* rowp = O + (size_t)(row0 + ai * HALF + m * 16) * DFF + col0;
                const f32x4 g0 = acc[ai][0][m][0], g1 = acc[ai][0][m][1], u0 = acc[ai][1][m][0], u1 = acc[ai][1][m][1];
                u32x4 w;
                w.x = pk_f16(siluf_(g0[0]) * u0[0], siluf_(g0[1]) * u0[1]); w.y = pk_f16(siluf_(g0[2]) * u0[2], siluf_(g0[3]) * u0[3]);
                w.z = pk_f16(siluf_(g1[0]) * u1[0], siluf_(g1[1]) * u1[1]); w.w = pk_f16(siluf_(g1[2]) * u1[2], siluf_(g1[3]) * u1[3]);
                *(u32x4*)rowp = w;
            }
    }
};
struct EpiResid {
    static constexpr bool PERM = false;
    float* X; const float* modg;
    float coef; const float* XinL; const float* XinC;
    __device__ __forceinline__ void operator()(const f32x4 (&acc)[2][2][4][2], const Unit& u, int wr, int wc, int fr, int fq) const {
        asm volatile("" : "+v"(fr), "+v"(fq));
        const int row0 = u.pm * BM + wr * 64 + fr, col0 = u.pn * BM + wc * 32 + 4 * fq;
        const int bidx = u.pm < 32 ? (u.pm >> 3) : 4;
        const float* gp = modg + (size_t)bidx * NMODC + col0;
        f32x4 gv[2][2];
#pragma unroll
        for (int bj = 0; bj < 2; ++bj)
#pragma unroll
            for (int n = 0; n < 2; ++n) gv[bj][n] = *(const f32x4*)(gp + bj * HALF + n * 16) * coef;
#pragma unroll
        for (int ai = 0; ai < 2; ++ai)
#pragma unroll
            for (int m = 0; m < 4; ++m) { const size_t ro = (size_t)(row0 + ai * HALF + m * 16) * D + col0; float* rowp = X + ro; const float* inp_ = (u.pm < 32 ? XinL : XinC) + ro;
#pragma unroll
                for (int bj = 0; bj < 2; ++bj)
#pragma unroll
                    for (int n = 0; n < 2; ++n) { *(f32x4*)(rowp + bj * HALF + n * 16) = *(const f32x4*)(inp_ + bj * HALF + n * 16) + gv[bj][n] * acc[ai][bj][m][n]; } }
    }
};
struct EpiProj {
    static constexpr bool PERM = true;
    f16* P; float* G; const float* rope;
    __device__ __forceinline__ void operator()(const f32x4 (&acc)[2][2][4][2], const Unit& u, int wr, int wc, int fr, int fq) const {
        asm volatile("" : "+v"(fr), "+v"(fq));
        const int row0 = u.pm * BM + wr * 64 + fr; const int pn = u.pn;
        if (pn == 60) {
            if (wc == 0 && fq < 2) {
#pragma unroll
                for (int ai = 0; ai < 2; ++ai)
#pragma unroll
                    for (int m = 0; m < 4; ++m) { float* gp = G + (size_t)(row0 + ai * HALF + m * 16) * 16 + 8 * fq;
                        *(f32x4*)gp = acc[ai][0][m][0]; *(f32x4*)(gp + 4) = acc[ai][0][m][1]; }
            }
            return;
        }
        const int col0 = pn * BM + wc * 32 + 8 * fq;
        int mode = 0; float scl = 1.0f;
        if (pn < 8) { mode = (u.pm < 32) ? 1 : 2; scl = (pn >= 4) ? 0.0625f : 1.0f; }
        else if (pn >= 12 && pn < 16) mode = 3;
        else if (pn >= 16 && pn < 20) { mode = 2; scl = 0.08838834764831845f; }
        else if (pn >= 32 && pn < 36) mode = 4;
        else if (pn >= 36) mode = 3;
#pragma unroll
        for (int ai = 0; ai < 2; ++ai)
#pragma unroll
            for (int m = 0; m < 4; ++m) {
                const int row = row0 + ai * HALF + m * 16;
                f16* rowp = P + (size_t)row * LDP + col0;
#pragma unroll
                for (int bj = 0; bj < 2; ++bj) {
                    f32x4 v0 = acc[ai][bj][m][0], v1 = acc[ai][bj][m][1];
                    if (mode == 1) {
                        const int t = row & (SEQ - 1); const int pos = bj == 0 ? (t >> 6) : (t & 63);
                        const float* cp = rope + pos * 64 + 16 * wc + 4 * fq;
                        const f32x4 c = *(const f32x4*)cp, s = *(const f32x4*)(cp + 4096);
                        f32x4 o0, o1;
                        o0[0] = v0[0] * c[0] - v0[1] * s[0]; o0[1] = v0[0] * s[0] + v0[1] * c[0];
                        o0[2] = v0[2] * c[1] - v0[3] * s[1]; o0[3] = v0[2] * s[1] + v0[3] * c[1];
                        o1[0] = v1[0] * c[2] - v1[1] * s[2]; o1[1] = v1[0] * s[2] + v1[1] * c[2];
                        o1[2] = v1[2] * c[3] - v1[3] * s[3]; o1[3] = v1[2] * s[3] + v1[3] * c[3];
                        v0 = o0 * scl; v1 = o1 * scl;
                    } else if (mode == 2) { v0 = v0 * scl; v1 = v1 * scl; }
                    else if (mode == 3) {
#pragma unroll
                        for (int e = 0; e < 4; ++e) { v0[e] = sigmoidf_(v0[e]); v1[e] = sigmoidf_(v1[e]); }
                    } else if (mode == 4) {
#pragma unroll
                        for (int e = 0; e < 4; ++e) { v0[e] = gelu_tanh_(v0[e]); v1[e] = gelu_tanh_(v1[e]); }
                    }
                    u32x4 w; w.x = pk_f16(v0[0], v0[1]); w.y = pk_f16(v0[2], v0[3]); w.z = pk_f16(v1[0], v1[1]); w.w = pk_f16(v1[2], v1[3]);
                    *(u32x4*)(rowp + bj * HALF) = w;
                }
            }
    }
};
template <int MODE> struct EpiGate {
    static constexpr bool PERM = true;
    const f16* gate;
    float* MF; f16* MH;
    __device__ __forceinline__ void operator()(const f32x4 (&acc)[2][2][4][2], const Unit& u, int wr, int wc, int fr, int fq) const {
        asm volatile("" : "+v"(fr), "+v"(fq));
        const int row0 = u.pm * BM + wr * 64 + fr, col0 = u.pn * BM + wc * 32 + 8 * fq;
#pragma unroll
        for (int ai = 0; ai < 2; ++ai)
#pragma unroll
            for (int m = 0; m < 4; ++m) {
                const int row = row0 + ai * HALF + m * 16;
#pragma unroll
                for (int bj = 0; bj < 2; ++bj) {
                    const f16x8 gh = *(const f16x8*)(gate + (size_t)row * LDP + col0 + bj * HALF);
                    float* mp = MF + (size_t)row * D + col0 + bj * HALF;
                    f32x4 v0 = acc[ai][bj][m][0], v1 = acc[ai][bj][m][1];
#pragma unroll
                    for (int e = 0; e < 4; ++e) { v0[e] *= (float)gh[e]; v1[e] *= (float)gh[4 + e]; }
                    if (MODE >= 1) { v0 = v0 + *(const f32x4*)mp; v1 = v1 + *(const f32x4*)(mp + 4); }
                    if (MODE <= 1) { *(f32x4*)mp = v0; *(f32x4*)(mp + 4) = v1; }
                    else { u32x4 w; w.x = pk_f16(v0[0], v0[1]); w.y = pk_f16(v0[2], v0[3]); w.z = pk_f16(v1[0], v1[1]); w.w = pk_f16(v1[2], v1[3]);
                        *(u32x4*)(MH + (size_t)row * D + col0 + bj * HALF) = w; }
                }
            }
    }
};

struct Args { const float* in[28]; float* out; unsigned char* ws; int ph_lo, ph_hi; };
struct Frame {
    LAS unsigned char* lds; int tid, lane, wave, G, bid;
    float* out; unsigned char* ws;
};
typedef const Args __attribute__((address_space(4)))* KArgs;
__device__ __forceinline__ KArgs kargs() { return (KArgs)__builtin_amdgcn_kernarg_segment_ptr(); }
__device__ __forceinline__ const float* inp(int k) { return kargs()->in[k]; }
extern __shared__ __attribute__((aligned(16))) unsigned char lds_raw[];
__device__ __forceinline__ Frame make_frame() {
    Frame F; F.lds = (LAS unsigned char*)lds_raw; int t = threadIdx.x; asm volatile("" : "+v"(t));
    F.tid = t; F.lane = F.tid & 63; F.wave = __builtin_amdgcn_readfirstlane(F.tid >> 6);
    int g = gridDim.x, b = blockIdx.x; asm volatile("" : "+s"(g), "+s"(b)); F.G = g; F.bid = b;
    KArgs ka = kargs(); asm volatile("" : "+s"(ka)); F.out = ka->out; F.ws = ka->ws; return F;
}
#define UNI(x) __builtin_amdgcn_readfirstlane(x)
#define WSP(T, off) ((T*)(F.ws + (off)))

__device__ __forceinline__ void transpose_item(const float* W, int ldw, int k0, int srccol, f16* WT, int Kdim, int drow0, LAS float* scr, int lane) {
#pragma unroll 8
    for (int i = 0; i < 32; ++i) { const int kk = 2 * i + (lane >> 5); scr[kk * 33 + (lane & 31)] = srccol >= 0 ? W[(size_t)(k0 + kk) * ldw + srccol] : 0.0f; }
    LDS_WAIT();
    const int c = lane & 7;
#pragma unroll
    for (int j = 0; j < 4; ++j) { const int n = (lane >> 3) + 8 * j; const LAS float* s = scr + (8 * c) * 33 + n;
        u32x4 o; o.x = pk_f16(s[0 * 33], s[1 * 33]); o.y = pk_f16(s[2 * 33], s[3 * 33]); o.z = pk_f16(s[4 * 33], s[5 * 33]); o.w = pk_f16(s[6 * 33], s[7 * 33]);
        *(u32x4*)(WT + (size_t)(drow0 + n) * Kdim + k0 + 8 * c) = o; }
    LDS_WAIT();
}
__device__ __forceinline__ int win_src(int dr) {
    if (dr < 2048) { const int base = dr < 1024 ? 0 : 1024, w = dr & 1023, h = w >> 8, x = w & 255, bj = x >> 7, within = x & 127, i = within >> 1, e = within & 1; return base + h * 256 + bj * 128 + e * 64 + i; }
    if (dr < 4096) return dr;
    if (dr < 15360) return dr + 16;
    const int w = dr - 15360; return w < 16 ? 4096 + w : -1;
}
template <int MAP> __device__ __forceinline__ int dest_row(int c) {
    if (MAP == 0) return c;
    if (MAP == 1) { const int bj = c >= DFF ? 1 : 0, j = c - bj * DFF; return (j >> 7) * 256 + bj * 128 + (j & 127); }
    if (c < 2048) { const int base = c & 1024, x = c & 255, hh = (c >> 8) & 3, bj = x >> 7, within = x & 127, e = within >> 6, i = within & 63; return base + hh * 256 + bj * 128 + 2 * i + e; }
    if (c < 4096) return c;
    if (c < 4112) return 15360 + (c - 4096);
    return c - 16;
}
template <int MAP> __device__ __forceinline__ void transpose_item2(const float* W, int ldw, int k0, int c0, f16* WT, int Kdim, LAS float* scr, int lane) {
    const int col4 = (lane & 7) * 4; const bool cv = c0 + col4 < ldw;
    f32x4 v[8];
#pragma unroll
    for (int it = 0; it < 8; ++it) { const int r = it * 8 + (lane >> 3); v[it] = cv ? *(const f32x4*)(W + (size_t)(k0 + r) * ldw + c0 + col4) : (f32x4){0.f, 0.f, 0.f, 0.f}; }
#pragma unroll
    for (int it = 0; it < 8; ++it) { const int r = it * 8 + (lane >> 3); LAS float* d = scr + r * 33 + col4; d[0] = v[it].x; d[1] = v[it].y; d[2] = v[it].z; d[3] = v[it].w; }
    LDS_WAIT();
    const int c = lane & 7;
#pragma unroll
    for (int j = 0; j < 4; ++j) { const int n = (lane >> 3) + 8 * j; const LAS float* sp = scr + (8 * c) * 33 + n;
        u32x4 o; o.x = pk_f16(sp[0 * 33], sp[1 * 33]); o.y = pk_f16(sp[2 * 33], sp[3 * 33]); o.z = pk_f16(sp[4 * 33], sp[5 * 33]); o.w = pk_f16(sp[6 * 33], sp[7 * 33]);
        if (c0 + n < ldw) *(u32x4*)(WT + (size_t)dest_row<MAP>(c0 + n) * Kdim + k0 + 8 * c) = o; }
    LDS_WAIT();
}
__device__ __forceinline__ void phase_prologue() {
    Frame F = make_frame();
    const int gw = F.bid * 8 + F.wave, NGW = F.G * 8;
    const int gt = F.bid * 512 + F.tid, NGT = F.G * 512;
    { float* rope = WSP(float, WS_ROPE);
      for (int i = gt; i < 4096; i += NGT) { const int pos = i >> 6, j = i & 63; const float inv = powf(10000.0f, -(float)j / 64.0f); const float a = (float)pos * inv; rope[i] = cosf(a); rope[4096 + i] = sinf(a); }
      for (int l = 0; l < DEPTH; ++l) { u32x4* z = (u32x4*)(F.ws + WS_W + (size_t)l * WL_SIZE + WL_WIN + (size_t)15376 * D * 2);
          for (int i = gt; i < 240 * D * 2 / 16; i += NGT) z[i] = (u32x4){0u, 0u, 0u, 0u}; } }
    LAS float* scr = (LAS float*)(F.lds + F.wave * 16384);
    LAS float* sa = (LAS float*)(F.lds + F.wave * 16384 + 8448);
    constexpr int I_MOD = DEPTH * 72 * 8;
    constexpr int I_W1 = 32 * 352, I_W2 = 88 * 64, I_WIN = 32 * 481, I_WBR = 3 * 16 * 64, I_WOUT = 32 * 64, I_LRU = 256;
    constexpr int PER_L = 2 * I_W1 + 2 * I_W2 + I_WIN + I_WBR + I_WOUT + I_LRU;
    for (int it = gw; it < I_MOD + DEPTH * PER_L; it += NGW) {
        if (it < I_MOD) {
            const int l = it / 576, r = it % 576, cg = r >> 3, kr = r & 7, n0 = cg * 256 + 4 * F.lane, k0 = kr * 256;
            for (int i = F.lane; i < 5 * 256; i += 64) { const int bi = i >> 8, k = i & 255; const float c = bi < 4 ? inp(1)[bi * D + k0 + k] : inp(3)[k0 + k]; sa[i] = siluf_(c); }
            LDS_WAIT();
            const float* Wm = inp(4) + (size_t)l * D * NMODC + (size_t)k0 * NMODC + n0;
            f32x4 acc[5];
#pragma unroll
            for (int bi = 0; bi < 5; ++bi) acc[bi] = (f32x4){0.f, 0.f, 0.f, 0.f};
#pragma unroll 8
            for (int kk = 0; kk < 256; ++kk) { const f32x4 w = __builtin_nontemporal_load((const f32x4*)(Wm + (size_t)kk * NMODC));
#pragma unroll
                for (int bi = 0; bi < 5; ++bi) acc[bi] = acc[bi] + w * sa[bi * 256 + kk]; }
            if (kr == 0) { const f32x4 bm = *(const f32x4*)(inp(5) + (size_t)l * NMODC + n0);
#pragma unroll
                for (int bi = 0; bi < 5; ++bi) acc[bi] = acc[bi] + bm; }
#pragma unroll
            for (int bi = 0; bi < 5; ++bi) { float* mp = WSP(float, WS_MOD) + ((size_t)l * 5 + bi) * NMODC + n0;
#pragma unroll
                for (int e = 0; e < 4; ++e) __hip_atomic_fetch_add(mp + e, acc[bi][e], __ATOMIC_RELAXED, __HIP_MEMORY_SCOPE_AGENT); }
            LDS_WAIT();
            continue;
        }
        const int itw = it - I_MOD; const int l = itw / PER_L; int r = itw % PER_L;
        unsigned char* wl = F.ws + WS_W + (size_t)l * WL_SIZE;
        if (r < 2 * I_W1) { const int which = r / I_W1; r %= I_W1;
            transpose_item2<1>(inp(which ? 11 : 9) + (size_t)l * D * 2 * DFF, 2 * DFF, (r / 352) * 64, (r % 352) * 32, (f16*)(wl + (which ? WL_W3 : WL_W1)), D, scr, F.lane); continue; }
        r -= 2 * I_W1;
        if (r < 2 * I_W2) { const int which = r / I_W2; r %= I_W2;
            transpose_item2<0>(inp(which ? 12 : 10) + (size_t)l * DFF * D, D, (r / 64) * 64, (r % 64) * 32, (f16*)(wl + (which ? WL_W4 : WL_W2)), DFF, scr, F.lane); continue; }
        r -= 2 * I_W2;
        if (r < I_WIN) { transpose_item2<2>(inp(13) + (size_t)l * D * PIN_SRC, PIN_SRC, (r / 481) * 64, (r % 481) * 32, (f16*)(wl + WL_WIN), D, scr, F.lane); continue; }
        r -= I_WIN;
        if (r < I_WBR) { const int n = r / 1024; r %= 1024;
            transpose_item2<0>(inp(25) + ((size_t)l * 3 + n) * BW * D, D, (r / 64) * 64, (r % 64) * 32, (f16*)(wl + WL_WBR) + (size_t)n * D * BW, BW, scr, F.lane); continue; }
        r -= I_WBR;
        if (r < I_WOUT) { transpose_item2<0>(inp(26) + (size_t)l * D * D, D, (r / 64) * 64, (r % 64) * 32, (f16*)(wl + WL_WOUT), D, scr, F.lane); continue; }
        r -= I_WOUT;
        { const int mat = r >> 7, ng = (r >> 3) & 15, kb = (r >> 2) & 1, nb = r & 3;
          transpose_item2<0>(inp(mat ? 22 : 20) + ((size_t)l * 16 + ng) * 128 * 128, 128, kb * 64, nb * 32, WSP(f16, WS_WLRU) + (((size_t)l * 2 + mat) * 16 + ng) * 128 * 128, 128, scr, F.lane); }
    }
}

__device__ __forceinline__ void phase_adaln(int li_v, int which_v) {
    Frame F = make_frame(); const int li = UNI(li_v), which = UNI(which_v);
    const float* gain = inp(6 + which) + (size_t)li * D; const int chunk_shift = 3 * which; const int M = (which == 2 && li == DEPTH - 1) ? ML : MT;
    const int gw = F.bid * 8 + F.wave, NGW = F.G * 8;
    const bool first = li == 0 && which == 0;
    const float* XL = first ? inp(0) : WSP(float, WS_X); const float* XC = first ? inp(2) - (size_t)ML * D : WSP(float, WS_X); f16* H = WSP(f16, WS_H);
    for (int row = gw; row < M; row += NGW) {
        const float* X = row < ML ? XL : XC;
        const int bidx = row < ML ? row / SEQ : 4;
        const float* modb = WSP(float, WS_MOD) + ((size_t)li * 5 + bidx) * NMODC + chunk_shift * D;
        const f32x4* xr = (const f32x4*)(X + (size_t)row * D) + F.lane;
        f32x4 v[8]; float ss = 0.f;
#pragma unroll
        for (int j = 0; j < 8; ++j) { v[j] = xr[64 * j]; ss += (v[j].x * v[j].x + v[j].y * v[j].y) + (v[j].z * v[j].z + v[j].w * v[j].w); }
        const float rstd = rsqrtf(wave_sum(ss) * (1.0f / D) + EPS);
        u32x2* o = (u32x2*)(H + (size_t)row * D) + F.lane;
#pragma unroll
        for (int j = 0; j < 8; ++j) { const int c = (64 * j + F.lane) * 4;
            const f32x4 g = *(const f32x4*)(gain + c), sh = *(const f32x4*)(modb + c), sc = *(const f32x4*)(modb + D + c);
            const f32x4 y = v[j] * rstd * g * (sc + 1.0f) + sh;
            u32x2 w; w.x = pk_f16(y.x, y.y); w.y = pk_f16(y.z, y.w); o[64 * j] = w; }
    }
}
__device__ __forceinline__ void phase_final() {
    Frame F = make_frame();
    const int gw = F.bid * 8 + F.wave, NGW = F.G * 8;
    const float* X = WSP(float, WS_X); const float* gain = inp(27);
    for (int row = gw; row < ML; row += NGW) {
        const f32x4* xr = (const f32x4*)(X + (size_t)row * D) + F.lane;
        f32x4 v[8]; float ss = 0.f;
#pragma unroll
        for (int j = 0; j < 8; ++j) { v[j] = xr[64 * j]; ss += (v[j].x * v[j].x + v[j].y * v[j].y) + (v[j].z * v[j].z + v[j].w * v[j].w); }
        const float rstd = rsqrtf(wave_sum(ss) * (1.0f / D) + EPS);
        f32x4* o = (f32x4*)(F.out + (size_t)row * D) + F.lane;
#pragma unroll
        for (int j = 0; j < 8; ++j) { const int c = (64 * j + F.lane) * 4; o[64 * j] = v[j] * rstd * *(const f32x4*)(gain + c); }
    }
}

__device__ __forceinline__ void phase_lru_a(int li_v) {
    Frame F = make_frame(); const int li = UNI(li_v);
    LAS float* xc = (LAS float*)F.lds;
    const f16* P = WSP(f16, WS_P); float* LA = WSP(float, WS_LA); float* LU = WSP(float, WS_LU);
    const float* cw = inp(18) + (size_t)li * 4 * BW; const float* cb = inp(19) + (size_t)li * BW;
    const float* wa = inp(20) + (size_t)li * 2 * 8 * 128 * 128; const float* ba = inp(21) + (size_t)li * 2 * BW;
    const float* wx = inp(22) + (size_t)li * 2 * 8 * 128 * 128; const float* bx = inp(23) + (size_t)li * 2 * BW;
    const float* lam = inp(24) + (size_t)li * 2 * BW;
    for (int it = F.bid; it < MT / 8; it += F.G) {
        const int row0 = it * 8;
        int sbeg, send; if (row0 < ML) { sbeg = (row0 / SEQ) * SEQ; send = sbeg + SEQ; } else { sbeg = ML + ((row0 - ML) / CTXL) * CTXL; send = sbeg + CTXL; }
        for (int i = F.tid; i < 8 * BW; i += 512) { const int tt = i >> 10, ch = i & 1023, row = row0 + tt;
            float y = cb[ch];
#pragma unroll
            for (int j = 0; j < 4; ++j) { const int rr = row + j - 1; if (rr >= sbeg && rr < send) y += cw[j * BW + ch] * (float)P[(size_t)rr * LDP + LX + ch]; }
            xc[i] = y; }
        __syncthreads();
#pragma unroll 1
        for (int q = 0; q < 4; ++q) {
            const int o = q * 512 + F.tid, n = o >> 10, ch = o & 1023, g = ch >> 7, j = ch & 127;
            const float* wap = wa + ((size_t)(n * 8 + g) * 128) * 128 + j; const float* wxp = wx + ((size_t)(n * 8 + g) * 128) * 128 + j;
            float aa[8], ax[8];
#pragma unroll
            for (int t = 0; t < 8; ++t) { aa[t] = 0.f; ax[t] = 0.f; }
#pragma unroll 4
            for (int i = 0; i < 128; ++i) { const float w1 = wap[i * 128], w2 = wxp[i * 128];
#pragma unroll
                for (int t = 0; t < 8; ++t) { const float xv = xc[t * 1024 + g * 128 + i]; aa[t] += xv * w1; ax[t] += xv * w2; } }
            const float bav = ba[n * BW + ch], bxv = bx[n * BW + ch]; const float lm = lam[n * BW + ch];
            const float sp = log1pf(expf(-lm));
#pragma unroll
            for (int t = 0; t < 8; ++t) { const float r = sigmoidf_(aa[t] + bav), ig = sigmoidf_(ax[t] + bxv);
                const float log_a = -8.0f * r * sp; const float a = expf(log_a); const float uu = sqrtf(-expm1f(2.0f * log_a)) * ig * xc[t * 1024 + ch];
                LA[((size_t)(row0 + t) * 2 + n) * BW + ch] = a; LU[((size_t)(row0 + t) * 2 + n) * BW + ch] = uu; }
        }
        __syncthreads();
    }
}
__device__ __forceinline__ void lru_scan_item(Frame& F, int item) {
    const int idx = item * 512 + F.tid;
    const int ch = idx & 1023, dir = (idx >> 10) & 1, b = idx >> 11;
    const float* LA = WSP(float, WS_LA); const float* LU = WSP(float, WS_LU); float* HL = WSP(float, WS_HL);
    float h = 0.f;
#pragma unroll 1
    for (int seg = 0; seg < 2; ++seg) {
        const int base = seg == 0 ? ML + b * CTXL : b * SEQ, len = seg == 0 ? CTXL : SEQ;
#pragma unroll 8
        for (int s = 0; s < len; ++s) { const int row = base + (dir ? len - 1 - s : s); const size_t o = ((size_t)row * 2 + dir) * BW + ch;
            h = LA[o] * h + LU[o]; HL[((size_t)dir * MT + row) * BW + ch] = h; }
    }
}


template <int PASS> __device__ __forceinline__ void lru_unit(Frame& F, int li, int unit) {
    const int g = unit & 7, seg = (unit >> 3) % 36, b = unit / 288;
    const bool isctx = seg < 4; const int row0 = isctx ? ML + b * CTXL + seg * 64 : b * SEQ + (seg - 4) * 64;
    const int sbeg = isctx ? ML + b * CTXL : b * SEQ, send = sbeg + (isctx ? CTXL : SEQ);
    LAS f16* Xc = (LAS f16*)F.lds;
    LAS float* Hs = (LAS float*)(F.lds + 17408);
    const f16* P = WSP(f16, WS_P); float* SUM = WSP(float, WS_LSUM);
    const int lane = F.lane, wave = F.wave, fr = lane & 15, fq = lane >> 4, tid = F.tid;
    { const float* cw = inp(18) + (size_t)li * 4 * BW + g * 128; const float* cb = inp(19) + (size_t)li * BW + g * 128;
#pragma unroll
      for (int it = 0; it < 2; ++it) { const int id = it * 512 + tid, t = id >> 4, c8 = (id & 15) * 8; const int row = row0 + t;
          float y[8];
#pragma unroll
          for (int e = 0; e < 8; ++e) y[e] = cb[c8 + e];
#pragma unroll
          for (int j = 0; j < 4; ++j) { const int rr = row + j - 1; if (rr >= sbeg && rr < send) { const f16x8 xv = *(const f16x8*)(P + (size_t)rr * LDP + LX + g * 128 + c8);
#pragma unroll
                  for (int e = 0; e < 8; ++e) y[e] += cw[j * BW + c8 + e] * (float)xv[e]; } }
          u32x4 w; w.x = pk_f16(y[0], y[1]); w.y = pk_f16(y[2], y[3]); w.z = pk_f16(y[4], y[5]); w.w = pk_f16(y[6], y[7]);
          *(LAS u32x4*)(Xc + t * 136 + c8) = w; } }
    __syncthreads();
#pragma unroll 1
    for (int q = 0; q < 2; ++q) {
        const int c = wave * 2 + q, n = c >> 3, jt = c & 7, ch = g * 128 + 16 * jt + fr;
        const f16* wt = WSP(f16, WS_WLRU) + ((((size_t)li * 2 + 0) * 2 + n) * 8 + g) * 128 * 128 + (size_t)(16 * jt + fr) * 128 + 8 * fq;
        f16x8 wa[4], wx[4];
#pragma unroll
        for (int ks = 0; ks < 4; ++ks) { wa[ks] = *(const f16x8*)(wt + 32 * ks); wx[ks] = *(const f16x8*)(wt + (size_t)2 * 8 * 128 * 128 + 32 * ks); }
        const float bav = inp(21)[(size_t)li * 2 * BW + n * BW + ch], bxv = inp(23)[(size_t)li * 2 * BW + n * BW + ch];
        const float sp = log1pf(expf(-inp(24)[(size_t)li * 2 * BW + n * BW + ch]));
        float carry = 0.f, aprod = 1.f;
        if (PASS == 1) {
            const float* sb = SUM + ((size_t)b * 36 * 2 + n) * 2048 + ch * 2;
            const int cnt = n == 0 ? seg : (isctx ? 3 - seg : 39 - seg);
            f32x2 pv[9];
#pragma unroll
            for (int e = 0; e < 9; ++e) { const int p = fq * 9 + e; const int s2 = n == 0 ? p : (isctx ? 3 - p : (p < 4 ? 3 - p : 39 - p));
                pv[e] = (f32x2){1.f, 0.f}; if (p < cnt) pv[e] = *(const f32x2*)(sb + (size_t)s2 * 4096); }
            float Al = 1.f, Ul = 0.f;
#pragma unroll
            for (int e = 0; e < 9; ++e) { Ul = Ul * pv[e].x + pv[e].y; Al *= pv[e].x; }
#pragma unroll
            for (int gg = 0; gg < 4; ++gg) { const float Ag = __shfl(Al, gg * 16 + fr), Ug = __shfl(Ul, gg * 16 + fr); carry = carry * Ag + Ug; }
        }
#pragma unroll 1
        for (int k = 0; k < 4; ++k) {
            const int tt = n ? 3 - k : k;
            f32x4 racc = (f32x4){0.f, 0.f, 0.f, 0.f}, iacc = (f32x4){0.f, 0.f, 0.f, 0.f};
#pragma unroll
            for (int ks = 0; ks < 4; ++ks) { const f16x8 a = *(const LAS f16x8*)(Xc + (16 * tt + fr) * 136 + 32 * ks + 8 * fq); racc = mfma16(a, wa[ks], racc); iacc = mfma16(a, wx[ks], iacc); }
            float av_[4], uv_[4];
#pragma unroll
            for (int r = 0; r < 4; ++r) { const int t = 16 * tt + 4 * fq + r; const float rg = sigmoidf_(racc[r] + bav), ig = sigmoidf_(iacc[r] + bxv);
                const float log_a = -8.0f * rg * sp; av_[r] = expf(log_a); uv_[r] = sqrtf(-expm1f(2.0f * log_a)) * ig * (float)Xc[t * 136 + 16 * jt + fr]; }
            float Al = 1.f, Ul = 0.f;
#pragma unroll
            for (int rr = 0; rr < 4; ++rr) { const int r = n ? 3 - rr : rr; Ul = Ul * av_[r] + uv_[r]; Al *= av_[r]; }
            float preA = 1.f, preU = 0.f, totA = 1.f, totU = 0.f;
#pragma unroll
            for (int gg = 0; gg < 4; ++gg) { const int gsrc = n ? 3 - gg : gg; const float Ag = __shfl(Al, gsrc * 16 + fr), Ug = __shfl(Ul, gsrc * 16 + fr);
                const bool before = n ? (gsrc > fq) : (gsrc < fq);
                if (before) { preU = preU * Ag + Ug; preA *= Ag; }
                totU = totU * Ag + Ug; totA *= Ag; }
            float hrun = carry * preA + preU;
#pragma unroll
            for (int rr = 0; rr < 4; ++rr) { const int r = n ? 3 - rr : rr; hrun = av_[r] * hrun + uv_[r];
                if (PASS == 1) Hs[(n * 64 + 16 * tt + 4 * fq + r) * 128 + 16 * jt + fr] = hrun; }
            carry = carry * totA + totU; aprod *= totA;
        }
        if (PASS == 0 && fq == 0) { f32x2 v = {aprod, carry}; *(f32x2*)(SUM + (((size_t)b * 36 + seg) * 2 + n) * 2048 + ch * 2) = v; }
    }
    __syncthreads();
    if (PASS == 1) {
        f16* Y = WSP(f16, WS_Y) + (size_t)2 * MT * BW;
#pragma unroll
        for (int it = 0; it < 2; ++it) { const int id = it * 512 + tid, t = id >> 4, c8 = (id & 15) * 8; const int row = row0 + t;
            const f16x8 gg = *(const f16x8*)(P + (size_t)row * LDP + LG + g * 128 + c8);
            float y[8];
#pragma unroll
            for (int e = 0; e < 8; ++e) y[e] = (Hs[t * 128 + c8 + e] + Hs[(64 + t) * 128 + c8 + e]) * (float)gg[e];
            u32x4 w; w.x = pk_f16(y[0], y[1]); w.y = pk_f16(y[2], y[3]); w.z = pk_f16(y[4], y[5]); w.w = pk_f16(y[6], y[7]);
            *(u32x4*)(Y + (size_t)row * BW + g * 128 + c8) = w; }
        __syncthreads();
    }
}

__device__ __forceinline__ void na_unit(Frame& F, int li, int unit) {
    const bool lat = unit < 1024; const int uu = lat ? unit : unit - 1024;
    const int h = uu & 7, rr = (uu >> 3) & (lat ? 31 : 3), b = uu >> (lat ? 8 : 5);
    const f16* P = WSP(f16, WS_P); f16* Y = WSP(f16, WS_Y) + (size_t)1 * MT * BW;
    const float* rpb = inp(17) + ((size_t)li * 8 + h) * 15 * 31;
    LAS float* qf = (LAS float*)(F.lds + F.wave * 4096);
    LAS float* pj = qf + 128;
    const int npass = lat ? 6 : 4; const int rs = lat ? min(max(rr - 4, 0), 24) : 0;
    for (int qi = 0; qi < 8; ++qi) {
        const int qc = F.wave * 8 + qi;
        const int rowq = lat ? b * SEQ + rr * 64 + qc : ML + b * CTXL + rr * 64 + qc;
        { const f16x2 qv = *(const f16x2*)(P + (size_t)rowq * LDP + NQ + h * 128 + 2 * F.lane); qf[2 * F.lane] = (float)qv[0]; qf[2 * F.lane + 1] = (float)qv[1]; }
        LDS_WAIT();
        const int cs = min(max(qc - 8, 0), 48);
        float sc[6];
#pragma unroll
        for (int p = 0; p < 6; ++p) {
            sc[p] = -INFINITY;
            if (p < npass) {
                int krow_g; float bias = 0.f;
                if (lat && p < 2) { const int jrow = (F.lane >> 4) + 4 * p, kc = cs + (F.lane & 15), kr = rs + jrow; krow_g = b * SEQ + kr * 64 + kc;
                    bias = rpb[(kr - rr + 7) * 31 + (min(max(kc - qc, -15), 15) + 15)]; }
                else { const int ci = (lat ? p - 2 : p) * 64 + F.lane; krow_g = ML + b * CTXL + ci; }
                const f16x8* kp = (const f16x8*)(P + (size_t)krow_g * LDP + NK + h * 128);
                float d = 0.f;
#pragma unroll 4
                for (int i = 0; i < 16; ++i) { const f16x8 kv = kp[i];
#pragma unroll
                    for (int e = 0; e < 8; ++e) d += (float)kv[e] * qf[8 * i + e]; }
                sc[p] = d + bias;
            }
        }
        float mx = sc[0];
#pragma unroll
        for (int p = 1; p < 6; ++p) mx = fmaxf(mx, sc[p]);
        mx = wave_max(mx);
        float sm = 0.f;
#pragma unroll
        for (int p = 0; p < 6; ++p) { sc[p] = p < npass ? __expf(sc[p] - mx) : 0.f; sm += sc[p]; }
        sm = wave_sum(sm); const float inv = 1.0f / sm;
#pragma unroll
        for (int p = 0; p < 6; ++p) if (p < npass) pj[p * 64 + F.lane] = sc[p] * inv;
        LDS_WAIT();
        float a0 = 0.f, a1 = 0.f;
        for (int j = 0; j < npass * 64; ++j) {
            const int p = j >> 6, l = j & 63; int krow_g;
            if (lat && p < 2) { const int jrow = (l >> 4) + 4 * p, kc = cs + (l & 15); krow_g = b * SEQ + (rs + jrow) * 64 + kc; }
            else krow_g = ML + b * CTXL + (lat ? p - 2 : p) * 64 + l;
            const f16x2 vv = *(const f16x2*)(P + (size_t)krow_g * LDP + NV + h * 128 + 2 * F.lane);
            const float pv = pj[j]; a0 += pv * (float)vv[0]; a1 += pv * (float)vv[1];
        }
        *(unsigned*)(Y + (size_t)rowq * BW + h * 128 + 2 * F.lane) = pk_f16(a0, a1);
        LDS_WAIT();
    }
}


__device__ __forceinline__ void na_tile(Frame& F, int li, bool lat, int b, int rr, int i, int h) {
    LAS f16* Vs = (LAS f16*)(F.lds + F.wave * 10240);
    const int lane = F.lane, fr = lane & 15, fq = lane >> 4;
    const f16* P = WSP(f16, WS_P); f16* Y = WSP(f16, WS_Y) + (size_t)1 * MT * BW;
    const float* rpb = inp(17) + ((size_t)li * 8 + h) * 15 * 31;
    const int q0row = lat ? b * SEQ + rr * 64 + 16 * i : ML + b * CTXL + rr * 64 + 16 * i;
    f16x8 qf[4];
#pragma unroll
    for (int ks = 0; ks < 4; ++ks) qf[ks] = *(const f16x8*)(P + (size_t)(q0row + fr) * LDP + NQ + h * 128 + 32 * ks + 8 * fq);
    f32x4 oacc[8];
#pragma unroll
    for (int dt = 0; dt < 8; ++dt) oacc[dt] = (f32x4){0.f, 0.f, 0.f, 0.f};
    float m_run = -INFINITY, l_run = 0.f;
    const int c0 = min(max(16 * i - 8, 0), 32), rs = min(max(rr - 4, 0), 24), qc = 16 * i + fr, cs = min(max(qc - 8, 0), 48);
    const int nblk = lat ? 16 : 8;
#define NA_KEYBASE(blk) ((lat && (blk) < 8) ? b * SEQ + (rs + (blk)) * 64 + c0 : ML + b * CTXL + ((blk) - (lat ? 8 : 0)) * 32)
    f16x8 kreg[2][4], vreg[8];
    { const int kb = NA_KEYBASE(0);
#pragma unroll
      for (int nt = 0; nt < 2; ++nt)
#pragma unroll
          for (int ks = 0; ks < 4; ++ks) kreg[nt][ks] = *(const f16x8*)(P + (size_t)(kb + 16 * nt + fr) * LDP + NK + h * 128 + 32 * ks + 8 * fq);
#pragma unroll
      for (int it = 0; it < 8; ++it) { const int id = it * 64 + lane; vreg[it] = *(const f16x8*)(P + (size_t)(kb + (id >> 4)) * LDP + NV + h * 128 + (id & 15) * 8); } }
#pragma unroll 1
    for (int blk = 0; blk < nblk; ++blk) {
        const bool win = lat && blk < 8;
#pragma unroll
        for (int it = 0; it < 8; ++it) { const int id = it * 64 + lane; *(LAS f16x8*)(Vs + (id >> 4) * 144 + (id & 15) * 8) = vreg[it]; }
        f32x4 sacc[2];
#pragma unroll
        for (int nt = 0; nt < 2; ++nt) { sacc[nt] = (f32x4){0.f, 0.f, 0.f, 0.f};
#pragma unroll
            for (int ks = 0; ks < 4; ++ks) sacc[nt] = mfma16(kreg[nt][ks], qf[ks], sacc[nt]); }
        if (blk + 1 < nblk) {
            const int kb = NA_KEYBASE(blk + 1);
#pragma unroll
            for (int nt = 0; nt < 2; ++nt)
#pragma unroll
                for (int ks = 0; ks < 4; ++ks) kreg[nt][ks] = *(const f16x8*)(P + (size_t)(kb + 16 * nt + fr) * LDP + NK + h * 128 + 32 * ks + 8 * fq);
#pragma unroll
            for (int it = 0; it < 8; ++it) { const int id = it * 64 + lane; vreg[it] = *(const f16x8*)(P + (size_t)(kb + (id >> 4)) * LDP + NV + h * 128 + (id & 15) * 8); }
        }
        float sv[8]; float bm = -INFINITY;
#pragma unroll
        for (int nt = 0; nt < 2; ++nt)
#pragma unroll
            for (int r = 0; r < 4; ++r) { float x = sacc[nt][r];
                if (win) { const int kc = c0 + 16 * nt + 4 * fq + r; const bool valid = kc >= cs && kc < cs + 16; const int dc = min(max(kc - qc + 15, 0), 30);
                    const float bias = rpb[(rs + blk - rr + 7) * 31 + dc]; x = valid ? x + bias : -INFINITY; }
                sv[nt * 4 + r] = x; bm = fmaxf(bm, x); }
        bm = fmaxf(bm, __shfl_xor(bm, 16)); bm = fmaxf(bm, __shfl_xor(bm, 32));
        const float m_new = fmaxf(m_run, bm), alpha = __expf(m_run - m_new);
        float ps = 0.f;
#pragma unroll
        for (int e = 0; e < 8; ++e) { sv[e] = __expf(sv[e] - m_new); ps += sv[e]; }
        ps += __shfl_xor(ps, 16); ps += __shfl_xor(ps, 32);
        l_run = l_run * alpha + ps; m_run = m_new;
        f16x8 pf;
#pragma unroll
        for (int e = 0; e < 8; ++e) pf[e] = (f16)sv[e];
        const LAS f16* vb = Vs + (4 * fq + (fr >> 2)) * 144 + 4 * (fr & 3);
#pragma unroll
        for (int dt = 0; dt < 8; ++dt) { oacc[dt] = oacc[dt] * alpha;
            const f16x4 alo = lds_tr4(vb + 16 * dt), ahi = lds_tr4(vb + 16 * 144 + 16 * dt);
            const f16x8 a = __builtin_shufflevector(alo, ahi, 0, 1, 2, 3, 4, 5, 6, 7);
            oacc[dt] = mfma16(a, pf, oacc[dt]); }
    }
#undef NA_KEYBASE
    const float inv = 1.0f / l_run;
    LAS f16* Ot = Vs;
#pragma unroll
    for (int dt = 0; dt < 8; ++dt) { u32x2 w; w.x = pk_f16(oacc[dt][0] * inv, oacc[dt][1] * inv); w.y = pk_f16(oacc[dt][2] * inv, oacc[dt][3] * inv);
        *(LAS u32x2*)(Ot + fr * 136 + 16 * dt + 4 * fq) = w; }
    { const int row = lane >> 2, seg = lane & 3;
#pragma unroll
      for (int c = 0; c < 4; ++c) { const u32x4 w = *(const LAS u32x4*)(Ot + row * 136 + seg * 32 + c * 8);
          *(u32x4*)(Y + (size_t)(q0row + row) * BW + h * 128 + seg * 32 + c * 8) = w; } }
}

__device__ __forceinline__ void mlstm_unit(Frame& F, int li, int unit, bool ctx_out) {
    const int vs = unit & 7, dir = (unit >> 3) & 1, h = (unit >> 4) & 3, b = unit >> 6;
    LAS float* Cs = (LAS float*)F.lds;
    LAS float* ns = Cs + 32 * 257;
    LAS float* Vs = ns + 256;
    LAS float* Ss = Vs + 64 * 33;
    LAS float* cum = Ss + 64 * 65;
    LAS float* mrow = cum + 64; LAS float* ig = mrow + 64; LAS float* lf = ig + 64; LAS float* inter = lf + 64; LAS float* wst = inter + 64; LAS float* den = wst + 64; LAS float* misc = den + 64;
    LAS f16* Qs = (LAS f16*)(misc + 64);
    LAS f16* Ks = Qs + 64 * 264;
    const f16* P = WSP(f16, WS_P); const float* G = WSP(float, WS_G); float* HMD = WSP(float, WS_HMD) + (size_t)dir * MT * BW;
    const float bi_ = inp(14)[(li * 2 + dir) * 4 + h], bf_ = inp(15)[(li * 2 + dir) * 4 + h];
    for (int i = F.tid; i < 32 * 257 + 256; i += 512) Cs[i] = 0.f;
    if (F.tid == 0) misc[0] = -INFINITY;
    __syncthreads();
    for (int j = 0; j < 36; ++j) {
        const bool isctx = j < 4; const int base = isctx ? ML + b * CTXL : b * SEQ, len = isctx ? CTXL : SEQ, off = isctx ? j * 64 : (j - 4) * 64;
#define MROW(s) (base + (dir ? len - 1 - (off + (s)) : off + (s)))
        for (int i = F.tid; i < 2048; i += 512) { const int s = i >> 5, c8 = i & 31; const size_t ro = (size_t)MROW(s) * LDP + h * 256 + c8 * 8;
            *(LAS f16x8*)(Qs + s * 264 + c8 * 8) = *(const f16x8*)(P + ro + PQ); *(LAS f16x8*)(Ks + s * 264 + c8 * 8) = *(const f16x8*)(P + ro + PK); }
        if (F.tid < 256) { const int s = F.tid >> 2, c8 = F.tid & 3; const f16x8 v = *(const f16x8*)(P + (size_t)MROW(s) * LDP + PV + h * 256 + vs * 32 + c8 * 8);
#pragma unroll
            for (int e = 0; e < 8; ++e) Vs[s * 33 + c8 * 8 + e] = (float)v[e]; }
        if (F.tid < 64) { const int row = MROW(F.tid); ig[F.tid] = G[(size_t)row * 16 + dir * 8 + h] + bi_; const float fp = G[(size_t)row * 16 + dir * 8 + 4 + h] + bf_;
            lf[F.tid] = fminf(fp, 0.f) - log1pf(expf(-fabsf(fp))); }
        __syncthreads();
        if (F.tid == 0) { const float mp = misc[0]; float c = 0.f, R = mp;
            for (int s = 0; s < 64; ++s) { c += lf[s]; cum[s] = c; R = fmaxf(R, ig[s] - c); mrow[s] = c + R; inter[s] = expf(c + mp - (c + R)); }
            const float mn = mrow[63], cl = cum[63];
            for (int s = 0; s < 64; ++s) wst[s] = expf(cl - cum[s] + ig[s] - mn);
            misc[1] = expf(cl + mp - mn); misc[0] = mn; }
        __syncthreads();
        const bool need_out = !isctx || ctx_out;
        if (need_out) {
            for (int i = F.tid; i < 4096; i += 512) { const int t = i >> 6, s = i & 63; float v = 0.f;
                if (s <= t) { float d = 0.f;
#pragma unroll 8
                    for (int k = 0; k < 256; ++k) d += (float)Qs[t * 264 + k] * (float)Ks[s * 264 + k];
                    v = d * expf(cum[t] - cum[s] + ig[s] - mrow[t]); }
                Ss[t * 65 + s] = v; }
            __syncthreads();
            float num[4];
#pragma unroll
            for (int q = 0; q < 4; ++q) { const int i = q * 512 + F.tid, t = i >> 5, v = i & 31; float a = 0.f, bs = 0.f;
#pragma unroll 8
                for (int k = 0; k < 256; ++k) a += Cs[v * 257 + k] * (float)Qs[t * 264 + k];
#pragma unroll 8
                for (int s = 0; s < 64; ++s) bs += Ss[t * 65 + s] * Vs[s * 33 + v];
                num[q] = inter[t] * a + bs; }
            if (F.tid < 64) { const int t = F.tid; float a = 0.f, bs = 0.f;
                for (int k = 0; k < 256; ++k) a += ns[k] * (float)Qs[t * 264 + k];
                for (int s = 0; s < 64; ++s) bs += Ss[t * 65 + s];
                den[t] = inter[t] * a + bs; }
            __syncthreads();
#pragma unroll
            for (int q = 0; q < 4; ++q) { const int i = q * 512 + F.tid, t = i >> 5, v = i & 31;
                HMD[(size_t)MROW(t) * BW + h * 256 + vs * 32 + v] = num[q] / fmaxf(fabsf(den[t]), expf(-mrow[t])); }
        }
        __syncthreads();
        { const float decay = misc[1];
          for (int i = F.tid; i < 8192; i += 512) { const int v = i >> 8, k = i & 255; float a = 0.f;
#pragma unroll 8
              for (int s = 0; s < 64; ++s) a += wst[s] * Vs[s * 33 + v] * (float)Ks[s * 264 + k];
              Cs[v * 257 + k] = decay * Cs[v * 257 + k] + a; }
          if (F.tid < 256) { const int k = F.tid; float a = 0.f;
              for (int s = 0; s < 64; ++s) a += wst[s] * (float)Ks[s * 264 + k];
              ns[k] = decay * ns[k] + a; } }
        __syncthreads();
#undef MROW
    }
}


__device__ __forceinline__ void mlstm_unit2(Frame& F, int li, int unit, bool ctx_out) {
    const int vs = unit & 7, dir = (unit >> 3) & 1, h = (unit >> 4) & 3, b = unit >> 6;
    constexpr int QS = 0, KS = 33792, KT = 67584, VT = 104448, SC = 111360, C16 = 120576, VEC = 145920;
    LAS f16* Qs = (LAS f16*)(F.lds + QS); LAS f16* Ks = (LAS f16*)(F.lds + KS); LAS f16* Kt = (LAS f16*)(F.lds + KT); LAS f16* Vt = (LAS f16*)(F.lds + VT);
    LAS f16* Sc = (LAS f16*)(F.lds + SC); LAS f16* Cs = (LAS f16*)(F.lds + C16);
    LAS float* av = (LAS float*)(F.lds + VEC); LAS float* Rv = av + 64; LAS float* interv = av + 128; LAS float* eneg = av + 192; LAS f16* w16 = (LAS f16*)(av + 256); LAS float* misc = av + 288;
    const f16* P = WSP(f16, WS_P); const float* G = WSP(float, WS_G); float* HMD = WSP(float, WS_HMD) + (size_t)dir * MT * BW;
    const float bi_ = inp(14)[(li * 2 + dir) * 4 + h], bf_ = inp(15)[(li * 2 + dir) * 4 + h];
    const int lane = F.lane, wave = F.wave, fr = lane & 15, fq = lane >> 4, tid = F.tid;
    for (int i = tid; i < 48 * 264; i += 512) Cs[i] = (f16)0.f;
    for (int i = tid; i < 16 * 72; i += 512) Vt[32 * 72 + i] = (i < 64) ? (f16)1.f : (f16)0.f;
    f32x4 Cacc[3][2];
#pragma unroll
    for (int vt = 0; vt < 3; ++vt)
#pragma unroll
        for (int nt = 0; nt < 2; ++nt) Cacc[vt][nt] = (f32x4){0.f, 0.f, 0.f, 0.f};
    float m_prev = -INFINITY;
    __syncthreads();
#pragma unroll 1
    for (int j = 0; j < 36; ++j) {
        const bool isctx = j < 4; const int base = isctx ? ML + b * CTXL : b * SEQ, len = isctx ? CTXL : SEQ, off = isctx ? j * 64 : (j - 4) * 64;
#define MROW(s) (base + (dir ? len - 1 - (off + (s)) : off + (s)))
#pragma unroll
        for (int it = 0; it < 4; ++it) { const int i = it * 512 + tid, s = i >> 5, c8 = i & 31; const size_t ro = (size_t)MROW(s) * LDP + h * 256 + c8 * 8;
            const f16x8 q = *(const f16x8*)(P + ro + PQ), k = *(const f16x8*)(P + ro + PK);
            *(LAS f16x8*)(Qs + s * 264 + c8 * 8) = q; *(LAS f16x8*)(Ks + s * 264 + c8 * 8) = k;
#pragma unroll
            for (int e = 0; e < 8; ++e) Kt[(c8 * 8 + e) * 72 + s] = k[e]; }
        if (tid < 256) { const int s = tid >> 2, c = tid & 3; const f16x8 v = *(const f16x8*)(P + (size_t)MROW(s) * LDP + PV + h * 256 + vs * 32 + c * 8);
#pragma unroll
            for (int e = 0; e < 8; ++e) Vt[(c * 8 + e) * 72 + s] = v[e]; }
        if (wave == 0) {
            const int row = MROW(lane); const float igv = G[(size_t)row * 16 + dir * 8 + h] + bi_; const float fp = G[(size_t)row * 16 + dir * 8 + 4 + h] + bf_;
            float cum = fminf(fp, 0.f) - log1pf(expf(-fabsf(fp)));
#pragma unroll
            for (int d = 1; d < 64; d <<= 1) { const float t = __shfl_up(cum, d); if (lane >= d) cum += t; }
            const float a = igv - cum; float R = a;
#pragma unroll
            for (int d = 1; d < 64; d <<= 1) { const float t = __shfl_up(R, d); if (lane >= d) R = fmaxf(R, t); }
            R = fmaxf(R, m_prev);
            const float mrow = cum + R, m_new = __shfl(mrow, 63), cl = __shfl(cum, 63);
            av[lane] = a; Rv[lane] = R; interv[lane] = expf(m_prev - R); eneg[lane] = expf(-mrow); w16[lane] = (f16)expf(cl + a - m_new);
            if (lane == 0) misc[0] = expf(cl + m_prev - m_new);
            m_prev = m_new;
        }
        __syncthreads();
        const bool need_out = !isctx || ctx_out;
        f32x4 nacc[3];
        if (need_out) {
            if (wave >= 4) {
                const int i = wave - 4; f32x4 sacc[4];
#pragma unroll
                for (int st = 0; st < 4; ++st) sacc[st] = (f32x4){0.f, 0.f, 0.f, 0.f};
#pragma unroll
                for (int ks = 0; ks < 8; ++ks) { const f16x8 a = *(const LAS f16x8*)(Qs + (16 * i + fr) * 264 + 32 * ks + 8 * fq);
#pragma unroll
                    for (int st = 0; st < 4; ++st) if (st <= i) { const f16x8 bq = *(const LAS f16x8*)(Ks + (16 * st + fr) * 264 + 32 * ks + 8 * fq); sacc[st] = mfma16(a, bq, sacc[st]); } }
#pragma unroll
                for (int st = 0; st < 4; ++st) { const int sidx = 16 * st + fr; const float as = av[sidx];
#pragma unroll
                    for (int r = 0; r < 4; ++r) { const int t = 16 * i + 4 * fq + r; const float val = (st <= i && sidx <= t) ? sacc[st][r] * __expf(as - Rv[t]) : 0.f; Sc[t * 72 + sidx] = (f16)val; } }
            } else {
                const int i = wave;
#pragma unroll
                for (int vt = 0; vt < 3; ++vt) nacc[vt] = (f32x4){0.f, 0.f, 0.f, 0.f};
#pragma unroll
                for (int ks = 0; ks < 8; ++ks) { const f16x8 a = *(const LAS f16x8*)(Qs + (16 * i + fr) * 264 + 32 * ks + 8 * fq);
#pragma unroll
                    for (int vt = 0; vt < 3; ++vt) { const f16x8 bc = *(const LAS f16x8*)(Cs + (16 * vt + fr) * 264 + 32 * ks + 8 * fq); nacc[vt] = mfma16(a, bc, nacc[vt]); } }
#pragma unroll
                for (int r = 0; r < 4; ++r) { const float sc_ = interv[16 * i + 4 * fq + r];
#pragma unroll
                    for (int vt = 0; vt < 3; ++vt) nacc[vt][r] *= sc_; }
            }
        }
        __syncthreads();
        if (need_out && wave < 4) {
            const int i = wave;
#pragma unroll
            for (int k2 = 0; k2 < 2; ++k2) { const f16x8 a = *(const LAS f16x8*)(Sc + (16 * i + fr) * 72 + 32 * k2 + 8 * fq);
#pragma unroll
                for (int vt = 0; vt < 3; ++vt) { const f16x8 bv = *(const LAS f16x8*)(Vt + (16 * vt + fr) * 72 + 32 * k2 + 8 * fq); nacc[vt] = mfma16(a, bv, nacc[vt]); } }
#pragma unroll
            for (int r = 0; r < 4; ++r) { const int t = 16 * i + 4 * fq + r; const float dn = __shfl(nacc[2][r], lane & 48); const float inv = 1.0f / fmaxf(fabsf(dn), eneg[t]);
                float* hp = HMD + (size_t)MROW(t) * BW + h * 256 + vs * 32 + fr;
                hp[0] = nacc[0][r] * inv; hp[16] = nacc[1][r] * inv; }
        }
        { const float decay = misc[0];
#pragma unroll
          for (int vt = 0; vt < 3; ++vt)
#pragma unroll
              for (int nt = 0; nt < 2; ++nt) Cacc[vt][nt] = Cacc[vt][nt] * decay;
#pragma unroll
          for (int k2 = 0; k2 < 2; ++k2) { const f16x8 wf = *(const LAS f16x8*)(w16 + 32 * k2 + 8 * fq); f16x8 af[3];
#pragma unroll
              for (int vt = 0; vt < 3; ++vt) af[vt] = *(const LAS f16x8*)(Vt + (16 * vt + fr) * 72 + 32 * k2 + 8 * fq) * wf;
#pragma unroll
              for (int nt = 0; nt < 2; ++nt) { const f16x8 bk = *(const LAS f16x8*)(Kt + (32 * wave + 16 * nt + fr) * 72 + 32 * k2 + 8 * fq);
#pragma unroll
                  for (int vt = 0; vt < 3; ++vt) Cacc[vt][nt] = mfma16(af[vt], bk, Cacc[vt][nt]); } }
#pragma unroll
          for (int vt = 0; vt < 3; ++vt)
#pragma unroll
              for (int nt = 0; nt < 2; ++nt)
#pragma unroll
                  for (int r = 0; r < 4; ++r) Cs[(16 * vt + 4 * fq + r) * 264 + 32 * wave + 16 * nt + fr] = (f16)Cacc[vt][nt][r]; }
        __syncthreads();
#undef MROW
    }
}


__device__ __forceinline__ void mlstm_gate_scan(Frame& F, int li, int seq) {
    const int dir = seq & 1, h = (seq >> 1) & 3, b = seq >> 3, lane = F.lane;
    const float* G = WSP(float, WS_G); float* GS = WSP(float, WS_GS) + (size_t)seq * 36 * 320; float* GD = WSP(float, WS_GS + 3 * 512 * 1024) + seq * 36;
    const float bi_ = inp(14)[(li * 2 + dir) * 4 + h], bf_ = inp(15)[(li * 2 + dir) * 4 + h];
    float m_prev = -INFINITY;
#pragma unroll 1
    for (int j = 0; j < 36; ++j) {
        const bool isctx = j < 4; const int base = isctx ? ML + b * CTXL : b * SEQ, len = isctx ? CTXL : SEQ, off = isctx ? j * 64 : (j - 4) * 64;
        const int row = base + (dir ? len - 1 - (off + lane) : off + lane);
        const float igv = G[(size_t)row * 16 + dir * 8 + h] + bi_; const float fp = G[(size_t)row * 16 + dir * 8 + 4 + h] + bf_;
        float cum = fminf(fp, 0.f) - log1pf(expf(-fabsf(fp)));
#pragma unroll
        for (int d = 1; d < 64; d <<= 1) { const float t = __shfl_up(cum, d); if (lane >= d) cum += t; }
        const float a = igv - cum; float R = a;
#pragma unroll
        for (int d = 1; d < 64; d <<= 1) { const float t = __shfl_up(R, d); if (lane >= d) R = fmaxf(R, t); }
        R = fmaxf(R, m_prev);
        const float mrow = cum + R, m_new = __shfl(mrow, 63), cl = __shfl(cum, 63);
        float* o = GS + j * 320 + lane;
        o[0] = a; o[64] = R; o[128] = expf(m_prev - R); o[192] = expf(-mrow); o[256] = expf(cl + a - m_new);
        if (lane == 0) GD[j] = expf(cl + m_prev - m_new);
        m_prev = m_new;
    }
}

__device__ __forceinline__ void mlstm_unit3(Frame& F, int li, int unit, bool ctx_out) {
    const int vs = unit & 7, dir = (unit >> 3) & 1, h = (unit >> 4) & 3, b = unit >> 6, seq = unit >> 3;
    constexpr int QS = 0, KS = 33792, VS = 67584, SC = 74752, C16 = 83968, VEC = 109312;
    LAS f16* Qs = (LAS f16*)(F.lds + QS); LAS f16* Ks = (LAS f16*)(F.lds + KS); LAS f16* Vs = (LAS f16*)(F.lds + VS);
    LAS f16* Sc = (LAS f16*)(F.lds + SC); LAS f16* Cs = (LAS f16*)(F.lds + C16);
    LAS float* gv = (LAS float*)(F.lds + VEC);
    LAS float* av = gv; LAS float* Rv = gv + 64; LAS float* interv = gv + 128; LAS float* eneg = gv + 192; LAS f16* w16 = (LAS f16*)(gv + 320); LAS float* misc = gv + 352;
    const f16* P = WSP(f16, WS_P); float* HMD = WSP(float, WS_HMD) + (size_t)dir * MT * BW;
    const float* GS = WSP(float, WS_GS) + (size_t)seq * 36 * 320; const float* GD = WSP(float, WS_GS + 3 * 512 * 1024) + seq * 36;
    const int lane = F.lane, wave = F.wave, fr = lane & 15, fq = lane >> 4, tid = F.tid;
    for (int i = tid; i < 48 * 264; i += 512) Cs[i] = (f16)0.f;
    for (int i = tid; i < 64 * 16; i += 512) Vs[(i >> 4) * 56 + 32 + (i & 15)] = ((i & 15) == 0) ? (f16)1.f : (f16)0.f;
    f32x4 Cacc[3][2];
#pragma unroll
    for (int vt = 0; vt < 3; ++vt)
#pragma unroll
        for (int nt = 0; nt < 2; ++nt) Cacc[vt][nt] = (f32x4){0.f, 0.f, 0.f, 0.f};
#define MROWJ(j, s) (((j) < 4 ? ML + b * CTXL : b * SEQ) + (dir ? ((j) < 4 ? CTXL : SEQ) - 1 - (((j) < 4 ? (j) * 64 : ((j) - 4) * 64) + (s)) : ((j) < 4 ? (j) * 64 : ((j) - 4) * 64) + (s)))
    f16x8 qreg[4], kreg[4], vreg; float greg = 0.f, dreg = 0.f;
#define ML_PREFETCH(j) do { \
        _Pragma("unroll") for (int it = 0; it < 4; ++it) { const int i_ = it * 512 + tid, s_ = i_ >> 5, c8_ = i_ & 31; const size_t ro_ = (size_t)MROWJ(j, s_) * LDP + h * 256 + c8_ * 8; \
            qreg[it] = *(const f16x8*)(P + ro_ + PQ); kreg[it] = *(const f16x8*)(P + ro_ + PK); } \
        if (tid < 256) vreg = *(const f16x8*)(P + (size_t)MROWJ(j, tid >> 2) * LDP + PV + h * 256 + vs * 32 + (tid & 3) * 8); \
        if (tid < 320) greg = GS[(j) * 320 + tid]; \
        if (tid == 320) dreg = GD[j]; } while (0)
    ML_PREFETCH(0);
    __syncthreads();
#pragma unroll 1
    for (int j = 0; j < 36; ++j) {
        const bool isctx = j < 4;
#pragma unroll
        for (int it = 0; it < 4; ++it) { const int i = it * 512 + tid, s = i >> 5, c8 = i & 31;
            *(LAS f16x8*)(Qs + s * 264 + c8 * 8) = qreg[it]; *(LAS f16x8*)(Ks + s * 264 + c8 * 8) = kreg[it]; }
        if (tid < 256) *(LAS f16x8*)(Vs + (tid >> 2) * 56 + (tid & 3) * 8) = vreg;
        if (tid < 320) { gv[tid] = greg; if (tid >= 256) w16[tid - 256] = (f16)greg; }
        if (tid == 320) misc[0] = dreg;
        __syncthreads();
        if (j + 1 < 36) ML_PREFETCH(j + 1);
        const bool need_out = !isctx || ctx_out;
        f32x4 nacc[3];
        if (need_out) {
            if (wave >= 4) {
                const int i = wave - 4; f32x4 sacc[4];
#pragma unroll
                for (int st = 0; st < 4; ++st) sacc[st] = (f32x4){0.f, 0.f, 0.f, 0.f};
#pragma unroll
                for (int ks = 0; ks < 8; ++ks) { const f16x8 a = *(const LAS f16x8*)(Qs + (16 * i + fr) * 264 + 32 * ks + 8 * fq);
#pragma unroll
                    for (int st = 0; st < 4; ++st) if (st <= i) { const f16x8 bq = *(const LAS f16x8*)(Ks + (16 * st + fr) * 264 + 32 * ks + 8 * fq); sacc[st] = mfma16(a, bq, sacc[st]); } }
#pragma unroll
                for (int st = 0; st < 4; ++st) { const int sidx = 16 * st + fr; const float as = av[sidx];
#pragma unroll
                    for (int r = 0; r < 4; ++r) { const int t = 16 * i + 4 * fq + r; const float val = (st <= i && sidx <= t) ? sacc[st][r] * __expf(as - Rv[t]) : 0.f; Sc[t * 72 + sidx] = (f16)val; } }
            } else {
                const int i = wave;
#pragma unroll
                for (int vt = 0; vt < 3; ++vt) nacc[vt] = (f32x4){0.f, 0.f, 0.f, 0.f};
#pragma unroll
                for (int ks = 0; ks < 8; ++ks) { const f16x8 a = *(const LAS f16x8*)(Qs + (16 * i + fr) * 264 + 32 * ks + 8 * fq);
#pragma unroll
                    for (int vt = 0; vt < 3; ++vt) { const f16x8 bc = *(const LAS f16x8*)(Cs + (16 * vt + fr) * 264 + 32 * ks + 8 * fq); nacc[vt] = mfma16(a, bc, nacc[vt]); } }
#pragma unroll
                for (int r = 0; r < 4; ++r) { const float sc_ = interv[16 * i + 4 * fq + r];
#pragma unroll
                    for (int vt = 0; vt < 3; ++vt) nacc[vt][r] *= sc_; }
            }
        }
        __syncthreads();
        f16x8 vf[2][3];
#pragma unroll
        for (int k2 = 0; k2 < 2; ++k2)
#pragma unroll
            for (int vt = 0; vt < 3; ++vt) { const LAS f16* p = Vs + (32 * k2 + 8 * fq + (fr >> 2)) * 56 + 16 * vt + 4 * (fr & 3);
                const f16x4 lo = lds_tr4(p), hi = lds_tr4(p + 4 * 56); vf[k2][vt] = __builtin_shufflevector(lo, hi, 0, 1, 2, 3, 4, 5, 6, 7); }
        if (need_out && wave < 4) {
            const int i = wave;
#pragma unroll
            for (int k2 = 0; k2 < 2; ++k2) { const f16x8 a = *(const LAS f16x8*)(Sc + (16 * i + fr) * 72 + 32 * k2 + 8 * fq);
#pragma unroll
                for (int vt = 0; vt < 3; ++vt) nacc[vt] = mfma16(a, vf[k2][vt], nacc[vt]); }
#pragma unroll
            for (int r = 0; r < 4; ++r) { const int t = 16 * i + 4 * fq + r; const float dn = __shfl(nacc[2][r], lane & 48); const float inv = 1.0f / fmaxf(fabsf(dn), eneg[t]);
                float* hp = HMD + (size_t)MROWJ(j, t) * BW + h * 256 + vs * 32 + fr;
                hp[0] = nacc[0][r] * inv; hp[16] = nacc[1][r] * inv; }
        }
        { const float decay = misc[0];
#pragma unroll
          for (int vt = 0; vt < 3; ++vt)
#pragma unroll
              for (int nt = 0; nt < 2; ++nt) Cacc[vt][nt] = Cacc[vt][nt] * decay;
#pragma unroll
          for (int k2 = 0; k2 < 2; ++k2) { const f16x8 wf = *(const LAS f16x8*)(w16 + 32 * k2 + 8 * fq);
#pragma unroll
              for (int nt = 0; nt < 2; ++nt) { const LAS f16* p = Ks + (32 * k2 + 8 * fq + (fr >> 2)) * 264 + 32 * wave + 16 * nt + 4 * (fr & 3);
                  const f16x4 lo = lds_tr4(p), hi = lds_tr4(p + 4 * 264); const f16x8 bk = __builtin_shufflevector(lo, hi, 0, 1, 2, 3, 4, 5, 6, 7);
#pragma unroll
                  for (int vt = 0; vt < 3; ++vt) Cacc[vt][nt] = mfma16(vf[k2][vt] * wf, bk, Cacc[vt][nt]); } }
#pragma unroll
          for (int vt = 0; vt < 3; ++vt)
#pragma unroll
              for (int nt = 0; nt < 2; ++nt)
#pragma unroll
                  for (int r = 0; r < 4; ++r) Cs[(16 * vt + 4 * fq + r) * 264 + 32 * wave + 16 * nt + fr] = (f16)Cacc[vt][nt][r]; }
        __syncthreads();
    }
#undef MROWJ
#undef ML_PREFETCH
}

__device__ __forceinline__ void phase_finish(int li_v) {
    Frame F = make_frame(); const int li = UNI(li_v); const int M = li == DEPTH - 1 ? ML : MT;
    const int gw = F.bid * 8 + F.wave, NGW = F.G * 8;
    const f16* P = WSP(f16, WS_P); const float* HMD = WSP(float, WS_HMD); const float* HL = WSP(float, WS_HL); f16* Y = WSP(f16, WS_Y);
    const float* gn = inp(16) + (size_t)li * BW;
    for (int row = gw; row < M; row += NGW) {
#pragma unroll
        for (int hh = 0; hh < 4; ++hh) { const int c = hh * 256 + 4 * F.lane;
            const f32x4 a = *(const f32x4*)(HMD + (size_t)row * BW + c), bq = *(const f32x4*)(HMD + ((size_t)MT + row) * BW + c);
            const f32x4 s = a + bq; const float ss = wave_sum((s.x * s.x + s.y * s.y) + (s.z * s.z + s.w * s.w));
            const float rstd = rsqrtf(ss * (1.0f / 256.0f) + EPS);
            const f16x4 og = *(const f16x4*)(P + (size_t)row * LDP + PO + c); const f32x4 g = *(const f32x4*)(gn + c);
            u32x2 w; w.x = pk_f16((float)og[0] * s.x * rstd * g.x, (float)og[1] * s.y * rstd * g.y); w.y = pk_f16((float)og[2] * s.z * rstd * g.z, (float)og[3] * s.w * rstd * g.w);
            *(u32x2*)(Y + (size_t)row * BW + c) = w; }
    }
}

constexpr int REP_MIX = 1, REP_L1 = 1, REP_NA = 1, REP_ML = 1; constexpr int REP_GATE = 1, REP_RES = 1, REP_BAR = 0; constexpr int REP_PRO = 1, REP_G1 = 1, REP_G3 = 1, REP_ADALN = 1, REP_LRU0 = 1, REP_FIN = 1;
constexpr int NPL = 13, PH_FINAL = 1 + DEPTH * NPL, NPHASE = PH_FINAL + 1;
__device__ __forceinline__ void ph_gemm_swiglu(int li_v, int which_v) {
    Frame F = make_frame(); const int li = UNI(li_v), which = UNI(which_v);
    unsigned char* wl = F.ws + WS_W + (size_t)li * WL_SIZE; const int M = (which == 1 && li == DEPTH - 1) ? ML : MT;
    pg8::Gemm g{WSP(f16, WS_H), (const f16*)(wl + (which ? WL_W3 : WL_W1)), M, 2 * DFF, D}; pg8::StaticOrder S; S.init(M, 2 * DFF, F.G, F.bid);
    EpiSwiGLU E{WSP(f16, WS_P)}; pg8::gemm_phase<EpiSwiGLU, pg8::StaticOrder, true, true>(F.lds, g, S, E, F.tid);
}
__device__ __forceinline__ void ph_gemm_resid(int li_v, int which_v, float cmul = 1.0f) {
    Frame F = make_frame(); const int li = UNI(li_v), which = UNI(which_v);
    unsigned char* wl = F.ws + WS_W + (size_t)li * WL_SIZE; const int M = (which >= 1 && li == DEPTH - 1) ? ML : MT;
    const float* modl = WSP(float, WS_MOD) + (size_t)li * 5 * NMODC + (2 + 3 * which) * D;
    const f16* A = which == 1 ? WSP(f16, WS_MH) : WSP(f16, WS_P); const f16* Bt = (const f16*)(wl + (which == 0 ? WL_W2 : which == 1 ? WL_WOUT : WL_W4));
    const int K = which == 1 ? D : DFF;
    pg8::Gemm g{A, Bt, M, D, K}; pg8::StaticOrder S; S.init(M, D, F.G, F.bid);
    const bool first = li == 0 && which == 0;
    const float* xl = first ? inp(0) : WSP(float, WS_X); const float* xc = first ? inp(2) - (size_t)ML * D : WSP(float, WS_X);
    EpiResid E{WSP(float, WS_X), modl, (which == 1 ? 1.0f : 0.5f) * cmul, xl, xc}; pg8::gemm_phase<EpiResid, pg8::StaticOrder, true, true>(F.lds, g, S, E, F.tid);
}
__device__ __forceinline__ void ph_gemm_proj(int li_v) {
    Frame F = make_frame(); const int li = UNI(li_v);
    unsigned char* wl = F.ws + WS_W + (size_t)li * WL_SIZE;
    pg8::Gemm g{WSP(f16, WS_H), (const f16*)(wl + WL_WIN), MT, NPIN, D}; pg8::StaticOrder S; S.init(MT, NPIN, F.G, F.bid);
    EpiProj E{WSP(f16, WS_P), WSP(float, WS_G), WSP(float, WS_ROPE)}; pg8::gemm_phase<EpiProj, pg8::StaticOrder, true, true>(F.lds, g, S, E, F.tid);
}
template <int MODE> __device__ __forceinline__ void ph_gemm_gate(int li_v) {
    Frame F = make_frame(); const int li = UNI(li_v);
    unsigned char* wl = F.ws + WS_W + (size_t)li * WL_SIZE; const int M = li == DEPTH - 1 ? ML : MT;
    const f16* Y = WSP(f16, WS_Y) + (size_t)MODE * MT * BW; const f16* wbr = (const f16*)(wl + WL_WBR) + (size_t)MODE * D * BW; const f16* gate = WSP(f16, WS_P) + GX + MODE * D;
    pg8::Gemm g{Y, wbr, M, D, BW}; pg8::StaticOrder S; S.init(M, D, F.G, F.bid);
    EpiGate<MODE> E{gate, WSP(float, WS_MF), WSP(f16, WS_MH)}; pg8::gemm_phase<EpiGate<MODE>, pg8::StaticOrder, true, true>(F.lds, g, S, E, F.tid);
}
__device__ __forceinline__ void phase_lru_p0(int li_v) {
    Frame F = make_frame(); const int li = UNI(li_v);
    if (F.bid * 8 + F.wave < 32) mlstm_gate_scan(F, li, F.bid * 8 + F.wave);
    __syncthreads();
    for (int u = F.bid; u < 4 * 36 * 8; u += F.G) lru_unit<0>(F, li, u);
}
__device__ __forceinline__ void ph_mixers(int li_v) {
    Frame F = make_frame(); const int li = UNI(li_v); const bool last = li == DEPTH - 1;
    for (int rep = 0; rep < REP_ML; ++rep) for (int u = F.bid; u < 256; u += F.G) { mlstm_unit3(F, li, u, !last); __syncthreads(); }
    __syncthreads();
    for (int rep = 0; rep < REP_NA; ++rep) { const int nna = last ? 512 : 576;
      for (int it = F.bid; it < nna; it += F.G) { const bool lat = it < 512; const int x = lat ? it : it - 512;
          const int hp = x & 3, rr = lat ? (x >> 2) & 31 : (x >> 2) & 3, b = lat ? x >> 7 : x >> 4;
          na_tile(F, li, lat, b, rr, F.wave & 3, hp * 2 + (F.wave >> 2)); }
      __syncthreads(); }
    for (int rep = 0; rep < REP_L1; ++rep) { const int nl = last ? 4 * 32 * 8 : 4 * 36 * 8;
      for (int it = F.bid; it < nl; it += F.G) { const int u = last ? (it / 256) * 288 + 32 + (it % 256) : it; lru_unit<1>(F, li, u); } }
}

__global__ void __launch_bounds__(512, 2) mega_fwd(Args args) {
    LAS unsigned char* lds = (LAS unsigned char*)lds_raw;
    const int tid = threadIdx.x;
    volatile LAS unsigned* MISC = (volatile LAS unsigned*)(lds + LDS_MISC);
    if (tid < 64) MISC[tid] = 0u;
    __syncthreads();
    unsigned* barw = (unsigned*)(args.ws + WS_CTL) + 4096;
    XcdBarrier bar; bar.bar = barw; bar.x = 0; bar.st = nullptr;
    const int lo = args.ph_lo, hi = args.ph_hi;
    if (hi - lo > 1) bar = xcd_barrier_post(barw, MISC + 8);
#define IN(k) (lo <= (k) && (k) < hi && ((PHSEL >> ((k) == 0 ? 16 : (k) == PH_FINAL ? 17 : ((k) - 1) % NPL)) & 1))
#define SEAM(k) do { if (lo <= (k) && (k) + 1 < hi) xcd_barrier(bar); } while (0)
    if (IN(0)) for (int rep = 0; rep < REP_PRO; ++rep) { phase_prologue(); __syncthreads(); }
    SEAM(0);
#pragma unroll 1
    for (int li = 0; li < DEPTH; ++li) {
        const int p0 = 1 + li * NPL;
        if (IN(p0 + 0)) for (int rep = 0; rep < REP_ADALN; ++rep) { phase_adaln(li, 0); __syncthreads(); }
        SEAM(p0 + 0); for (int rep = 0; rep < REP_BAR; ++rep) SEAM(p0 + 0);
        if (IN(p0 + 1)) for (int rep = 0; rep < REP_G1; ++rep) { ph_gemm_swiglu(li, 0); __syncthreads(); }
        SEAM(p0 + 1);
        if (IN(p0 + 2)) { ph_gemm_resid(li, 0); for (int rep = 1; rep < REP_RES; ++rep) { __syncthreads(); ph_gemm_resid(li, 0, 0.0f); } }
        SEAM(p0 + 2);
        if (IN(p0 + 3)) phase_adaln(li, 1);
        SEAM(p0 + 3);
        if (IN(p0 + 4)) for (int rep = 0; rep < REP_G3; ++rep) { ph_gemm_proj(li); __syncthreads(); }
        SEAM(p0 + 4);
        if (IN(p0 + 5)) for (int rep = 0; rep < REP_LRU0; ++rep) { phase_lru_p0(li); __syncthreads(); }
        SEAM(p0 + 5);
        if (IN(p0 + 6)) for (int rep = 0; rep < REP_MIX; ++rep) { ph_mixers(li); __syncthreads(); }
        SEAM(p0 + 6);
        if (IN(p0 + 7)) for (int rep = 0; rep < REP_FIN; ++rep) { phase_finish(li); __syncthreads(); }
        SEAM(p0 + 7);
        if (IN(p0 + 8)) for (int rep = 0; rep < REP_GATE; ++rep) { ph_gemm_gate<0>(li); ph_gemm_gate<1>(li); ph_gemm_gate<2>(li); __syncthreads(); }
        SEAM(p0 + 8);
        if (IN(p0 + 9)) ph_gemm_resid(li, 1);
        SEAM(p0 + 9);
        if (IN(p0 + 10)) phase_adaln(li, 2);
        SEAM(p0 + 10);
        if (IN(p0 + 11)) ph_gemm_swiglu(li, 1);
        SEAM(p0 + 11);
        if (IN(p0 + 12)) ph_gemm_resid(li, 2);
        SEAM(p0 + 12);
    }
    if (IN(PH_FINAL)) phase_final();
#undef IN
#undef SEAM
}

extern "C" void kernel_launch(void* const* d_in, const int* in_sizes, int n_in, void* d_out, int out_size, void* d_ws, size_t ws_size, hipStream_t stream) {
    static int grid = 0;
    if (grid == 0) {
        if (n_in != 28 || ws_size < WS_END) { fprintf(stderr, "kernel_launch: unexpected n_in %d or ws_size %zu (< %zu)\n", n_in, ws_size, (size_t)WS_END); grid = -1; return; }
        int dev = 0, cus = 0, per_cu = 0;
        if (hipGetDevice(&dev) != hipSuccess || hipDeviceGetAttribute(&cus, hipDeviceAttributeMultiprocessorCount, dev) != hipSuccess) { grid = -1; return; }
        if (hipFuncSetAttribute((const void*)mega_fwd, hipFuncAttributeMaxDynamicSharedMemorySize, LDS_BYTES) != hipSuccess) { fprintf(stderr, "kernel_launch: hipFuncSetAttribute failed\n"); grid = -1; return; }
        if (hipOccupancyMaxActiveBlocksPerMultiprocessor(&per_cu, (const void*)mega_fwd, 512, LDS_BYTES) != hipSuccess || per_cu < 1) fprintf(stderr, "kernel_launch: occupancy query says %d\n", per_cu);
        (void)hipGetLastError();
        grid = cus;
    }
    if (grid < 0) return;
    (void)hipMemsetAsync((char*)d_ws + WS_CTL, 0, 2 * MiB, stream);
    Args a{};
    for (int i = 0; i < 28; ++i) a.in[i] = (const float*)d_in[i];
    a.out = (float*)d_out; a.ws = (unsigned char*)d_ws;
#if MK_ONE_LAUNCH
    a.ph_lo = 0; a.ph_hi = NPHASE;
    hipLaunchKernelGGL(mega_fwd, dim3(grid), dim3(512), LDS_BYTES, stream, a);
#else
    for (int p = 0; p < NPHASE; ++p) { a.ph_lo = p; a.ph_hi = p + 1; hipLaunchKernelGGL(mega_fwd, dim3(grid), dim3(512), LDS_BYTES, stream, a); }
#endif
}
```

```cpp
#include <hip/hip_runtime.h>
#include <cstdio>
#include <cstdint>

#define LAS __attribute__((address_space(3)))
typedef _Float16 f16;
typedef _Float16 f16x8 __attribute__((ext_vector_type(8)));
typedef _Float16 f16x4 __attribute__((ext_vector_type(4)));
typedef _Float16 f16x2 __attribute__((ext_vector_type(2)));
typedef float f32x4 __attribute__((ext_vector_type(4)));
typedef float f32x2 __attribute__((ext_vector_type(2)));
typedef unsigned u32x4 __attribute__((ext_vector_type(4)));
typedef unsigned u32x2 __attribute__((ext_vector_type(2)));

#ifndef PHSEL
#define PHSEL 0xFFFFF
#endif
#ifndef MK_ONE_LAUNCH
#define MK_ONE_LAUNCH 1
#endif

constexpr int D = 2048, NB = 4, SEQ = 2048, CTXL = 256, DEPTH = 2, DFF = 5632, BW = 1024;
constexpr int ML = NB * SEQ, MC = NB * CTXL, MT = ML + MC;
constexpr int NMODC = 9 * D;
constexpr int PIN_SRC = 15376;
constexpr int NPIN = 15616;
constexpr int LDP = 15360;
constexpr int PQ = 0, PK = 1024, PV = 2048, PO = 3072, NQ = 4096, NK = 5120, NV = 6144, LX = 7168, LG = 8192, GX = 9216;
constexpr float EPS = 1e-6f;

constexpr size_t MiB = 1u << 20;
constexpr size_t WS_CTL = 0;
constexpr size_t WS_MOD = 1 * MiB;
constexpr size_t WS_ROPE = 2 * MiB;
constexpr size_t WS_G = 3 * MiB;
constexpr size_t WS_W = 4 * MiB;
constexpr size_t WL_W1 = 0, WL_W2 = 44 * MiB, WL_W3 = 66 * MiB, WL_W4 = 110 * MiB, WL_WIN = 132 * MiB, WL_WBR = 193 * MiB, WL_WOUT = 205 * MiB, WL_SIZE = 213 * MiB;
constexpr size_t WS_X = WS_W + 2 * WL_SIZE;
constexpr size_t WS_H = WS_X + 72 * MiB;
constexpr size_t WS_P = WS_H + 36 * MiB;
constexpr size_t WS_Y = WS_P + 270 * MiB;
constexpr size_t WS_HMD = WS_Y + 54 * MiB;
constexpr size_t WS_LA = WS_HMD + 72 * MiB;
constexpr size_t WS_LU = WS_LA + 72 * MiB;
constexpr size_t WS_HL = WS_LU + 72 * MiB;
constexpr size_t WS_MF = WS_LA;
constexpr size_t WS_MH = WS_LU;
constexpr size_t WS_WLRU = WS_HL + 72 * MiB;
constexpr size_t WS_LSUM = WS_WLRU + 2 * MiB;
constexpr size_t WS_GS = WS_LSUM + 3 * MiB;
constexpr size_t WS_END = WS_GS + 2 * MiB;

constexpr int LDS_BYTES = 147456;
constexpr int LDS_MISC = 147200;

__device__ __forceinline__ unsigned pk_f16(float lo, float hi) { f32x2 v = {lo, hi}; f16x2 h = __builtin_convertvector(v, f16x2); return __builtin_bit_cast(unsigned, h); }
__device__ __forceinline__ float wave_sum(float v) {
#pragma unroll
    for (int o = 1; o < 64; o <<= 1) v += __shfl_xor(v, o);
    return v;
}
__device__ __forceinline__ float wave_max(float v) {
#pragma unroll
    for (int o = 1; o < 64; o <<= 1) v = fmaxf(v, __shfl_xor(v, o));
    return v;
}
__device__ __forceinline__ float sigmoidf_(float x) { return 1.0f / (1.0f + __expf(-x)); }
__device__ __forceinline__ float siluf_(float x) { return x / (1.0f + __expf(-x)); }
__device__ __forceinline__ float gelu_tanh_(float x) { const float z = 0.7978845608028654f * (x + 0.044715f * x * x * x); const float e = __expf(2.0f * z); return 0.5f * x * (1.0f + (1.0f - 2.0f / (e + 1.0f))); }
#define LDS_WAIT() asm volatile("s_waitcnt lgkmcnt(0)" ::: "memory")
__device__ __forceinline__ f32x4 mfma16(f16x8 a, f16x8 b, f32x4 c) { return __builtin_amdgcn_mfma_f32_16x16x32_f16(a, b, c, 0, 0, 0); }

typedef __fp16 fp16x4v __attribute__((__vector_size__(8)));
__device__ __forceinline__ f16x4 lds_tr4(const LAS f16* p) { return __builtin_bit_cast(f16x4, __builtin_amdgcn_ds_read_tr16_b64_v4f16((LAS fp16x4v*)p)); }

#define XB_TMO      128
#define XB_XCNT(j)  (256  + 64 * (j))
#define XB_XSUB(j)  (1280 + 64 * (j))
#define XB_XGEN(j)  (2304 + 64 * (j))
#define XB_TOP      3328
#define XB_TOPGEN   3392
#define XCD_BAR_WORDS 3456
#define XB_SPIN_CAP (1u << 25)
__device__ __forceinline__ unsigned xb_ld(unsigned* p)              { return __hip_atomic_load(p, __ATOMIC_RELAXED, __HIP_MEMORY_SCOPE_AGENT); }
__device__ __forceinline__ unsigned xb_add(unsigned* p, unsigned v) { return __hip_atomic_fetch_add(p, v, __ATOMIC_RELAXED, __HIP_MEMORY_SCOPE_AGENT); }
__device__ __forceinline__ unsigned xb_xcc_id() { return (unsigned)__builtin_amdgcn_s_getreg((3 << 11) | 20) & 0xFu; }
#define XB_SPIN(cond, bar) do { unsigned _sp = 0; while (cond) { __builtin_amdgcn_s_sleep(1); \
    if ((++_sp & 255u) == 0u) { if (xb_ld(&(bar)[XB_TMO])) break; if (_sp > XB_SPIN_CAP) { atomicAdd(&(bar)[XB_TMO], 1u); break; } } } } while (0)
struct XcdBarrier { unsigned* bar; unsigned x; volatile LAS unsigned* st; };
__device__ __forceinline__ XcdBarrier xcd_barrier_post(unsigned* bar, volatile LAS unsigned* st) {
    XcdBarrier b; b.bar = bar; b.x = xb_xcc_id(); b.st = st;
    if (threadIdx.x == 0) (void)xb_add(&bar[XB_XCNT(b.x)], 1u);
    return b;
}
__device__ __forceinline__ void xcd_barrier_complete(unsigned* bar, unsigned x, unsigned& nloc, unsigned& nx) {
    const unsigned G = gridDim.x * gridDim.y * gridDim.z;
    unsigned sum, cnt, mine, sp = 0u;
    for (;;) {
        sum = 0u; cnt = 0u; mine = 0u;
#pragma unroll
        for (unsigned j = 0; j < 16; ++j) { const unsigned c = xb_ld(&bar[XB_XCNT(j)]); sum += c; cnt += (c > 0u) ? 1u : 0u; mine = (j == x) ? c : mine; }
        if (sum == G) break;
        __builtin_amdgcn_s_sleep(1);
        if ((++sp & 255u) == 0u) { if (xb_ld(&bar[XB_TMO])) break; if (sp > XB_SPIN_CAP) { atomicAdd(&bar[XB_TMO], 1u); break; } }
    }
    nloc = mine > 0u ? mine : 1u; nx = cnt > 0u ? cnt : 1u;
}
__device__ __forceinline__ void xcd_barrier(const XcdBarrier& b) {
    asm volatile("s_waitcnt vmcnt(0)" ::: "memory");
    __syncthreads();
    if (threadIdx.x == 0) {
        unsigned* bar = b.bar;
        __builtin_amdgcn_s_waitcnt(0);
        unsigned nloc = b.st[0], nx = b.st[1];
        if (nloc == 0u) { xcd_barrier_complete(bar, b.x, nloc, nx); b.st[0] = nloc; b.st[1] = nx; }
        const unsigned old = xb_add(&bar[XB_XSUB(b.x)], 1u);
        const unsigned gen = old / nloc;
        if (old + 1u == (gen + 1u) * nloc) {
            __builtin_amdgcn_fence(__ATOMIC_RELEASE, "agent");
            asm volatile("s_waitcnt vmcnt(0)" ::: "memory");
            const unsigned og = xb_add(&bar[XB_TOP], 1u);
            const unsigned tg = og / nx;
            if (og + 1u == (tg + 1u) * nx) xb_add(&bar[XB_TOPGEN], 1u);
            else XB_SPIN(xb_ld(&bar[XB_TOPGEN]) == tg, bar);
            __builtin_amdgcn_fence(__ATOMIC_ACQUIRE, "agent");
            xb_add(&bar[XB_XGEN(b.x)], 1u);
            asm volatile("s_waitcnt vmcnt(0)" ::: "memory");
        } else {
            XB_SPIN(xb_ld(&bar[XB_XGEN(b.x)]) == gen, bar);
            __builtin_amdgcn_fence(__ATOMIC_ACQUIRE, "agent");
            asm volatile("s_waitcnt vmcnt(0)" ::: "memory");
        }
    }
    __syncthreads();
}

namespace pg8 {
constexpr int BM = 256, BK = 64, HALF = 128, HTB = HALF * BK * 2, STAGE_BYTES = 8 * HTB, NXCD = 8, WGM = 8;
__host__ __device__ __forceinline__ int lds_byte(int r, int c) { const int st = (r >> 4) * 2 + (c >> 5), rr = r & 15, cc = c & 31, ob = rr * 64 + cc * 2; return st * 1024 + (ob ^ (((ob >> 9) & 1) << 5)); }
__host__ __device__ __forceinline__ void stage_rc(int b, int& R, int& C) { const int st = b / 1024, sb = b % 1024, swz = sb ^ (((sb >> 9) & 1) << 5); R = (st >> 1) * 16 + swz / 64; C = (st & 1) * 32 + (swz % 64) / 2; }
__host__ __device__ __forceinline__ int perm32(int rho) { const int n = rho >> 4, i = rho & 15; return 8 * (i >> 2) + 4 * n + (i & 3); }
struct Unit { int pm, pn, kp; };
struct Gemm { const f16* A; const f16* Bt; int M, N, K, ld; };
struct StaticOrder {
    int nM, nN, nwg, G, c;
    __host__ __device__ void init(int M, int N, int G_, int c_) { nM = M / BM; nN = N / BM; nwg = nM * nN; G = G_; c = c_; }
    __host__ __device__ bool next(int i, Unit& u) const {
        const long L = (long)i * G + c; if (L >= nwg) return false;
        int wgid = (int)L; { const int q = nwg / NXCD, r = nwg % NXCD, xcd = wgid % NXCD, off = wgid / NXCD; wgid = (xcd < r ? xcd * (q + 1) : r * (q + 1) + (xcd - r) * q) + off; }
        const int nig = WGM * nN, gid = wgid / nig, fm = gid * WGM, gsz = (nM - fm) < WGM ? (nM - fm) : WGM;
        u.pm = fm + ((wgid % nig) % gsz); u.pn = (wgid % nig) / gsz; u.kp = 0; return true;
    }
    __device__ __forceinline__ void a_ready(const Unit&) const {}
    __device__ __forceinline__ void done(const Unit&) const {}
};
struct ProjLastOrder {
    int G, c;
    __device__ bool next(int i, Unit& u) const {
        const int L = i * G + c; u.kp = 0;
        if (L < 32 * 61) { const int grp = L / (8 * 61), rem = L % (8 * 61); u.pm = grp * 8 + (rem & 7); u.pn = rem >> 3; return true; }
        const int x = L - 32 * 61; if (x >= 4 * 21) return false;
        u.pm = 32 + (x & 3); const int t = x >> 2; u.pn = t < 8 ? 4 + t : (t < 20 ? 20 + (t - 8) : 60); return true;
    }
    __device__ __forceinline__ void a_ready(const Unit&) const {}
    __device__ __forceinline__ void done(const Unit&) const {}
};
struct CtxSplitOrder {
    int c;
    __device__ bool next(int i, Unit& u) const { if (i > 0 || c >= 128) return false; u.kp = c & 3; const int t = c >> 2; u.pm = 32 + (t >> 3); u.pn = t & 7; return true; }
    __device__ __forceinline__ void a_ready(const Unit&) const {}
    __device__ __forceinline__ void done(const Unit&) const {}
};
template <class Epi, class Sched, bool ALIGN_EPI = false, bool SP2 = false>
__device__ __forceinline__ void gemm_phase(LAS unsigned char* lds, const Gemm g, const Sched& S, const Epi& E, const int tid) {
    const int wid = __builtin_amdgcn_readfirstlane(tid >> 6), lane = tid & 63, wr = wid >> 2, wc = wid & 3, fr = lane & 15, fq = lane >> 4;
    const int K = g.K, nt = K / BK;
    unsigned voffA[2], voffB[2];
#pragma unroll
    for (int i = 0; i < 2; ++i) { int R, C; stage_rc(tid * 16 + i * 8192, R, C); const int Rb = Epi::PERM ? ((R & ~31) + perm32(R & 31)) : R;
        voffA[i] = (unsigned)(R * g.ld + C) * 2u; voffB[i] = (unsigned)(Rb * g.ld + C) * 2u; }
    const size_t kstep = (size_t)(BK * 2);
    const size_t hstep = (size_t)HALF * g.ld * 2;
    const size_t tstep = 2 * hstep;
    const unsigned ldsw = (unsigned)wid * 1024u;
    const int aoff = lds_byte(wr * 64 + fr, fq * 8), boff = lds_byte(wc * 32 + fr, fq * 8);
#define PG8_SA(b, h) (((b) * 2 + (h)) * HTB)
#define PG8_SB(b, h) ((4 + (b) * 2 + (h)) * HTB)
#define PG8_STAGE(bufoff, gbase, voff) do { _Pragma("unroll") for (int _i = 0; _i < 2; ++_i) \
        __builtin_amdgcn_global_load_lds((const unsigned*)((const char*)(gbase) + (voff)[_i]), (LAS unsigned*)(lds + (bufoff) + ldsw + _i * 8192), 16, 0, 0); } while (0)
#define PG8_LDA(dst, b, h) do { _Pragma("unroll") for (int m = 0; m < 4; ++m) _Pragma("unroll") for (int k = 0; k < 2; ++k) dst[m][k] = *(const LAS f16x8*)(lds + PG8_SA(b, h) + aoff + m * 2048 + k * 1024); } while (0)
#define PG8_LDB(dst, b, h) do { _Pragma("unroll") for (int n = 0; n < 2; ++n) _Pragma("unroll") for (int k = 0; k < 2; ++k) dst[n][k] = *(const LAS f16x8*)(lds + PG8_SB(b, h) + boff + n * 2048 + k * 1024); } while (0)
#define PG8_MMA(ai, bj, At, Bt) do { __builtin_amdgcn_s_setprio(1); _Pragma("unroll") for (int m = 0; m < 4; ++m) _Pragma("unroll") for (int n = 0; n < 2; ++n) _Pragma("unroll") for (int k = 0; k < 2; ++k) \
        acc[ai][bj][m][n] = __builtin_amdgcn_mfma_f32_16x16x32_f16(Bt[n][k], At[m][k], acc[ai][bj][m][n], 0, 0, 0); __builtin_amdgcn_s_setprio(0); } while (0)
#define PG8_WAIT_V(n) asm volatile("s_waitcnt vmcnt(" #n ")" ::: "memory")
#define PG8_WAIT_L(n) asm volatile("s_waitcnt lgkmcnt(" #n ")" ::: "memory")
#define PG8_BAR __builtin_amdgcn_s_barrier()
#define PG8_SCHED __builtin_amdgcn_sched_barrier(0)
    Unit cur, nxt; int ui = 0;
    if (!S.next(0, cur)) return;
    f32x4 acc[2][2][4][2];
#pragma unroll
    for (int a = 0; a < 2; ++a)
#pragma unroll
        for (int b = 0; b < 2; ++b)
#pragma unroll
            for (int m = 0; m < 4; ++m)
#pragma unroll
                for (int n = 0; n < 2; ++n) acc[a][b][m][n] = (f32x4){0.f, 0.f, 0.f, 0.f};
    f16x8 At[4][2], B0[2][2], B1[2][2];
    const char* cA = (const char*)g.A + (size_t)cur.pm * tstep + (size_t)cur.kp * K * 2; const char* cB = (const char*)g.Bt + (size_t)cur.pn * tstep + (size_t)cur.kp * K * 2;
    S.a_ready(cur);
    if constexpr (SP2) {
        PG8_STAGE(PG8_SB(0, 0), cB, voffB); PG8_STAGE(PG8_SB(0, 1), cB + hstep, voffB); PG8_STAGE(PG8_SA(0, 0), cA, voffA); PG8_STAGE(PG8_SA(0, 1), cA + hstep, voffA);
        if (wr == 1) PG8_BAR;
        PG8_WAIT_V(2); PG8_BAR;
        PG8_STAGE(PG8_SB(1, 0), cB + kstep, voffB); PG8_STAGE(PG8_SA(1, 0), cA + kstep, voffA); PG8_STAGE(PG8_SB(1, 1), cB + hstep + kstep, voffB);
        PG8_WAIT_V(6); PG8_BAR;
    } else {
        PG8_STAGE(PG8_SB(0, 0), cB, voffB); PG8_STAGE(PG8_SA(0, 0), cA, voffA); PG8_STAGE(PG8_SB(0, 1), cB + hstep, voffB); PG8_STAGE(PG8_SA(0, 1), cA + hstep, voffA);
        if (wr == 1) PG8_BAR;
        PG8_WAIT_V(4); PG8_BAR;
        PG8_STAGE(PG8_SB(1, 0), cB + kstep, voffB); PG8_STAGE(PG8_SA(1, 0), cA + kstep, voffA); PG8_STAGE(PG8_SB(1, 1), cB + hstep + kstep, voffB);
        PG8_WAIT_V(6); PG8_BAR;
    }
    for (;;) {
        const bool has_next = S.next(ui + 1, nxt);
        const char* nA = has_next ? (const char*)g.A + (size_t)nxt.pm * tstep + (size_t)nxt.kp * K * 2 : cA; const char* nB = has_next ? (const char*)g.Bt + (size_t)nxt.pn * tstep + (size_t)nxt.kp * K * 2 : cB;
        for (int t = 0; t < nt; t += 2) {
            const bool last = (t == nt - 2);
            const char* a1 = cA + (size_t)(t + 1) * kstep;
            const char* a2 = last ? nA : cA + (size_t)(t + 2) * kstep; const char* b2 = last ? nB : cB + (size_t)(t + 2) * kstep;
            const char* a3 = a2 + kstep; const char* b3 = b2 + kstep;
            if (last && has_next) S.a_ready(nxt);
            if constexpr (SP2) {
            PG8_LDB(B0, 0, 0); PG8_LDB(B1, 0, 1); PG8_SCHED; PG8_LDA(At, 0, 0); PG8_STAGE(PG8_SA(1, 1), a1 + hstep, voffA);
            PG8_WAIT_V(8); PG8_WAIT_L(0); PG8_BAR; PG8_MMA(0, 0, At, B0); PG8_MMA(0, 1, At, B1); PG8_BAR; PG8_SCHED;
            PG8_LDA(At, 0, 1); PG8_STAGE(PG8_SB(0, 0), b2, voffB); PG8_STAGE(PG8_SB(0, 1), b2 + hstep, voffB); PG8_STAGE(PG8_SA(0, 0), a2, voffA);
            PG8_WAIT_V(8); PG8_WAIT_L(0); PG8_BAR; PG8_MMA(1, 0, At, B0); PG8_MMA(1, 1, At, B1); PG8_BAR; PG8_SCHED;
            PG8_LDB(B0, 1, 0); PG8_LDB(B1, 1, 1); PG8_SCHED; PG8_LDA(At, 1, 0); PG8_STAGE(PG8_SA(0, 1), a2 + hstep, voffA);
            PG8_WAIT_V(8); PG8_WAIT_L(0); PG8_BAR; PG8_MMA(0, 0, At, B0); PG8_MMA(0, 1, At, B1); PG8_BAR; PG8_SCHED;
            PG8_LDA(At, 1, 1); PG8_STAGE(PG8_SB(1, 0), b3, voffB); PG8_STAGE(PG8_SB(1, 1), b3 + hstep, voffB); PG8_STAGE(PG8_SA(1, 0), a3, voffA);
            PG8_WAIT_V(8); PG8_WAIT_L(0); PG8_BAR; PG8_MMA(1, 0, At, B0); PG8_MMA(1, 1, At, B1); PG8_BAR; PG8_SCHED;
            } else {
            PG8_LDB(B0, 0, 0); PG8_SCHED; PG8_LDA(At, 0, 0); PG8_STAGE(PG8_SA(1, 1), a1 + hstep, voffA);
            PG8_WAIT_L(8); PG8_BAR; PG8_WAIT_L(0); PG8_MMA(0, 0, At, B0); PG8_BAR; PG8_SCHED;
            PG8_LDB(B1, 0, 1); PG8_STAGE(PG8_SB(0, 0), b2, voffB);
            PG8_BAR; PG8_WAIT_L(0); PG8_MMA(0, 1, At, B1); PG8_BAR;
            PG8_LDA(At, 0, 1); PG8_STAGE(PG8_SA(0, 0), a2, voffA);
            PG8_BAR; PG8_WAIT_L(0); PG8_MMA(1, 0, At, B0); PG8_BAR; PG8_SCHED;
            PG8_STAGE(PG8_SB(0, 1), b2 + hstep, voffB);
            PG8_WAIT_V(6); PG8_BAR; PG8_MMA(1, 1, At, B1); PG8_BAR;
            PG8_LDB(B0, 1, 0); PG8_SCHED; PG8_LDA(At, 1, 0); PG8_STAGE(PG8_SA(0, 1), a2 + hstep, voffA);
            PG8_WAIT_L(8); PG8_BAR; PG8_WAIT_L(0); PG8_MMA(0, 0, At, B0); PG8_BAR; PG8_SCHED;
            PG8_LDB(B1, 1, 1); PG8_STAGE(PG8_SB(1, 0), b3, voffB);
            PG8_BAR; PG8_WAIT_L(0); PG8_MMA(0, 1, At, B1); PG8_BAR;
            PG8_LDA(At, 1, 1); PG8_STAGE(PG8_SA(1, 0), a3, voffA);
            PG8_BAR; PG8_WAIT_L(0); PG8_MMA(1, 0, At, B0); PG8_BAR; PG8_SCHED;
            PG8_STAGE(PG8_SB(1, 1), b3 + hstep, voffB);
            PG8_WAIT_V(6); PG8_BAR; PG8_MMA(1, 1, At, B1); PG8_BAR;
            }
        }
        if constexpr (ALIGN_EPI) { if (wr == 0) PG8_BAR; }
        E(acc, cur, wr, wc, fr, fq); S.done(cur);
        if (!has_next) break;
#pragma unroll
        for (int a = 0; a < 2; ++a)
#pragma unroll
            for (int b = 0; b < 2; ++b)
#pragma unroll
                for (int m = 0; m < 4; ++m)
#pragma unroll
                    for (int n = 0; n < 2; ++n) acc[a][b][m][n] = (f32x4){0.f, 0.f, 0.f, 0.f};
        cur = nxt; cA = nA; cB = nB; ++ui;
        if constexpr (ALIGN_EPI) { if (wr == 1) PG8_BAR; }
    }
    PG8_WAIT_V(0);
    if constexpr (!ALIGN_EPI) { if (wr == 0) PG8_BAR; }
    PG8_BAR;
#undef PG8_SA
#undef PG8_SB
#undef PG8_STAGE
#undef PG8_LDA
#undef PG8_LDB
#undef PG8_MMA
#undef PG8_WAIT_V
#undef PG8_WAIT_L
#undef PG8_BAR
#undef PG8_SCHED
}
}
using pg8::Unit;
constexpr int HALF = pg8::HALF, BM = pg8::BM;

struct EpiSwiGLU {
    static constexpr bool PERM = true;
    f16* O;
    __device__ __forceinline__ void operator()(const f32x4 (&acc)[2][2][4][2], const Unit& u, int wr, int wc, int fr, int fq) const {
        asm volatile("" : "+v"(fr), "+v"(fq));
        const int row0 = u.pm * BM + wr * 64 + fr, col0 = u.pn * HALF + wc * 32 + 8 * fq;
#pragma unroll
        for (int ai = 0; ai < 2; ++ai)
#pragma unroll
            for (int m = 0; m < 4; ++m) {
                f16* rowp = O + (size_t)(row0 + ai * HALF + m * 16) * DFF + col0;
                const f32x4 g0 = acc[ai][0][m][0], g1 = acc[ai][0][m][1], u0 = acc[ai][1][m][0], u1 = acc[ai][1][m][1];
                u32x4 w;
                w.x = pk_f16(siluf_(g0[0]) * u0[0], siluf_(g0[1]) * u0[1]); w.y = pk_f16(siluf_(g0[2]) * u0[2], siluf_(g0[3]) * u0[3]);
                w.z = pk_f16(siluf_(g1[0]) * u1[0], siluf_(g1[1]) * u1[1]); w.w = pk_f16(siluf_(g1[2]) * u1[2], siluf_(g1[3]) * u1[3]);
                *(u32x4*)rowp = w;
            }
    }
};
struct EpiResid {
    static constexpr bool PERM = false;
    float* X; const float* modg;
    float coef; const float* XinL; const float* XinC;
    __device__ __forceinline__ void operator()(const f32x4 (&acc)[2][2][4][2], const Unit& u, int wr, int wc, int fr, int fq) const {
        asm volatile("" : "+v"(fr), "+v"(fq));
        const int row0 = u.pm * BM + wr * 64 + fr, col0 = u.pn * BM + wc * 32 + 4 * fq;
        const int bidx = u.pm < 32 ? (u.pm >> 3) : 4;
        const float* gp = modg + (size_t)bidx * NMODC + col0;
        f32x4 gv[2][2];
#pragma unroll
        for (int bj = 0; bj < 2; ++bj)
#pragma unroll
            for (int n = 0; n < 2; ++n) gv[bj][n] = *(const f32x4*)(gp + bj * HALF + n * 16) * coef;
#pragma unroll
        for (int ai = 0; ai < 2; ++ai)
#pragma unroll
            for (int m = 0; m < 4; ++m) { const size_t ro = (size_t)(row0 + ai * HALF + m * 16) * D + col0; float* rowp = X + ro; const float* inp_ = (u.pm < 32 ? XinL : XinC) + ro;
#pragma unroll
                for (int bj = 0; bj < 2; ++bj)
#pragma unroll
                    for (int n = 0; n < 2; ++n) { *(f32x4*)(rowp + bj * HALF + n * 16) = *(const f32x4*)(inp_ + bj * HALF + n * 16) + gv[bj][n] * acc[ai][bj][m][n]; } }
    }
};
struct EpiResidPart {
    static constexpr bool PERM = false;
    float* PART; const float* modg; float coef;
    __device__ __forceinline__ void operator()(const f32x4 (&acc)[2][2][4][2], const Unit& u, int wr, int wc, int fr, int fq) const {
        asm volatile("" : "+v"(fr), "+v"(fq));
        const int row0 = (u.pm - 32) * BM + wr * 64 + fr, col0 = u.pn * BM + wc * 32 + 4 * fq;
        const float* gp = modg + (size_t)4 * NMODC + col0;
        f32x4 gv[2][2];
#pragma unroll
        for (int bj = 0; bj < 2; ++bj)
#pragma unroll
            for (int n = 0; n < 2; ++n) gv[bj][n] = *(const f32x4*)(gp + bj * HALF + n * 16) * coef;
#pragma unroll
        for (int ai = 0; ai < 2; ++ai)
#pragma unroll
            for (int m = 0; m < 4; ++m) { float* rowp = PART + ((size_t)u.kp * MC + row0 + ai * HALF + m * 16) * D + col0;
#pragma unroll
                for (int bj = 0; bj < 2; ++bj)
#pragma unroll
                    for (int n = 0; n < 2; ++n) *(f32x4*)(rowp + bj * HALF + n * 16) = gv[bj][n] * acc[ai][bj][m][n]; }
    }
};
struct EpiProj {
    static constexpr bool PERM = true;
    f16* P; float* G; const float* rope;
    __device__ __forceinline__ void operator()(const f32x4 (&acc)[2][2][4][2], const Unit& u, int wr, int wc, int fr, int fq) const {
        asm volatile("" : "+v"(fr), "+v"(fq));
        const int row0 = u.pm * BM + wr * 64 + fr; const int pn = u.pn;
        if (pn == 60) {
            if (wc == 0 && fq < 2) {
#pragma unroll
                for (int ai = 0; ai < 2; ++ai)
#pragma unroll
                    for (int m = 0; m < 4; ++m) { float* gp = G + (size_t)(row0 + ai * HALF + m * 16) * 16 + 8 * fq;
                        *(f32x4*)gp = acc[ai][0][m][0]; *(f32x4*)(gp + 4) = acc[ai][0][m][1]; }
            }
            return;
        }
        const int col0 = pn * BM + wc * 32 + 8 * fq;
        int mode = 0; float scl = 1.0f;
        if (pn < 8) { mode = (u.pm < 32) ? 1 : 2; scl = (pn >= 4) ? 0.0625f : 1.0f; }
        else if (pn >= 12 && pn < 16) mode = 3;
        else if (pn >= 16 && pn < 20) { mode = 2; scl = 0.08838834764831845f; }
        else if (pn >= 32 && pn < 36) mode = 4;
        else if (pn >= 36) mode = 3;
#pragma unroll
        for (int ai = 0; ai < 2; ++ai)
#pragma unroll
            for (int m = 0; m < 4; ++m) {
                const int row = row0 + ai * HALF + m * 16;
                f16* rowp = P + (size_t)row * LDP + col0;
#pragma unroll
                for (int bj = 0; bj < 2; ++bj) {
                    f32x4 v0 = acc[ai][bj][m][0], v1 = acc[ai][bj][m][1];
                    if (mode == 1) {
                        const int t = row & (SEQ - 1); const int pos = bj == 0 ? (t >> 6) : (t & 63);
                        const float* cp = rope + pos * 64 + 16 * wc + 4 * fq;
                        const f32x4 c = *(const f32x4*)cp, s = *(const f32x4*)(cp + 4096);
                        f32x4 o0, o1;
                        o0[0] = v0[0] * c[0] - v0[1] * s[0]; o0[1] = v0[0] * s[0] + v0[1] * c[0];
                        o0[2] = v0[2] * c[1] - v0[3] * s[1]; o0[3] = v0[2] * s[1] + v0[3] * c[1];
                        o1[0] = v1[0] * c[2] - v1[1] * s[2]; o1[1] = v1[0] * s[2] + v1[1] * c[2];
                        o1[2] = v1[2] * c[3] - v1[3] * s[3]; o1[3] = v1[2] * s[3] + v1[3] * c[3];
                        v0 = o0 * scl; v1 = o1 * scl;
                    } else if (mode == 2) { v0 = v0 * scl; v1 = v1 * scl; }
                    else if (mode == 3) {
#pragma unroll
                        for (int e = 0; e < 4; ++e) { v0[e] = sigmoidf_(v0[e]); v1[e] = sigmoidf_(v1[e]); }
                    } else if (mode == 4) {
#pragma unroll
                        for (int e = 0; e < 4; ++e) { v0[e] = gelu_tanh_(v0[e]); v1[e] = gelu_tanh_(v1[e]); }
                    }
                    u32x4 w; w.x = pk_f16(v0[0], v0[1]); w.y = pk_f16(v0[2], v0[3]); w.z = pk_f16(v1[0], v1[1]); w.w = pk_f16(v1[2], v1[3]);
                    *(u32x4*)(rowp + bj * HALF) = w;
                }
            }
    }
};
template <int MODE> struct EpiGate {
    static constexpr bool PERM = true;
    const f16* gate;
    float* MF; f16* MH;
    __device__ __forceinline__ void operator()(const f32x4 (&acc)[2][2][4][2], const Unit& u, int wr, int wc, int fr, int fq) const {
        asm volatile("" : "+v"(fr), "+v"(fq));
        const int row0 = u.pm * BM + wr * 64 + fr, col0 = u.pn * BM + wc * 32 + 8 * fq;
#pragma unroll
        for (int ai = 0; ai < 2; ++ai)
#pragma unroll
            for (int m = 0; m < 4; ++m) {
                const int row = row0 + ai * HALF + m * 16;
#pragma unroll
                for (int bj = 0; bj < 2; ++bj) {
                    const f16x8 gh = *(const f16x8*)(gate + (size_t)row * LDP + col0 + bj * HALF);
                    float* mp = MF + (size_t)row * D + col0 + bj * HALF;
                    f32x4 v0 = acc[ai][bj][m][0], v1 = acc[ai][bj][m][1];
#pragma unroll
                    for (int e = 0; e < 4; ++e) { v0[e] *= (float)gh[e]; v1[e] *= (float)gh[4 + e]; }
                    if (MODE >= 1) { v0 = v0 + *(const f32x4*)mp; v1 = v1 + *(const f32x4*)(mp + 4); }
                    if (MODE <= 1) { *(f32x4*)mp = v0; *(f32x4*)(mp + 4) = v1; }
                    else { u32x4 w; w.x = pk_f16(v0[0], v0[1]); w.y = pk_f16(v0[2], v0[3]); w.z = pk_f16(v1[0], v1[1]); w.w = pk_f16(v1[2], v1[3]);
                        *(u32x4*)(MH + (size_t)row * D + col0 + bj * HALF) = w; }
                }
            }
    }
};

struct Args { const float* in[28]; float* out; unsigned char* ws; int ph_lo, ph_hi; };
struct Frame {
    LAS unsigned char* lds; int tid, lane, wave, G, bid;
    float* out; unsigned char* ws;
};
typedef const Args __attribute__((address_space(4)))* KArgs;
__device__ __forceinline__ KArgs kargs() { return (KArgs)__builtin_amdgcn_kernarg_segment_ptr(); }
__device__ __forceinline__ const float* inp(int k) { return kargs()->in[k]; }
extern __shared__ __attribute__((aligned(16))) unsigned char lds_raw[];
__device__ __forceinline__ Frame make_frame() {
    Frame F; F.lds = (LAS unsigned char*)lds_raw; int t = threadIdx.x; asm volatile("" : "+v"(t));
    F.tid = t; F.lane = F.tid & 63; F.wave = __builtin_amdgcn_readfirstlane(F.tid >> 6);
    int g = gridDim.x, b = blockIdx.x; asm volatile("" : "+s"(g), "+s"(b)); F.G = g; F.bid = b;
    KArgs ka = kargs(); asm volatile("" : "+s"(ka)); F.out = ka->out; F.ws = ka->ws; return F;
}
#define UNI(x) __builtin_amdgcn_readfirstlane(x)
#define WSP(T, off) ((T*)(F.ws + (off)))

__device__ __forceinline__ void transpose_item(const float* W, int ldw, int k0, int srccol, f16* WT, int Kdim, int drow0, LAS float* scr, int lane) {
#pragma unroll 8
    for (int i = 0; i < 32; ++i) { const int kk = 2 * i + (lane >> 5); scr[kk * 33 + (lane & 31)] = srccol >= 0 ? W[(size_t)(k0 + kk) * ldw + srccol] : 0.0f; }
    LDS_WAIT();
    const int c = lane & 7;
#pragma unroll
    for (int j = 0; j < 4; ++j) { const int n = (lane >> 3) + 8 * j; const LAS float* s = scr + (8 * c) * 33 + n;
        u32x4 o; o.x = pk_f16(s[0 * 33], s[1 * 33]); o.y = pk_f16(s[2 * 33], s[3 * 33]); o.z = pk_f16(s[4 * 33], s[5 * 33]); o.w = pk_f16(s[6 * 33], s[7 * 33]);
        *(u32x4*)(WT + (size_t)(drow0 + n) * Kdim + k0 + 8 * c) = o; }
    LDS_WAIT();
}
__device__ __forceinline__ int win_src(int dr) {
    if (dr < 2048) { const int base = dr < 1024 ? 0 : 1024, w = dr & 1023, h = w >> 8, x = w & 255, bj = x >> 7, within = x & 127, i = within >> 1, e = within & 1; return base + h * 256 + bj * 128 + e * 64 + i; }
    if (dr < 4096) return dr;
    if (dr < 15360) return dr + 16;
    const int w = dr - 15360; return w < 16 ? 4096 + w : -1;
}
template <int MAP> __device__ __forceinline__ int dest_row(int c) {
    if (MAP == 0) return c;
    if (MAP == 1) { const int bj = c >= DFF ? 1 : 0, j = c - bj * DFF; return (j >> 7) * 256 + bj * 128 + (j & 127); }
    if (c < 2048) { const int base = c & 1024, x = c & 255, hh = (c >> 8) & 3, bj = x >> 7, within = x & 127, e = within >> 6, i = within & 63; return base + hh * 256 + bj * 128 + 2 * i + e; }
    if (c < 4096) return c;
    if (c < 4112) return 15360 + (c - 4096);
    return c - 16;
}
template <int MAP> __device__ __forceinline__ void transpose_item2(const float* W, int ldw, int k0, int c0, f16* WT, int Kdim, LAS float* scr, int lane) {
    const int col4 = (lane & 7) * 4; const bool cv = c0 + col4 < ldw;
    f32x4 v[8];
#pragma unroll
    for (int it = 0; it < 8; ++it) { const int r = it * 8 + (lane >> 3); v[it] = cv ? *(const f32x4*)(W + (size_t)(k0 + r) * ldw + c0 + col4) : (f32x4){0.f, 0.f, 0.f, 0.f}; }
#pragma unroll
    for (int it = 0; it < 8; ++it) { const int r = it * 8 + (lane >> 3); LAS float* d = scr + r * 33 + col4; d[0] = v[it].x; d[1] = v[it].y; d[2] = v[it].z; d[3] = v[it].w; }
    LDS_WAIT();
    const int c = lane & 7;
#pragma unroll
    for (int j = 0; j < 4; ++j) { const int n = (lane >> 3) + 8 * j; const LAS float* sp = scr + (8 * c) * 33 + n;
        u32x4 o; o.x = pk_f16(sp[0 * 33], sp[1 * 33]); o.y = pk_f16(sp[2 * 33], sp[3 * 33]); o.z = pk_f16(sp[4 * 33], sp[5 * 33]); o.w = pk_f16(sp[6 * 33], sp[7 * 33]);
        if (c0 + n < ldw) *(u32x4*)(WT + (size_t)dest_row<MAP>(c0 + n) * Kdim + k0 + 8 * c) = o; }
    LDS_WAIT();
}
__device__ __forceinline__ void phase_prologue() {
    Frame F = make_frame();
    const int gw = F.bid * 8 + F.wave, NGW = F.G * 8;
    const int gt = F.bid * 512 + F.tid, NGT = F.G * 512;
    { const f32x4* cs = (const f32x4*)inp(2); f32x4* X = WSP(f32x4, WS_X) + (size_t)ML * D / 4; for (int i = gt; i < MC * D / 4; i += NGT) X[i] = cs[i]; }
    { float* rope = WSP(float, WS_ROPE);
      for (int i = gt; i < 4096; i += NGT) { const int pos = i >> 6, j = i & 63; const float inv = powf(10000.0f, -(float)j / 64.0f); const float a = (float)pos * inv; rope[i] = cosf(a); rope[4096 + i] = sinf(a); }
      for (int l = 0; l < DEPTH; ++l) { u32x4* z = (u32x4*)(F.ws + WS_W + (size_t)l * WL_SIZE + WL_WIN + (size_t)15376 * D * 2);
          for (int i = gt; i < 240 * D * 2 / 16; i += NGT) z[i] = (u32x4){0u, 0u, 0u, 0u}; } }
    LAS float* scr = (LAS float*)(F.lds + F.wave * 16384);
    LAS float* sa = (LAS float*)(F.lds + F.wave * 16384 + 8448);
    constexpr int I_MOD = DEPTH * 72 * 8;
    constexpr int I_W1 = 32 * 352, I_W2 = 88 * 64, I_WIN = 32 * 481, I_WBR = 3 * 16 * 64, I_WOUT = 32 * 64, I_LRU = 256;
    constexpr int PER_L = 2 * I_W1 + 2 * I_W2 + I_WIN + I_WBR + I_WOUT + I_LRU;
    for (int it = gw; it < I_MOD + DEPTH * PER_L; it += NGW) {
        if (it < I_MOD) {
            const int l = it / 576, r = it % 576, cg = r >> 3, kr = r & 7, n0 = cg * 256 + 4 * F.lane, k0 = kr * 256;
            for (int i = F.lane; i < 5 * 256; i += 64) { const int bi = i >> 8, k = i & 255; const float c = bi < 4 ? inp(1)[bi * D + k0 + k] : inp(3)[k0 + k]; sa[i] = siluf_(c); }
            LDS_WAIT();
            const float* Wm = inp(4) + (size_t)l * D * NMODC + (size_t)k0 * NMODC + n0;
            f32x4 acc[5];
#pragma unroll
            for (int bi = 0; bi < 5; ++bi) acc[bi] = (f32x4){0.f, 0.f, 0.f, 0.f};
#pragma unroll 8
            for (int kk = 0; kk < 256; ++kk) { const f32x4 w = __builtin_nontemporal_load((const f32x4*)(Wm + (size_t)kk * NMODC));
#pragma unroll
                for (int bi = 0; bi < 5; ++bi) acc[bi] = acc[bi] + w * sa[bi * 256 + kk]; }
            if (kr == 0) { const f32x4 bm = *(const f32x4*)(inp(5) + (size_t)l * NMODC + n0);
#pragma unroll
                for (int bi = 0; bi < 5; ++bi) acc[bi] = acc[bi] + bm; }
#pragma unroll
            for (int bi = 0; bi < 5; ++bi) { float* mp = WSP(float, WS_MOD) + ((size_t)l * 5 + bi) * NMODC + n0;
#pragma unroll
                for (int e = 0; e < 4; ++e) __hip_atomic_fetch_add(mp + e, acc[bi][e], __ATOMIC_RELAXED, __HIP_MEMORY_SCOPE_AGENT); }
            LDS_WAIT();
            continue;
        }
        const int itw = it - I_MOD; const int l = itw / PER_L; int r = itw % PER_L;
        unsigned char* wl = F.ws + WS_W + (size_t)l * WL_SIZE;
        if (r < 2 * I_W1) { const int which = r / I_W1; r %= I_W1;
            transpose_item2<1>(inp(which ? 11 : 9) + (size_t)l * D * 2 * DFF, 2 * DFF, (r / 352) * 64, (r % 352) * 32, (f16*)(wl + (which ? WL_W3 : WL_W1)), D, scr, F.lane); continue; }
        r -= 2 * I_W1;
        if (r < 2 * I_W2) { const int which = r / I_W2; r %= I_W2;
            transpose_item2<0>(inp(which ? 12 : 10) + (size_t)l * DFF * D, D, (r / 64) * 64, (r % 64) * 32, (f16*)(wl + (which ? WL_W4 : WL_W2)), DFF, scr, F.lane); continue; }
        r -= 2 * I_W2;
        if (r < I_WIN) { transpose_item2<2>(inp(13) + (size_t)l * D * PIN_SRC, PIN_SRC, (r / 481) * 64, (r % 481) * 32, (f16*)(wl + WL_WIN), D, scr, F.lane); continue; }
        r -= I_WIN;
        if (r < I_WBR) { const int n = r / 1024; r %= 1024;
            transpose_item2<0>(inp(25) + ((size_t)l * 3 + n) * BW * D, D, (r / 64) * 64, (r % 64) * 32, (f16*)(wl + WL_WBR) + (size_t)n * D * BW, BW, scr, F.lane); continue; }
        r -= I_WBR;
        if (r < I_WOUT) { transpose_item2<0>(inp(26) + (size_t)l * D * D, D, (r / 64) * 64, (r % 64) * 32, (f16*)(wl + WL_WOUT), D, scr, F.lane); continue; }
        r -= I_WOUT;
        { const int mat = r >> 7, ng = (r >> 3) & 15, kb = (r >> 2) & 1, nb = r & 3;
          transpose_item2<0>(inp(mat ? 22 : 20) + ((size_t)l * 16 + ng) * 128 * 128, 128, kb * 64, nb * 32, WSP(f16, WS_WLRU) + (((size_t)l * 2 + mat) * 16 + ng) * 128 * 128, 128, scr, F.lane); }
    }
}

__device__ __forceinline__ void phase_adaln(int li_v, int which_v) {
    Frame F = make_frame(); const int li = UNI(li_v), which = UNI(which_v);
    const float* gain = inp(6 + which) + (size_t)li * D; const int chunk_shift = 3 * which; const int M = (which == 2 && li == DEPTH - 1) ? ML : MT;
    const int gw = F.bid * 8 + F.wave, NGW = F.G * 8;
    const bool first = li == 0 && which == 0;
    const float* XL = first ? inp(0) : WSP(float, WS_X); const float* XC = WSP(float, WS_X); f16* H = WSP(f16, WS_H);
    for (int row = gw; row < M; row += NGW) {
        const float* X = row < ML ? XL : XC;
        const int bidx = row < ML ? row / SEQ : 4;
        const float* modb = WSP(float, WS_MOD) + ((size_t)li * 5 + bidx) * NMODC + chunk_shift * D;
        const f32x4* xr = (const f32x4*)(X + (size_t)row * D) + F.lane;
        f32x4 v[8]; float ss = 0.f;
#pragma unroll
        for (int j = 0; j < 8; ++j) v[j] = xr[64 * j];
        if (row >= ML && !first) {
            const f32x4* pr = (const f32x4*)(WSP(float, WS_HL) + (size_t)(row - ML) * D) + F.lane;
#pragma unroll
            for (int kp = 0; kp < 4; ++kp)
#pragma unroll
                for (int j = 0; j < 8; ++j) v[j] = v[j] + pr[(size_t)kp * MC * D / 4 + 64 * j];
            f32x4* xw = (f32x4*)(WSP(float, WS_X) + (size_t)row * D) + F.lane;
#pragma unroll
            for (int j = 0; j < 8; ++j) xw[64 * j] = v[j];
        }
#pragma unroll
        for (int j = 0; j < 8; ++j) ss += (v[j].x * v[j].x + v[j].y * v[j].y) + (v[j].z * v[j].z + v[j].w * v[j].w);
        const float rstd = rsqrtf(wave_sum(ss) * (1.0f / D) + EPS);
        u32x2* o = (u32x2*)(H + (size_t)row * D) + F.lane;
#pragma unroll
        for (int j = 0; j < 8; ++j) { const int c = (64 * j + F.lane) * 4;
            const f32x4 g = *(const f32x4*)(gain + c), sh = *(const f32x4*)(modb + c), sc = *(const f32x4*)(modb + D + c);
            const f32x4 y = v[j] * rstd * g * (sc + 1.0f) + sh;
            u32x2 w; w.x = pk_f16(y.x, y.y); w.y = pk_f16(y.z, y.w); o[64 * j] = w; }
    }
}
__device__ __forceinline__ void phase_final() {
    Frame F = make_frame();
    const int gw = F.bid * 8 + F.wave, NGW = F.G * 8;
    const float* X = WSP(float, WS_X); const float* gain = inp(27);
    for (int row = gw; row < ML; row += NGW) {
        const f32x4* xr = (const f32x4*)(X + (size_t)row * D) + F.lane;
        f32x4 v[8]; float ss = 0.f;
#pragma unroll
        for (int j = 0; j < 8; ++j) { v[j] = xr[64 * j]; ss += (v[j].x * v[j].x + v[j].y * v[j].y) + (v[j].z * v[j].z + v[j].w * v[j].w); }
        const float rstd = rsqrtf(wave_sum(ss) * (1.0f / D) + EPS);
        f32x4* o = (f32x4*)(F.out + (size_t)row * D) + F.lane;
#pragma unroll
        for (int j = 0; j < 8; ++j) { const int c = (64 * j + F.lane) * 4; o[64 * j] = v[j] * rstd * *(const f32x4*)(gain + c); }
    }
}

__device__ __forceinline__ void phase_lru_a(int li_v) {
    Frame F = make_frame(); const int li = UNI(li_v);
    LAS float* xc = (LAS float*)F.lds;
    const f16* P = WSP(f16, WS_P); float* LA = WSP(float, WS_LA); float* LU = WSP(float, WS_LU);
    const float* cw = inp(18) + (size_t)li * 4 * BW; const float* cb = inp(19) + (size_t)li * BW;
    const float* wa = inp(20) + (size_t)li * 2 * 8 * 128 * 128; const float* ba = inp(21) + (size_t)li * 2 * BW;
    const float* wx = inp(22) + (size_t)li * 2 * 8 * 128 * 128; const float* bx = inp(23) + (size_t)li * 2 * BW;
    const float* lam = inp(24) + (size_t)li * 2 * BW;
    for (int it = F.bid; it < MT / 8; it += F.G) {
        const int row0 = it * 8;
        int sbeg, send; if (row0 < ML) { sbeg = (row0 / SEQ) * SEQ; send = sbeg + SEQ; } else { sbeg = ML + ((row0 - ML) / CTXL) * CTXL; send = sbeg + CTXL; }
        for (int i = F.tid; i < 8 * BW; i += 512) { const int tt = i >> 10, ch = i & 1023, row = row0 + tt;
            float y = cb[ch];
#pragma unroll
            for (int j = 0; j < 4; ++j) { const int rr = row + j - 1; if (rr >= sbeg && rr < send) y += cw[j * BW + ch] * (float)P[(size_t)rr * LDP + LX + ch]; }
            xc[i] = y; }
        __syncthreads();
#pragma unroll 1
        for (int q = 0; q < 4; ++q) {
            const int o = q * 512 + F.tid, n = o >> 10, ch = o & 1023, g = ch >> 7, j = ch & 127;
            const float* wap = wa + ((size_t)(n * 8 + g) * 128) * 128 + j; const float* wxp = wx + ((size_t)(n * 8 + g) * 128) * 128 + j;
            float aa[8], ax[8];
#pragma unroll
            for (int t = 0; t < 8; ++t) { aa[t] = 0.f; ax[t] = 0.f; }
#pragma unroll 4
            for (int i = 0; i < 128; ++i) { const float w1 = wap[i * 128], w2 = wxp[i * 128];
#pragma unroll
                for (int t = 0; t < 8; ++t) { const float xv = xc[t * 1024 + g * 128 + i]; aa[t] += xv * w1; ax[t] += xv * w2; } }
            const float bav = ba[n * BW + ch], bxv = bx[n * BW + ch]; const float lm = lam[n * BW + ch];
            const float sp = log1pf(expf(-lm));
#pragma unroll
            for (int t = 0; t < 8; ++t) { const float r = sigmoidf_(aa[t] + bav), ig = sigmoidf_(ax[t] + bxv);
                const float log_a = -8.0f * r * sp; const float a = expf(log_a); const float uu = sqrtf(-expm1f(2.0f * log_a)) * ig * xc[t * 1024 + ch];
                LA[((size_t)(row0 + t) * 2 + n) * BW + ch] = a; LU[((size_t)(row0 + t) * 2 + n) * BW + ch] = uu; }
        }
        __syncthreads();
    }
}
__device__ __forceinline__ void lru_scan_item(Frame& F, int item) {
    const int idx = item * 512 + F.tid;
    const int ch = idx & 1023, dir = (idx >> 10) & 1, b = idx >> 11;
    const float* LA = WSP(float, WS_LA); const float* LU = WSP(float, WS_LU); float* HL = WSP(float, WS_HL);
    float h = 0.f;
#pragma unroll 1
    for (int seg = 0; seg < 2; ++seg) {
        const int base = seg == 0 ? ML + b * CTXL : b * SEQ, len = seg == 0 ? CTXL : SEQ;
#pragma unroll 8
        for (int s = 0; s < len; ++s) { const int row = base + (dir ? len - 1 - s : s); const size_t o = ((size_t)row * 2 + dir) * BW + ch;
            h = LA[o] * h + LU[o]; HL[((size_t)dir * MT + row) * BW + ch] = h; }
    }
}


template <int PASS> __device__ __forceinline__ void lru_block(Frame& F, int li, bool latent_only, int ufirst = 0, int ulimit = 1 << 30) {
    LAS f16* Xc = (LAS f16*)F.lds;
    LAS float* Hs = (LAS float*)(F.lds + 17408);
    const f16* P = WSP(f16, WS_P); float* SUM = WSP(float, WS_LSUM);
    const int lane0 = F.lane, wave = F.wave, tid0 = F.tid; int tid = tid0, c8 = (tid0 & 15) * 8;
    const int nunits = min(latent_only ? 4 * 32 * 8 : 4 * 36 * 8, ulimit);
#define LRU_UNIT(it) (latent_only ? ((it) / 256) * 288 + 32 + ((it) % 256) : (it))
#define LRU_ROW0(u) ((((u) >> 3) % 36) < 4 ? ML + ((u) / 288) * CTXL + (((u) >> 3) % 36) * 64 : ((u) / 288) * SEQ + ((((u) >> 3) % 36) - 4) * 64)
#define LRU_SBEG(u) ((((u) >> 3) % 36) < 4 ? ML + ((u) / 288) * CTXL : ((u) / 288) * SEQ)
#define LRU_SEND(u) (LRU_SBEG(u) + ((((u) >> 3) % 36) < 4 ? CTXL : SEQ))
    f16x8 raw[2][4];
#define LRU_PREFETCH(u) do { const int row0_ = LRU_ROW0(u), sb_ = LRU_SBEG(u), se_ = LRU_SEND(u), g_ = (u) & 7; \
        _Pragma("unroll") for (int it_ = 0; it_ < 2; ++it_) { const int row_ = row0_ + ((it_ * 512 + tid) >> 4); \
            _Pragma("unroll") for (int j_ = 0; j_ < 4; ++j_) { const int rr_ = row_ + j_ - 1; raw[it_][j_] = (f16x8){0, 0, 0, 0, 0, 0, 0, 0}; \
                if (rr_ >= sb_ && rr_ < se_) raw[it_][j_] = *(const f16x8*)(P + (size_t)rr_ * LDP + LX + g_ * 128 + c8); } } } while (0)
    int gprev = -1;
    f16x8 wa[2][4], wx[2][4]; float bav[2], bxv[2], sp[2];
    if (ufirst + F.bid < nunits) LRU_PREFETCH(LRU_UNIT(ufirst + F.bid));
#pragma unroll 1
    for (int itu = ufirst + F.bid; itu < nunits; itu += F.G) {
        const int unit = LRU_UNIT(itu);
        int lane = lane0; tid = tid0; asm volatile("" : "+v"(lane), "+v"(tid));
        const int fr = lane & 15, fq = lane >> 4; c8 = (tid & 15) * 8;
        const int g = unit & 7, seg = (unit >> 3) % 36, b = unit / 288;
        const bool isctx = seg < 4; const int row0 = LRU_ROW0(unit);
        if (g != gprev) {
            gprev = g;
#pragma unroll
            for (int q = 0; q < 2; ++q) { const int c = wave * 2 + q, n = c >> 3, jt = c & 7, ch = g * 128 + 16 * jt + fr;
                const f16* wt = WSP(f16, WS_WLRU) + ((((size_t)li * 2 + 0) * 2 + n) * 8 + g) * 128 * 128 + (size_t)(16 * jt + fr) * 128 + 8 * fq;
#pragma unroll
                for (int ks = 0; ks < 4; ++ks) { wa[q][ks] = *(const f16x8*)(wt + 32 * ks); wx[q][ks] = *(const f16x8*)(wt + (size_t)2 * 8 * 128 * 128 + 32 * ks); }
                bav[q] = inp(21)[(size_t)li * 2 * BW + n * BW + ch]; bxv[q] = inp(23)[(size_t)li * 2 * BW + n * BW + ch];
                sp[q] = log1pf(expf(-inp(24)[(size_t)li * 2 * BW + n * BW + ch])); }
        }
        const float* cw = inp(18) + (size_t)li * 4 * BW + g * 128 + c8; const float* cb = inp(19) + (size_t)li * BW + g * 128 + c8;
#pragma unroll
        for (int it = 0; it < 2; ++it) { const int t = (it * 512 + tid) >> 4;
            float y[8];
#pragma unroll
            for (int e = 0; e < 8; ++e) { y[e] = cb[e];
#pragma unroll
                for (int j = 0; j < 4; ++j) y[e] += cw[j * BW + e] * (float)raw[it][j][e]; }
            u32x4 w; w.x = pk_f16(y[0], y[1]); w.y = pk_f16(y[2], y[3]); w.z = pk_f16(y[4], y[5]); w.w = pk_f16(y[6], y[7]);
            *(LAS u32x4*)(Xc + t * 136 + c8) = w; }
        __syncthreads();
        if (itu + F.G < nunits) LRU_PREFETCH(LRU_UNIT(itu + F.G));
#pragma unroll
        for (int q = 0; q < 2; ++q) {
            const int c = wave * 2 + q, n = c >> 3, jt = c & 7, ch = g * 128 + 16 * jt + fr;
            float carry = 0.f, aprod = 1.f;
            if (PASS == 1) {
                const float* sb = SUM + ((size_t)b * 36 * 2 + n) * 2048 + ch * 2;
                const int cnt = n == 0 ? seg : (isctx ? 3 - seg : 39 - seg);
                f32x2 pv[9];
#pragma unroll
                for (int e = 0; e < 9; ++e) { const int p = fq * 9 + e; const int s2 = n == 0 ? p : (isctx ? 3 - p : (p < 4 ? 3 - p : 39 - p));
                    pv[e] = (f32x2){1.f, 0.f}; if (p < cnt) pv[e] = *(const f32x2*)(sb + (size_t)s2 * 4096); }
                float Al = 1.f, Ul = 0.f;
#pragma unroll
                for (int e = 0; e < 9; ++e) { Ul = Ul * pv[e].x + pv[e].y; Al *= pv[e].x; }
#pragma unroll
                for (int gg = 0; gg < 4; ++gg) { const float Ag = __shfl(Al, gg * 16 + fr), Ug = __shfl(Ul, gg * 16 + fr); carry = carry * Ag + Ug; }
                __builtin_amdgcn_sched_barrier(0);
            }
            float av_[4][4], uv_[4][4];
#pragma unroll
            for (int tt = 0; tt < 4; ++tt) {
                f32x4 racc = (f32x4){0.f, 0.f, 0.f, 0.f}, iacc = (f32x4){0.f, 0.f, 0.f, 0.f};
#pragma unroll
                for (int ks = 0; ks < 4; ++ks) { const f16x8 a = *(const LAS f16x8*)(Xc + (16 * tt + fr) * 136 + 32 * ks + 8 * fq); racc = mfma16(a, wa[q][ks], racc); iacc = mfma16(a, wx[q][ks], iacc); }
#pragma unroll
                for (int r = 0; r < 4; ++r) { const int t = 16 * tt + 4 * fq + r; const float rg = sigmoidf_(racc[r] + bav[q]), ig = sigmoidf_(iacc[r] + bxv[q]);
                    const float log_a = -8.0f * rg * sp[q]; av_[tt][r] = __expf(log_a);
                    const float y2 = 2.0f * log_a;
                    const float om = y2 > -0.125f ? -y2 * (1.0f + y2 * (0.5f + y2 * (0.16666667f + y2 * (0.041666668f + y2 * 0.0083333338f)))) : 1.0f - __expf(y2);
                    uv_[tt][r] = __builtin_amdgcn_sqrtf(om) * ig * (float)Xc[t * 136 + 16 * jt + fr]; }
                if (tt & 1) __builtin_amdgcn_sched_barrier(0);
            }
#pragma unroll
            for (int k = 0; k < 4; ++k) {
                const int tt = n ? 3 - k : k;
                float a4[4], u4[4];
#pragma unroll
                for (int r = 0; r < 4; ++r) { a4[r] = n ? av_[3 - k][r] : av_[k][r]; u4[r] = n ? uv_[3 - k][r] : uv_[k][r]; }
                float Al = 1.f, Ul = 0.f;
#pragma unroll
                for (int rr = 0; rr < 4; ++rr) { const float ar = n ? a4[3 - rr] : a4[rr], ur = n ? u4[3 - rr] : u4[rr]; Ul = Ul * ar + ur; Al *= ar; }
                float preA = 1.f, preU = 0.f, totA = 1.f, totU = 0.f;
#pragma unroll
                for (int gg = 0; gg < 4; ++gg) { const int gsrc = n ? 3 - gg : gg; const float Ag = __shfl(Al, gsrc * 16 + fr), Ug = __shfl(Ul, gsrc * 16 + fr);
                    const bool before = n ? (gsrc > fq) : (gsrc < fq);
                    if (before) { preU = preU * Ag + Ug; preA *= Ag; }
                    totU = totU * Ag + Ug; totA *= Ag; }
                float hrun = carry * preA + preU;
#pragma unroll
                for (int rr = 0; rr < 4; ++rr) { const float ar = n ? a4[3 - rr] : a4[rr], ur = n ? u4[3 - rr] : u4[rr]; hrun = ar * hrun + ur;
                    if (PASS == 1) Hs[(n * 64 + 16 * tt + 4 * fq + (n ? 3 - rr : rr)) * 128 + 16 * jt + fr] = hrun; }
                carry = carry * totA + totU; aprod *= totA;
            }
            if (PASS == 0 && fq == 0) { f32x2 v = {aprod, carry}; *(f32x2*)(SUM + (((size_t)b * 36 + seg) * 2 + n) * 2048 + ch * 2) = v; }
            __builtin_amdgcn_sched_barrier(0);
        }
        __syncthreads();
        if (PASS == 1) {
            f16* Y = WSP(f16, WS_Y) + (size_t)2 * MT * BW;
#pragma unroll
            for (int it = 0; it < 2; ++it) { const int t = (it * 512 + tid) >> 4; const int row = row0 + t;
                const f16x8 gg = *(const f16x8*)(P + (size_t)row * LDP + LG + g * 128 + c8);
                float y[8];
#pragma unroll
                for (int e = 0; e < 8; ++e) y[e] = (Hs[t * 128 + c8 + e] + Hs[(64 + t) * 128 + c8 + e]) * (float)gg[e];
                u32x4 w; w.x = pk_f16(y[0], y[1]); w.y = pk_f16(y[2], y[3]); w.z = pk_f16(y[4], y[5]); w.w = pk_f16(y[6], y[7]);
                *(u32x4*)(Y + (size_t)row * BW + g * 128 + c8) = w; }
            __syncthreads();
        }
    }
#undef LRU_UNIT
#undef LRU_ROW0
#undef LRU_SBEG
#undef LRU_SEND
#undef LRU_PREFETCH
}

__device__ __forceinline__ void na_unit(Frame& F, int li, int unit) {
    const bool lat = unit < 1024; const int uu = lat ? unit : unit - 1024;
    const int h = uu & 7, rr = (uu >> 3) & (lat ? 31 : 3), b = uu >> (lat ? 8 : 5);
    const f16* P = WSP(f16, WS_P); f16* Y = WSP(f16, WS_Y) + (size_t)1 * MT * BW;
    const float* rpb = inp(17) + ((size_t)li * 8 + h) * 15 * 31;
    LAS float* qf = (LAS float*)(F.lds + F.wave * 4096);
    LAS float* pj = qf + 128;
    const int npass = lat ? 6 : 4; const int rs = lat ? min(max(rr - 4, 0), 24) : 0;
    for (int qi = 0; qi < 8; ++qi) {
        const int qc = F.wave * 8 + qi;
        const int rowq = lat ? b * SEQ + rr * 64 + qc : ML + b * CTXL + rr * 64 + qc;
        { const f16x2 qv = *(const f16x2*)(P + (size_t)rowq * LDP + NQ + h * 128 + 2 * F.lane); qf[2 * F.lane] = (float)qv[0]; qf[2 * F.lane + 1] = (float)qv[1]; }
        LDS_WAIT();
        const int cs = min(max(qc - 8, 0), 48);
        float sc[6];
#pragma unroll
        for (int p = 0; p < 6; ++p) {
            sc[p] = -INFINITY;
            if (p < npass) {
                int krow_g; float bias = 0.f;
                if (lat && p < 2) { const int jrow = (F.lane >> 4) + 4 * p, kc = cs + (F.lane & 15), kr = rs + jrow; krow_g = b * SEQ + kr * 64 + kc;
                    bias = rpb[(kr - rr + 7) * 31 + (min(max(kc - qc, -15), 15) + 15)]; }
                else { const int ci = (lat ? p - 2 : p) * 64 + F.lane; krow_g = ML + b * CTXL + ci; }
                const f16x8* kp = (const f16x8*)(P + (size_t)krow_g * LDP + NK + h * 128);
                float d = 0.f;
#pragma unroll 4
                for (int i = 0; i < 16; ++i) { const f16x8 kv = kp[i];
#pragma unroll
                    for (int e = 0; e < 8; ++e) d += (float)kv[e] * qf[8 * i + e]; }
                sc[p] = d + bias;
            }
        }
        float mx = sc[0];
#pragma unroll
        for (int p = 1; p < 6; ++p) mx = fmaxf(mx, sc[p]);
        mx = wave_max(mx);
        float sm = 0.f;
#pragma unroll
        for (int p = 0; p < 6; ++p) { sc[p] = p < npass ? __expf(sc[p] - mx) : 0.f; sm += sc[p]; }
        sm = wave_sum(sm); const float inv = 1.0f / sm;
#pragma unroll
        for (int p = 0; p < 6; ++p) if (p < npass) pj[p * 64 + F.lane] = sc[p] * inv;
        LDS_WAIT();
        float a0 = 0.f, a1 = 0.f;
        for (int j = 0; j < npass * 64; ++j) {
            const int p = j >> 6, l = j & 63; int krow_g;
            if (lat && p < 2) { const int jrow = (l >> 4) + 4 * p, kc = cs + (l & 15); krow_g = b * SEQ + (rs + jrow) * 64 + kc; }
            else krow_g = ML + b * CTXL + (lat ? p - 2 : p) * 64 + l;
            const f16x2 vv = *(const f16x2*)(P + (size_t)krow_g * LDP + NV + h * 128 + 2 * F.lane);
            const float pv = pj[j]; a0 += pv * (float)vv[0]; a1 += pv * (float)vv[1];
        }
        *(unsigned*)(Y + (size_t)rowq * BW + h * 128 + 2 * F.lane) = pk_f16(a0, a1);
        LDS_WAIT();
    }
}


__device__ __forceinline__ void na_tile(Frame& F, int li, bool lat, int b, int rr, int i, int h) {
    LAS f16* Vs = (LAS f16*)(F.lds + F.wave * 10240);
    const int lane = F.lane, fr = lane & 15, fq = lane >> 4;
    const f16* P = WSP(f16, WS_P); f16* Y = WSP(f16, WS_Y) + (size_t)1 * MT * BW;
    const float* rpb = inp(17) + ((size_t)li * 8 + h) * 15 * 31;
    const int q0row = lat ? b * SEQ + rr * 64 + 16 * i : ML + b * CTXL + rr * 64 + 16 * i;
    f16x8 qf[4];
#pragma unroll
    for (int ks = 0; ks < 4; ++ks) qf[ks] = *(const f16x8*)(P + (size_t)(q0row + fr) * LDP + NQ + h * 128 + 32 * ks + 8 * fq);
    f32x4 oacc[8];
#pragma unroll
    for (int dt = 0; dt < 8; ++dt) oacc[dt] = (f32x4){0.f, 0.f, 0.f, 0.f};
    float m_run = -INFINITY, l_run = 0.f;
    const int c0 = min(max(16 * i - 8, 0), 32), rs = min(max(rr - 4, 0), 24), qc = 16 * i + fr, cs = min(max(qc - 8, 0), 48);
    const int nblk = lat ? 16 : 8;
#define NA_KEYBASE(blk) ((lat && (blk) < 8) ? b * SEQ + (rs + (blk)) * 64 + c0 : ML + b * CTXL + ((blk) - (lat ? 8 : 0)) * 32)
    f16x8 kreg[2][4], vreg[8];
    { const int kb = NA_KEYBASE(0);
#pragma unroll
      for (int nt = 0; nt < 2; ++nt)
#pragma unroll
          for (int ks = 0; ks < 4; ++ks) kreg[nt][ks] = *(const f16x8*)(P + (size_t)(kb + 16 * nt + fr) * LDP + NK + h * 128 + 32 * ks + 8 * fq);
#pragma unroll
      for (int it = 0; it < 8; ++it) { const int id = it * 64 + lane; vreg[it] = *(const f16x8*)(P + (size_t)(kb + (id >> 4)) * LDP + NV + h * 128 + (id & 15) * 8); } }
#pragma unroll 1
    for (int blk = 0; blk < nblk; ++blk) {
        const bool win = lat && blk < 8;
#pragma unroll
        for (int it = 0; it < 8; ++it) { const int id = it * 64 + lane; *(LAS f16x8*)(Vs + (id >> 4) * 144 + (id & 15) * 8) = vreg[it]; }
        f32x4 sacc[2];
#pragma unroll
        for (int nt = 0; nt < 2; ++nt) { sacc[nt] = (f32x4){0.f, 0.f, 0.f, 0.f};
#pragma unroll
            for (int ks = 0; ks < 4; ++ks) sacc[nt] = mfma16(kreg[nt][ks], qf[ks], sacc[nt]); }
        if (blk + 1 < nblk) {
            const int kb = NA_KEYBASE(blk + 1);
#pragma unroll
            for (int nt = 0; nt < 2; ++nt)
#pragma unroll
                for (int ks = 0; ks < 4; ++ks) kreg[nt][ks] = *(const f16x8*)(P + (size_t)(kb + 16 * nt + fr) * LDP + NK + h * 128 + 32 * ks + 8 * fq);
#pragma unroll
            for (int it = 0; it < 8; ++it) { const int id = it * 64 + lane; vreg[it] = *(const f16x8*)(P + (size_t)(kb + (id >> 4)) * LDP + NV + h * 128 + (id & 15) * 8); }
        }
        float sv[8]; float bm = -INFINITY;
#pragma unroll
        for (int nt = 0; nt < 2; ++nt)
#pragma unroll
            for (int r = 0; r < 4; ++r) { float x = sacc[nt][r];
                if (win) { const int kc = c0 + 16 * nt + 4 * fq + r; const bool valid = kc >= cs && kc < cs + 16; const int dc = min(max(kc - qc + 15, 0), 30);
                    const float bias = rpb[(rs + blk - rr + 7) * 31 + dc]; x = valid ? x + bias : -INFINITY; }
                sv[nt * 4 + r] = x; bm = fmaxf(bm, x); }
        bm = fmaxf(bm, __shfl_xor(bm, 16)); bm = fmaxf(bm, __shfl_xor(bm, 32));
        const float m_new = fmaxf(m_run, bm), alpha = __expf(m_run - m_new);
        float ps = 0.f;
#pragma unroll
        for (int e = 0; e < 8; ++e) { sv[e] = __expf(sv[e] - m_new); ps += sv[e]; }
        ps += __shfl_xor(ps, 16); ps += __shfl_xor(ps, 32);
        l_run = l_run * alpha + ps; m_run = m_new;
        f16x8 pf;
#pragma unroll
        for (int e = 0; e < 8; ++e) pf[e] = (f16)sv[e];
        const LAS f16* vb = Vs + (4 * fq + (fr >> 2)) * 144 + 4 * (fr & 3);
#pragma unroll
        for (int dt = 0; dt < 8; ++dt) { oacc[dt] = oacc[dt] * alpha;
            const f16x4 alo = lds_tr4(vb + 16 * dt), ahi = lds_tr4(vb + 16 * 144 + 16 * dt);
            const f16x8 a = __builtin_shufflevector(alo, ahi, 0, 1, 2, 3, 4, 5, 6, 7);
            oacc[dt] = mfma16(a, pf, oacc[dt]); }
    }
#undef NA_KEYBASE
    const float inv = 1.0f / l_run;
    LAS f16* Ot = Vs;
#pragma unroll
    for (int dt = 0; dt < 8; ++dt) { u32x2 w; w.x = pk_f16(oacc[dt][0] * inv, oacc[dt][1] * inv); w.y = pk_f16(oacc[dt][2] * inv, oacc[dt][3] * inv);
        *(LAS u32x2*)(Ot + fr * 136 + 16 * dt + 4 * fq) = w; }
    { const int row = lane >> 2, seg = lane & 3;
#pragma unroll
      for (int c = 0; c < 4; ++c) { const u32x4 w = *(const LAS u32x4*)(Ot + row * 136 + seg * 32 + c * 8);
          *(u32x4*)(Y + (size_t)(q0row + row) * BW + h * 128 + seg * 32 + c * 8) = w; } }
}


__device__ __forceinline__ void na_item(Frame& F, int li, bool lat, int b, int rr, int hpair) {
    constexpr int KB = 34816, VB = 36864, BUF = KB + VB;
    const int lane = F.lane, wave = F.wave, fr = lane & 15, fq = lane >> 4, tid = F.tid;
    const int i = wave & 3, hs = wave >> 2, h = hpair * 2 + hs;
    const f16* P = WSP(f16, WS_P); f16* Y = WSP(f16, WS_Y) + (size_t)1 * MT * BW;
    const float* rpb = inp(17) + ((size_t)li * 8 + h) * 15 * 31;
    const int q0row = lat ? b * SEQ + rr * 64 + 16 * i : ML + b * CTXL + rr * 64 + 16 * i;
    f16x8 qf[4];
#pragma unroll
    for (int ks = 0; ks < 4; ++ks) qf[ks] = *(const f16x8*)(P + (size_t)(q0row + fr) * LDP + NQ + h * 128 + 32 * ks + 8 * fq);
    f32x4 oacc[8];
#pragma unroll
    for (int dt = 0; dt < 8; ++dt) oacc[dt] = (f32x4){0.f, 0.f, 0.f, 0.f};
    float m_run = -INFINITY, l_run = 0.f;
    const int c0 = min(max(16 * i - 8, 0), 32), rs = min(max(rr - 4, 0), 24), qc = 16 * i + fr, cs = min(max(qc - 8, 0), 48);
    const int nstep = lat ? 12 : 4, nwin = lat ? 8 : 0;
#define NA_ROWBASE(st) ((st) < nwin ? b * SEQ + (rs + (st)) * 64 : ML + b * CTXL + ((st) - nwin) * 64)
    f16x8 pre[8];
#define NA_LOAD(st) do { const int rb_ = NA_ROWBASE(st); _Pragma("unroll") for (int it_ = 0; it_ < 8; ++it_) { const int id_ = it_ * 512 + tid, rem_ = id_ & 2047; \
        pre[it_] = *(const f16x8*)(P + (size_t)(rb_ + ((rem_ >> 4) & 63)) * LDP + ((id_ >> 11) ? NV : NK) + (hpair * 2 + (rem_ >> 10)) * 128 + (rem_ & 15) * 8); } } while (0)
#define NA_STORE(buf) do { _Pragma("unroll") for (int it_ = 0; it_ < 8; ++it_) { const int id_ = it_ * 512 + tid, rem_ = id_ & 2047, hs_ = rem_ >> 10, key_ = (rem_ >> 4) & 63, ch_ = rem_ & 15; \
        LAS f16* d_ = (LAS f16*)(F.lds + (buf) * BUF + ((id_ >> 11) ? KB + (hs_ * 64 + key_) * 288 : (hs_ * 64 + key_) * 272)) + ch_ * 8; *(LAS f16x8*)d_ = pre[it_]; } } while (0)
    NA_LOAD(0); NA_STORE(0);
    __syncthreads();
#pragma unroll 1
    for (int st = 0; st < nstep; ++st) {
        const int cur = st & 1;
        if (st + 1 < nstep) NA_LOAD(st + 1);
        const bool win = st < nwin;
        const LAS f16* Kb = (const LAS f16*)(F.lds + cur * BUF) + hs * 64 * 136;
        const LAS f16* Vb = (const LAS f16*)(F.lds + cur * BUF + KB) + hs * 64 * 144;
        const int nsub = win ? 1 : 2;
#pragma unroll 1
        for (int sub = 0; sub < nsub; ++sub) {
            const int koff = win ? c0 : 32 * sub;
            f32x4 sacc[2];
#pragma unroll
            for (int nt = 0; nt < 2; ++nt) { sacc[nt] = (f32x4){0.f, 0.f, 0.f, 0.f};
#pragma unroll
                for (int ks = 0; ks < 4; ++ks) { const f16x8 kf = *(const LAS f16x8*)(Kb + (koff + 16 * nt + fr) * 136 + 32 * ks + 8 * fq); sacc[nt] = mfma16(kf, qf[ks], sacc[nt]); } }
            float sv[8]; float bm = -INFINITY;
#pragma unroll
            for (int nt = 0; nt < 2; ++nt)
#pragma unroll
                for (int r = 0; r < 4; ++r) { float x = sacc[nt][r];
                    if (win) { const int kc = c0 + 16 * nt + 4 * fq + r; const bool valid = kc >= cs && kc < cs + 16; const int dc = min(max(kc - qc + 15, 0), 30);
                        const float bias = rpb[(rs + st - rr + 7) * 31 + dc]; x = valid ? x + bias : -INFINITY; }
                    sv[nt * 4 + r] = x; bm = fmaxf(bm, x); }
            bm = fmaxf(bm, __shfl_xor(bm, 16)); bm = fmaxf(bm, __shfl_xor(bm, 32));
            const float m_new = fmaxf(m_run, bm), alpha = __expf(m_run - m_new);
            float ps = 0.f;
#pragma unroll
            for (int e = 0; e < 8; ++e) { sv[e] = __expf(sv[e] - m_new); ps += sv[e]; }
            ps += __shfl_xor(ps, 16); ps += __shfl_xor(ps, 32);
            l_run = l_run * alpha + ps; m_run = m_new;
            f16x8 pf;
#pragma unroll
            for (int e = 0; e < 8; ++e) pf[e] = (f16)sv[e];
            const LAS f16* vb = Vb + (koff + 4 * fq + (fr >> 2)) * 144 + 4 * (fr & 3);
#pragma unroll
            for (int dt = 0; dt < 8; ++dt) { oacc[dt] = oacc[dt] * alpha;
                const f16x4 alo = lds_tr4(vb + 16 * dt), ahi = lds_tr4(vb + 16 * 144 + 16 * dt);
                const f16x8 a = __builtin_shufflevector(alo, ahi, 0, 1, 2, 3, 4, 5, 6, 7);
                oacc[dt] = mfma16(a, pf, oacc[dt]); }
        }
        if (st + 1 < nstep) NA_STORE(cur ^ 1);
        __syncthreads();
    }
#undef NA_ROWBASE
#undef NA_LOAD
#undef NA_STORE
    const float inv = 1.0f / l_run;
    LAS f16* Ot = (LAS f16*)(F.lds + wave * 4352);
#pragma unroll
    for (int dt = 0; dt < 8; ++dt) { u32x2 w; w.x = pk_f16(oacc[dt][0] * inv, oacc[dt][1] * inv); w.y = pk_f16(oacc[dt][2] * inv, oacc[dt][3] * inv);
        *(LAS u32x2*)(Ot + fr * 136 + 16 * dt + 4 * fq) = w; }
    { const int row = lane >> 2, seg = lane & 3;
#pragma unroll
      for (int c = 0; c < 4; ++c) { const u32x4 w = *(const LAS u32x4*)(Ot + row * 136 + seg * 32 + c * 8);
          *(u32x4*)(Y + (size_t)(q0row + row) * BW + h * 128 + seg * 32 + c * 8) = w; } }
    __syncthreads();
}

__device__ __forceinline__ void mlstm_unit(Frame& F, int li, int unit, bool ctx_out) {
    const int vs = unit & 7, dir = (unit >> 3) & 1, h = (unit >> 4) & 3, b = unit >> 6;
    LAS float* Cs = (LAS float*)F.lds;
    LAS float* ns = Cs + 32 * 257;
    LAS float* Vs = ns + 256;
    LAS float* Ss = Vs + 64 * 33;
    LAS float* cum = Ss + 64 * 65;
    LAS float* mrow = cum + 64; LAS float* ig = mrow + 64; LAS float* lf = ig + 64; LAS float* inter = lf + 64; LAS float* wst = inter + 64; LAS float* den = wst + 64; LAS float* misc = den + 64;
    LAS f16* Qs = (LAS f16*)(misc + 64);
    LAS f16* Ks = Qs + 64 * 264;
    const f16* P = WSP(f16, WS_P); const float* G = WSP(float, WS_G); float* HMD = WSP(float, WS_HMD) + (size_t)dir * MT * BW;
    const float bi_ = inp(14)[(li * 2 + dir) * 4 + h], bf_ = inp(15)[(li * 2 + dir) * 4 + h];
    for (int i = F.tid; i < 32 * 257 + 256; i += 512) Cs[i] = 0.f;
    if (F.tid == 0) misc[0] = -INFINITY;
    __syncthreads();
    for (int j = 0; j < 36; ++j) {
        const bool isctx = j < 4; const int base = isctx ? ML + b * CTXL : b * SEQ, len = isctx ? CTXL : SEQ, off = isctx ? j * 64 : (j - 4) * 64;
#define MROW(s) (base + (dir ? len - 1 - (off + (s)) : off + (s)))
        for (int i = F.tid; i < 2048; i += 512) { const int s = i >> 5, c8 = i & 31; const size_t ro = (size_t)MROW(s) * LDP + h * 256 + c8 * 8;
            *(LAS f16x8*)(Qs + s * 264 + c8 * 8) = *(const f16x8*)(P + ro + PQ); *(LAS f16x8*)(Ks + s * 264 + c8 * 8) = *(const f16x8*)(P + ro + PK); }
        if (F.tid < 256) { const int s = F.tid >> 2, c8 = F.tid & 3; const f16x8 v = *(const f16x8*)(P + (size_t)MROW(s) * LDP + PV + h * 256 + vs * 32 + c8 * 8);
#pragma unroll
            for (int e = 0; e < 8; ++e) Vs[s * 33 + c8 * 8 + e] = (float)v[e]; }
        if (F.tid < 64) { const int row = MROW(F.tid); ig[F.tid] = G[(size_t)row * 16 + dir * 8 + h] + bi_; const float fp = G[(size_t)row * 16 + dir * 8 + 4 + h] + bf_;
            lf[F.tid] = fminf(fp, 0.f) - log1pf(expf(-fabsf(fp))); }
        __syncthreads();
        if (F.tid == 0) { const float mp = misc[0]; float c = 0.f, R = mp;
            for (int s = 0; s < 64; ++s) { c += lf[s]; cum[s] = c; R = fmaxf(R, ig[s] - c); mrow[s] = c + R; inter[s] = expf(c + mp - (c + R)); }
            const float mn = mrow[63], cl = cum[63];
            for (int s = 0; s < 64; ++s) wst[s] = expf(cl - cum[s] + ig[s] - mn);
            misc[1] = expf(cl + mp - mn); misc[0] = mn; }
        __syncthreads();
        const bool need_out = !isctx || ctx_out;
        if (need_out) {
            for (int i = F.tid; i < 4096; i += 512) { const int t = i >> 6, s = i & 63; float v = 0.f;
                if (s <= t) { float d = 0.f;
#pragma unroll 8
                    for (int k = 0; k < 256; ++k) d += (float)Qs[t * 264 + k] * (float)Ks[s * 264 + k];
                    v = d * expf(cum[t] - cum[s] + ig[s] - mrow[t]); }
                Ss[t * 65 + s] = v; }
            __syncthreads();
            float num[4];
#pragma unroll
            for (int q = 0; q < 4; ++q) { const int i = q * 512 + F.tid, t = i >> 5, v = i & 31; float a = 0.f, bs = 0.f;
#pragma unroll 8
                for (int k = 0; k < 256; ++k) a += Cs[v * 257 + k] * (float)Qs[t * 264 + k];
#pragma unroll 8
                for (int s = 0; s < 64; ++s) bs += Ss[t * 65 + s] * Vs[s * 33 + v];
                num[q] = inter[t] * a + bs; }
            if (F.tid < 64) { const int t = F.tid; float a = 0.f, bs = 0.f;
                for (int k = 0; k < 256; ++k) a += ns[k] * (float)Qs[t * 264 + k];
                for (int s = 0; s < 64; ++s) bs += Ss[t * 65 + s];
                den[t] = inter[t] * a + bs; }
            __syncthreads();
#pragma unroll
            for (int q = 0; q < 4; ++q) { const int i = q * 512 + F.tid, t = i >> 5, v = i & 31;
                HMD[(size_t)MROW(t) * BW + h * 256 + vs * 32 + v] = num[q] / fmaxf(fabsf(den[t]), expf(-mrow[t])); }
        }
        __syncthreads();
        { const float decay = misc[1];
          for (int i = F.tid; i < 8192; i += 512) { const int v = i >> 8, k = i & 255; float a = 0.f;
#pragma unroll 8
              for (int s = 0; s < 64; ++s) a += wst[s] * Vs[s * 33 + v] * (float)Ks[s * 264 + k];
              Cs[v * 257 + k] = decay * Cs[v * 257 + k] + a; }
          if (F.tid < 256) { const int k = F.tid; float a = 0.f;
              for (int s = 0; s < 64; ++s) a += wst[s] * (float)Ks[s * 264 + k];
              ns[k] = decay * ns[k] + a; } }
        __syncthreads();
#undef MROW
    }
}


__device__ __forceinline__ void mlstm_unit2(Frame& F, int li, int unit, bool ctx_out) {
    const int vs = unit & 7, dir = (unit >> 3) & 1, h = (unit >> 4) & 3, b = unit >> 6;
    constexpr int QS = 0, KS = 33792, KT = 67584, VT = 104448, SC = 111360, C16 = 120576, VEC = 145920;
    LAS f16* Qs = (LAS f16*)(F.lds + QS); LAS f16* Ks = (LAS f16*)(F.lds + KS); LAS f16* Kt = (LAS f16*)(F.lds + KT); LAS f16* Vt = (LAS f16*)(F.lds + VT);
    LAS f16* Sc = (LAS f16*)(F.lds + SC); LAS f16* Cs = (LAS f16*)(F.lds + C16);
    LAS float* av = (LAS float*)(F.lds + VEC); LAS float* Rv = av + 64; LAS float* interv = av + 128; LAS float* eneg = av + 192; LAS f16* w16 = (LAS f16*)(av + 256); LAS float* misc = av + 288;
    const f16* P = WSP(f16, WS_P); const float* G = WSP(float, WS_G); float* HMD = WSP(float, WS_HMD) + (size_t)dir * MT * BW;
    const float bi_ = inp(14)[(li * 2 + dir) * 4 + h], bf_ = inp(15)[(li * 2 + dir) * 4 + h];
    const int lane = F.lane, wave = F.wave, fr = lane & 15, fq = lane >> 4, tid = F.tid;
    for (int i = tid; i < 48 * 264; i += 512) Cs[i] = (f16)0.f;
    for (int i = tid; i < 16 * 72; i += 512) Vt[32 * 72 + i] = (i < 64) ? (f16)1.f : (f16)0.f;
    f32x4 Cacc[3][2];
#pragma unroll
    for (int vt = 0; vt < 3; ++vt)
#pragma unroll
        for (int nt = 0; nt < 2; ++nt) Cacc[vt][nt] = (f32x4){0.f, 0.f, 0.f, 0.f};
    float m_prev = -INFINITY;
    __syncthreads();
#pragma unroll 1
    for (int j = 0; j < 36; ++j) {
        const bool isctx = j < 4; const int base = isctx ? ML + b * CTXL : b * SEQ, len = isctx ? CTXL : SEQ, off = isctx ? j * 64 : (j - 4) * 64;
#define MROW(s) (base + (dir ? len - 1 - (off + (s)) : off + (s)))
#pragma unroll
        for (int it = 0; it < 4; ++it) { const int i = it * 512 + tid, s = i >> 5, c8 = i & 31; const size_t ro = (size_t)MROW(s) * LDP + h * 256 + c8 * 8;
            const f16x8 q = *(const f16x8*)(P + ro + PQ), k = *(const f16x8*)(P + ro + PK);
            *(LAS f16x8*)(Qs + s * 264 + c8 * 8) = q; *(LAS f16x8*)(Ks + s * 264 + c8 * 8) = k;
#pragma unroll
            for (int e = 0; e < 8; ++e) Kt[(c8 * 8 + e) * 72 + s] = k[e]; }
        if (tid < 256) { const int s = tid >> 2, c = tid & 3; const f16x8 v = *(const f16x8*)(P + (size_t)MROW(s) * LDP + PV + h * 256 + vs * 32 + c * 8);
#pragma unroll
            for (int e = 0; e < 8; ++e) Vt[(c * 8 + e) * 72 + s] = v[e]; }
        if (wave == 0) {
            const int row = MROW(lane); const float igv = G[(size_t)row * 16 + dir * 8 + h] + bi_; const float fp = G[(size_t)row * 16 + dir * 8 + 4 + h] + bf_;
            float cum = fminf(fp, 0.f) - log1pf(expf(-fabsf(fp)));
#pragma unroll
            for (int d = 1; d < 64; d <<= 1) { const float t = __shfl_up(cum, d); if (lane >= d) cum += t; }
            const float a = igv - cum; float R = a;
#pragma unroll
            for (int d = 1; d < 64; d <<= 1) { const float t = __shfl_up(R, d); if (lane >= d) R = fmaxf(R, t); }
            R = fmaxf(R, m_prev);
            const float mrow = cum + R, m_new = __shfl(mrow, 63), cl = __shfl(cum, 63);
            av[lane] = a; Rv[lane] = R; interv[lane] = expf(m_prev - R); eneg[lane] = expf(-mrow); w16[lane] = (f16)expf(cl + a - m_new);
            if (lane == 0) misc[0] = expf(cl + m_prev - m_new);
            m_prev = m_new;
        }
        __syncthreads();
        const bool need_out = !isctx || ctx_out;
        f32x4 nacc[3];
        if (need_out) {
            if (wave >= 4) {
                const int i = wave - 4; f32x4 sacc[4];
#pragma unroll
                for (int st = 0; st < 4; ++st) sacc[st] = (f32x4){0.f, 0.f, 0.f, 0.f};
#pragma unroll
                for (int ks = 0; ks < 8; ++ks) { const f16x8 a = *(const LAS f16x8*)(Qs + (16 * i + fr) * 264 + 32 * ks + 8 * fq);
#pragma unroll
                    for (int st = 0; st < 4; ++st) if (st <= i) { const f16x8 bq = *(const LAS f16x8*)(Ks + (16 * st + fr) * 264 + 32 * ks + 8 * fq); sacc[st] = mfma16(a, bq, sacc[st]); } }
#pragma unroll
                for (int st = 0; st < 4; ++st) { const int sidx = 16 * st + fr; const float as = av[sidx];
#pragma unroll
                    for (int r = 0; r < 4; ++r) { const int t = 16 * i + 4 * fq + r; const float val = (st <= i && sidx <= t) ? sacc[st][r] * __expf(as - Rv[t]) : 0.f; Sc[t * 72 + sidx] = (f16)val; } }
            } else {
                const int i = wave;
#pragma unroll
                for (int vt = 0; vt < 3; ++vt) nacc[vt] = (f32x4){0.f, 0.f, 0.f, 0.f};
#pragma unroll
                for (int ks = 0; ks < 8; ++ks) { const f16x8 a = *(const LAS f16x8*)(Qs + (16 * i + fr) * 264 + 32 * ks + 8 * fq);
#pragma unroll
                    for (int vt = 0; vt < 3; ++vt) { const f16x8 bc = *(const LAS f16x8*)(Cs + (16 * vt + fr) * 264 + 32 * ks + 8 * fq); nacc[vt] = mfma16(a, bc, nacc[vt]); } }
#pragma unroll
                for (int r = 0; r < 4; ++r) { const float sc_ = interv[16 * i + 4 * fq + r];
#pragma unroll
                    for (int vt = 0; vt < 3; ++vt) nacc[vt][r] *= sc_; }
            }
        }
        __syncthreads();
        if (need_out && wave < 4) {
            const int i = wave;
#pragma unroll
            for (int k2 = 0; k2 < 2; ++k2) { const f16x8 a = *(const LAS f16x8*)(Sc + (16 * i + fr) * 72 + 32 * k2 + 8 * fq);
#pragma unroll
                for (int vt = 0; vt < 3; ++vt) { const f16x8 bv = *(const LAS f16x8*)(Vt + (16 * vt + fr) * 72 + 32 * k2 + 8 * fq); nacc[vt] = mfma16(a, bv, nacc[vt]); } }
#pragma unroll
            for (int r = 0; r < 4; ++r) { const int t = 16 * i + 4 * fq + r; const float dn = __shfl(nacc[2][r], lane & 48); const float inv = 1.0f / fmaxf(fabsf(dn), eneg[t]);
                float* hp = HMD + (size_t)MROW(t) * BW + h * 256 + vs * 32 + fr;
                hp[0] = nacc[0][r] * inv; hp[16] = nacc[1][r] * inv; }
        }
        { const float decay = misc[0];
#pragma unroll
          for (int vt = 0; vt < 3; ++vt)
#pragma unroll
              for (int nt = 0; nt < 2; ++nt) Cacc[vt][nt] = Cacc[vt][nt] * decay;
#pragma unroll
          for (int k2 = 0; k2 < 2; ++k2) { const f16x8 wf = *(const LAS f16x8*)(w16 + 32 * k2 + 8 * fq); f16x8 af[3];
#pragma unroll
              for (int vt = 0; vt < 3; ++vt) af[vt] = *(const LAS f16x8*)(Vt + (16 * vt + fr) * 72 + 32 * k2 + 8 * fq) * wf;
#pragma unroll
              for (int nt = 0; nt < 2; ++nt) { const f16x8 bk = *(const LAS f16x8*)(Kt + (32 * wave + 16 * nt + fr) * 72 + 32 * k2 + 8 * fq);
#pragma unroll
                  for (int vt = 0; vt < 3; ++vt) Cacc[vt][nt] = mfma16(af[vt], bk, Cacc[vt][nt]); } }
#pragma unroll
          for (int vt = 0; vt < 3; ++vt)
#pragma unroll
              for (int nt = 0; nt < 2; ++nt)
#pragma unroll
                  for (int r = 0; r < 4; ++r) Cs[(16 * vt + 4 * fq + r) * 264 + 32 * wave + 16 * nt + fr] = (f16)Cacc[vt][nt][r]; }
        __syncthreads();
#undef MROW
    }
}


__device__ __forceinline__ void mlstm_gate_scan(Frame& F, int li, int seq) {
    const int dir = seq & 1, h = (seq >> 1) & 3, b = seq >> 3, lane = F.lane;
    const float* G = WSP(float, WS_G); float* GS = WSP(float, WS_GS) + (size_t)seq * 36 * 320; float* GD = WSP(float, WS_GS + 3 * 512 * 1024) + seq * 36;
    const float bi_ = inp(14)[(li * 2 + dir) * 4 + h], bf_ = inp(15)[(li * 2 + dir) * 4 + h];
    float m_prev = -INFINITY;
#pragma unroll 1
    for (int j = 0; j < 36; ++j) {
        const bool isctx = j < 4; const int base = isctx ? ML + b * CTXL : b * SEQ, len = isctx ? CTXL : SEQ, off = isctx ? j * 64 : (j - 4) * 64;
        const int row = base + (dir ? len - 1 - (off + lane) : off + lane);
        const float igv = G[(size_t)row * 16 + dir * 8 + h] + bi_; const float fp = G[(size_t)row * 16 + dir * 8 + 4 + h] + bf_;
        float cum = fminf(fp, 0.f) - log1pf(expf(-fabsf(fp)));
#pragma unroll
        for (int d = 1; d < 64; d <<= 1) { const float t = __shfl_up(cum, d); if (lane >= d) cum += t; }
        const float a = igv - cum; float R = a;
#pragma unroll
        for (int d = 1; d < 64; d <<= 1) { const float t = __shfl_up(R, d); if (lane >= d) R = fmaxf(R, t); }
        R = fmaxf(R, m_prev);
        const float mrow = cum + R, m_new = __shfl(mrow, 63), cl = __shfl(cum, 63);
        float* o = GS + j * 320 + lane;
        o[0] = a; o[64] = R; o[128] = expf(m_prev - R); o[192] = expf(-mrow); o[256] = expf(cl + a - m_new);
        if (lane == 0) GD[j] = expf(cl + m_prev - m_new);
        m_prev = m_new;
    }
}

__device__ __forceinline__ void mlstm_unit3(Frame& F, int li, int unit, bool ctx_out) {
    const int vs = unit & 7, dir = (unit >> 3) & 1, h = (unit >> 4) & 3, b = unit >> 6, seq = unit >> 3;
    constexpr int QS = 0, KS = 33792, VS = 67584, SC = 74752, C16 = 83968, VEC = 109312;
    LAS f16* Qs = (LAS f16*)(F.lds + QS); LAS f16* Ks = (LAS f16*)(F.lds + KS); LAS f16* Vs = (LAS f16*)(F.lds + VS);
    LAS f16* Sc = (LAS f16*)(F.lds + SC); LAS f16* Cs = (LAS f16*)(F.lds + C16);
    LAS float* gv = (LAS float*)(F.lds + VEC);
    LAS float* av = gv; LAS float* Rv = gv + 64; LAS float* interv = gv + 128; LAS float* eneg = gv + 192; LAS f16* w16 = (LAS f16*)(gv + 320); LAS float* misc = gv + 352;
    const f16* P = WSP(f16, WS_P); float* HMD = WSP(float, WS_HMD) + (size_t)dir * MT * BW;
    const float* GS = WSP(float, WS_GS) + (size_t)seq * 36 * 320; const float* GD = WSP(float, WS_GS + 3 * 512 * 1024) + seq * 36;
    const int lane = F.lane, wave = F.wave, fr = lane & 15, fq = lane >> 4, tid = F.tid;
    for (int i = tid; i < 48 * 264; i += 512) Cs[i] = (f16)0.f;
    for (int i = tid; i < 64 * 16; i += 512) Vs[(i >> 4) * 56 + 32 + (i & 15)] = ((i & 15) == 0) ? (f16)1.f : (f16)0.f;
    f32x4 Cacc[3][2];
#pragma unroll
    for (int vt = 0; vt < 3; ++vt)
#pragma unroll
        for (int nt = 0; nt < 2; ++nt) Cacc[vt][nt] = (f32x4){0.f, 0.f, 0.f, 0.f};
#define MROWJ(j, s) (((j) < 4 ? ML + b * CTXL : b * SEQ) + (dir ? ((j) < 4 ? CTXL : SEQ) - 1 - (((j) < 4 ? (j) * 64 : ((j) - 4) * 64) + (s)) : ((j) < 4 ? (j) * 64 : ((j) - 4) * 64) + (s)))
    f16x8 qreg[4], kreg[4], vreg; float greg = 0.f, dreg = 0.f;
#define ML_PREFETCH(j) do { \
        _Pragma("unroll") for (int it = 0; it < 4; ++it) { const int i_ = it * 512 + tid, s_ = i_ >> 5, c8_ = i_ & 31; const size_t ro_ = (size_t)MROWJ(j, s_) * LDP + h * 256 + c8_ * 8; \
            qreg[it] = *(const f16x8*)(P + ro_ + PQ); kreg[it] = *(const f16x8*)(P + ro_ + PK); } \
        if (tid < 256) vreg = *(const f16x8*)(P + (size_t)MROWJ(j, tid >> 2) * LDP + PV + h * 256 + vs * 32 + (tid & 3) * 8); \
        if (tid < 320) greg = GS[(j) * 320 + tid]; \
        if (tid == 320) dreg = GD[j]; } while (0)
    ML_PREFETCH(0);
    __syncthreads();
#pragma unroll 1
    for (int j = 0; j < 36; ++j) {
        const bool isctx = j < 4;
#pragma unroll
        for (int it = 0; it < 4; ++it) { const int i = it * 512 + tid, s = i >> 5, c8 = i & 31;
            *(LAS f16x8*)(Qs + s * 264 + c8 * 8) = qreg[it]; *(LAS f16x8*)(Ks + s * 264 + c8 * 8) = kreg[it]; }
        if (tid < 256) *(LAS f16x8*)(Vs + (tid >> 2) * 56 + (tid & 3) * 8) = vreg;
        if (tid < 320) { gv[tid] = greg; if (tid >= 256) w16[tid - 256] = (f16)greg; }
        if (tid == 320) misc[0] = dreg;
        __syncthreads();
        if (j + 1 < 36) ML_PREFETCH(j + 1);
        const bool need_out = !isctx || ctx_out;
        f32x4 nacc[3];
        if (need_out) {
            if (wave >= 4) {
                const int i = wave - 4; f32x4 sacc[4];
#pragma unroll
                for (int st = 0; st < 4; ++st) sacc[st] = (f32x4){0.f, 0.f, 0.f, 0.f};
#pragma unroll
                for (int ks = 0; ks < 8; ++ks) { const f16x8 a = *(const LAS f16x8*)(Qs + (16 * i + fr) * 264 + 32 * ks + 8 * fq);
#pragma unroll
                    for (int st = 0; st < 4; ++st) if (st <= i) { const f16x8 bq = *(const LAS f16x8*)(Ks + (16 * st + fr) * 264 + 32 * ks + 8 * fq); sacc[st] = mfma16(a, bq, sacc[st]); } }
#pragma unroll
                for (int st = 0; st < 4; ++st) { const int sidx = 16 * st + fr; const float as = av[sidx];
#pragma unroll
                    for (int r = 0; r < 4; ++r) { const int t = 16 * i + 4 * fq + r; const float val = (st <= i && sidx <= t) ? sacc[st][r] * __expf(as - Rv[t]) : 0.f; Sc[t * 72 + sidx] = (f16)val; } }
            } else {
                const int i = wave;
#pragma unroll
                for (int vt = 0; vt < 3; ++vt) nacc[vt] = (f32x4){0.f, 0.f, 0.f, 0.f};
#pragma unroll
                for (int ks = 0; ks < 8; ++ks) { const f16x8 a = *(const LAS f16x8*)(Qs + (16 * i + fr) * 264 + 32 * ks + 8 * fq);
#pragma unroll
                    for (int vt = 0; vt < 3; ++vt) { const f16x8 bc = *(const LAS f16x8*)(Cs + (16 * vt + fr) * 264 + 32 * ks + 8 * fq); nacc[vt] = mfma16(a, bc, nacc[vt]); } }
#pragma unroll
                for (int r = 0; r < 4; ++r) { const float sc_ = interv[16 * i + 4 * fq + r];
#pragma unroll
                    for (int vt = 0; vt < 3; ++vt) nacc[vt][r] *= sc_; }
            }
        }
        __syncthreads();
        f16x8 vf[2][3];
#pragma unroll
        for (int k2 = 0; k2 < 2; ++k2)
#pragma unroll
            for (int vt = 0; vt < 3; ++vt) { const LAS f16* p = Vs + (32 * k2 + 8 * fq + (fr >> 2)) * 56 + 16 * vt + 4 * (fr & 3);
                const f16x4 lo = lds_tr4(p), hi = lds_tr4(p + 4 * 56); vf[k2][vt] = __builtin_shufflevector(lo, hi, 0, 1, 2, 3, 4, 5, 6, 7); }
        if (need_out && wave < 4) {
            const int i = wave;
#pragma unroll
            for (int k2 = 0; k2 < 2; ++k2) { const f16x8 a = *(const LAS f16x8*)(Sc + (16 * i + fr) * 72 + 32 * k2 + 8 * fq);
#pragma unroll
                for (int vt = 0; vt < 3; ++vt) nacc[vt] = mfma16(a, vf[k2][vt], nacc[vt]); }
#pragma unroll
            for (int r = 0; r < 4; ++r) { const int t = 16 * i + 4 * fq + r; const float dn = __shfl(nacc[2][r], lane & 48); const float inv = 1.0f / fmaxf(fabsf(dn), eneg[t]);
                float* hp = HMD + (size_t)MROWJ(j, t) * BW + h * 256 + vs * 32 + fr;
                hp[0] = nacc[0][r] * inv; hp[16] = nacc[1][r] * inv; }
        }
        { const float decay = misc[0];
#pragma unroll
          for (int vt = 0; vt < 3; ++vt)
#pragma unroll
              for (int nt = 0; nt < 2; ++nt) Cacc[vt][nt] = Cacc[vt][nt] * decay;
#pragma unroll
          for (int k2 = 0; k2 < 2; ++k2) { const f16x8 wf = *(const LAS f16x8*)(w16 + 32 * k2 + 8 * fq);
#pragma unroll
              for (int nt = 0; nt < 2; ++nt) { const LAS f16* p = Ks + (32 * k2 + 8 * fq + (fr >> 2)) * 264 + 32 * wave + 16 * nt + 4 * (fr & 3);
                  const f16x4 lo = lds_tr4(p), hi = lds_tr4(p + 4 * 264); const f16x8 bk = __builtin_shufflevector(lo, hi, 0, 1, 2, 3, 4, 5, 6, 7);
#pragma unroll
                  for (int vt = 0; vt < 3; ++vt) Cacc[vt][nt] = mfma16(vf[k2][vt] * wf, bk, Cacc[vt][nt]); } }
#pragma unroll
          for (int vt = 0; vt < 3; ++vt)
#pragma unroll
              for (int nt = 0; nt < 2; ++nt)
#pragma unroll
                  for (int r = 0; r < 4; ++r) Cs[(16 * vt + 4 * fq + r) * 264 + 32 * wave + 16 * nt + fr] = (f16)Cacc[vt][nt][r]; }
        __syncthreads();
    }
#undef MROWJ
#undef ML_PREFETCH
}

__device__ __forceinline__ void mlstm_unit5(Frame& F, int li, int unit, bool ctx_out) {
    const int vs = unit & 3, dir = (unit >> 2) & 1, h = (unit >> 3) & 3, b = unit >> 5, seq = unit >> 2;
    constexpr int QS = 0, KS = 33792, VS = 67584, SC = 78848, C16 = 88064, VEC = 130304, NVT = 5, VP = 88;
    LAS f16* Qs = (LAS f16*)(F.lds + QS); LAS f16* Ks = (LAS f16*)(F.lds + KS); LAS f16* Vs = (LAS f16*)(F.lds + VS);
    LAS f16* Sc = (LAS f16*)(F.lds + SC); LAS f16* Cs = (LAS f16*)(F.lds + C16);
    LAS float* gv = (LAS float*)(F.lds + VEC);
    LAS float* av = gv; LAS float* Rv = gv + 64; LAS float* interv = gv + 128; LAS float* eneg = gv + 192; LAS f16* w16 = (LAS f16*)(gv + 320); LAS float* misc = gv + 352;
    const f16* P = WSP(f16, WS_P); float* HMD = WSP(float, WS_HMD) + (size_t)dir * MT * BW;
    const float* GS = WSP(float, WS_GS) + (size_t)seq * 36 * 320; const float* GD = WSP(float, WS_GS + 3 * 512 * 1024) + seq * 36;
    const int lane = F.lane, wave = F.wave, fr = lane & 15, fq = lane >> 4, tid = F.tid;
    for (int i = tid; i < 80 * 264; i += 512) Cs[i] = (f16)0.f;
    for (int i = tid; i < 64 * 16; i += 512) Vs[(i >> 4) * VP + 64 + (i & 15)] = ((i & 15) == 0) ? (f16)1.f : (f16)0.f;
    f32x4 Cacc[NVT][2];
#pragma unroll
    for (int vt = 0; vt < NVT; ++vt)
#pragma unroll
        for (int nt = 0; nt < 2; ++nt) Cacc[vt][nt] = (f32x4){0.f, 0.f, 0.f, 0.f};
#define MROWJ(j, s) (((j) < 4 ? ML + b * CTXL : b * SEQ) + (dir ? ((j) < 4 ? CTXL : SEQ) - 1 - (((j) < 4 ? (j) * 64 : ((j) - 4) * 64) + (s)) : ((j) < 4 ? (j) * 64 : ((j) - 4) * 64) + (s)))
    f16x8 qreg[4], kreg[4], vreg; float greg = 0.f, dreg = 0.f;
#define ML_PREFETCH(j) do { \
        _Pragma("unroll") for (int it = 0; it < 4; ++it) { const int i_ = it * 512 + tid, s_ = i_ >> 5, c8_ = i_ & 31; const size_t ro_ = (size_t)MROWJ(j, s_) * LDP + h * 256 + c8_ * 8; \
            qreg[it] = *(const f16x8*)(P + ro_ + PQ); kreg[it] = *(const f16x8*)(P + ro_ + PK); } \
        vreg = *(const f16x8*)(P + (size_t)MROWJ(j, tid >> 3) * LDP + PV + h * 256 + vs * 64 + (tid & 7) * 8); \
        if (tid < 320) greg = GS[(j) * 320 + tid]; \
        if (tid == 320) dreg = GD[j]; } while (0)
    ML_PREFETCH(0);
    __syncthreads();
#pragma unroll 1
    for (int j = 0; j < 36; ++j) {
        const bool isctx = j < 4;
#pragma unroll
        for (int it = 0; it < 4; ++it) { const int i = it * 512 + tid, s = i >> 5, c8 = i & 31;
            *(LAS f16x8*)(Qs + s * 264 + c8 * 8) = qreg[it]; *(LAS f16x8*)(Ks + s * 264 + c8 * 8) = kreg[it]; }
        *(LAS f16x8*)(Vs + (tid >> 3) * VP + (tid & 7) * 8) = vreg;
        if (tid < 320) { gv[tid] = greg; if (tid >= 256) w16[tid - 256] = (f16)greg; }
        if (tid == 320) misc[0] = dreg;
        __syncthreads();
        if (j + 1 < 36) ML_PREFETCH(j + 1);
        const bool need_out = !isctx || ctx_out;
        f32x4 nacc[NVT];
        if (need_out) {
            if (wave >= 4) {
                const int i = wave - 4; f32x4 sacc[4];
#pragma unroll
                for (int st = 0; st < 4; ++st) sacc[st] = (f32x4){0.f, 0.f, 0.f, 0.f};
#pragma unroll
                for (int ks = 0; ks < 8; ++ks) { const f16x8 a = *(const LAS f16x8*)(Qs + (16 * i + fr) * 264 + 32 * ks + 8 * fq);
#pragma unroll
                    for (int st = 0; st < 4; ++st) if (st <= i) { const f16x8 bq = *(const LAS f16x8*)(Ks + (16 * st + fr) * 264 + 32 * ks + 8 * fq); sacc[st] = mfma16(a, bq, sacc[st]); } }
#pragma unroll
                for (int st = 0; st < 4; ++st) { const int sidx = 16 * st + fr; const float as = av[sidx];
#pragma unroll
                    for (int r = 0; r < 4; ++r) { const int t = 16 * i + 4 * fq + r; const float val = (st <= i && sidx <= t) ? sacc[st][r] * __expf(as - Rv[t]) : 0.f; Sc[t * 72 + sidx] = (f16)val; } }
            } else {
                const int i = wave;
#pragma unroll
                for (int vt = 0; vt < NVT; ++vt) nacc[vt] = (f32x4){0.f, 0.f, 0.f, 0.f};
#pragma unroll
                for (int ks = 0; ks < 8; ++ks) { const f16x8 a = *(const LAS f16x8*)(Qs + (16 * i + fr) * 264 + 32 * ks + 8 * fq);
#pragma unroll
                    for (int vt = 0; vt < NVT; ++vt) { const f16x8 bc = *(const LAS f16x8*)(Cs + (16 * vt + fr) * 264 + 32 * ks + 8 * fq); nacc[vt] = mfma16(a, bc, nacc[vt]); } }
#pragma unroll
                for (int r = 0; r < 4; ++r) { const float sc_ = interv[16 * i + 4 * fq + r];
#pragma unroll
                    for (int vt = 0; vt < NVT; ++vt) nacc[vt][r] *= sc_; }
            }
        }
        __syncthreads();
        f16x8 vf[2][NVT];
#pragma unroll
        for (int k2 = 0; k2 < 2; ++k2)
#pragma unroll
            for (int vt = 0; vt < NVT; ++vt) { const LAS f16* p = Vs + (32 * k2 + 8 * fq + (fr >> 2)) * VP + 16 * vt + 4 * (fr & 3);
                const f16x4 lo = lds_tr4(p), hi = lds_tr4(p + 4 * VP); vf[k2][vt] = __builtin_shufflevector(lo, hi, 0, 1, 2, 3, 4, 5, 6, 7); }
        if (need_out && wave < 4) {
            const int i = wave;
#pragma unroll
            for (int k2 = 0; k2 < 2; ++k2) { const f16x8 a = *(const LAS f16x8*)(Sc + (16 * i + fr) * 72 + 32 * k2 + 8 * fq);
#pragma unroll
                for (int vt = 0; vt < NVT; ++vt) nacc[vt] = mfma16(a, vf[k2][vt], nacc[vt]); }
#pragma unroll
            for (int r = 0; r < 4; ++r) { const int t = 16 * i + 4 * fq + r; const float dn = __shfl(nacc[4][r], lane & 48); const float inv = 1.0f / fmaxf(fabsf(dn), eneg[t]);
                float* hp = HMD + (size_t)MROWJ(j, t) * BW + h * 256 + vs * 64 + fr;
                hp[0] = nacc[0][r] * inv; hp[16] = nacc[1][r] * inv; hp[32] = nacc[2][r] * inv; hp[48] = nacc[3][r] * inv; }
        }
        { const float decay = misc[0];
#pragma unroll
          for (int vt = 0; vt < NVT; ++vt)
#pragma unroll
              for (int nt = 0; nt < 2; ++nt) Cacc[vt][nt] = Cacc[vt][nt] * decay;
#pragma unroll
          for (int k2 = 0; k2 < 2; ++k2) { const f16x8 wf = *(const LAS f16x8*)(w16 + 32 * k2 + 8 * fq);
#pragma unroll
              for (int nt = 0; nt < 2; ++nt) { const LAS f16* p = Ks + (32 * k2 + 8 * fq + (fr >> 2)) * 264 + 32 * wave + 16 * nt + 4 * (fr & 3);
                  const f16x4 lo = lds_tr4(p), hi = lds_tr4(p + 4 * 264); const f16x8 bk = __builtin_shufflevector(lo, hi, 0, 1, 2, 3, 4, 5, 6, 7);
#pragma unroll
                  for (int vt = 0; vt < NVT; ++vt) Cacc[vt][nt] = mfma16(vf[k2][vt] * wf, bk, Cacc[vt][nt]); } }
#pragma unroll
          for (int vt = 0; vt < NVT; ++vt)
#pragma unroll
              for (int nt = 0; nt < 2; ++nt)
#pragma unroll
                  for (int r = 0; r < 4; ++r) Cs[(16 * vt + 4 * fq + r) * 264 + 32 * wave + 16 * nt + fr] = (f16)Cacc[vt][nt][r]; }
        __syncthreads();
    }
#undef MROWJ
#undef ML_PREFETCH
}

__device__ __forceinline__ void phase_finish(int li_v) {
    Frame F = make_frame(); const int li = UNI(li_v); const int M = li == DEPTH - 1 ? ML : MT;
    const int gw = F.bid * 8 + F.wave, NGW = F.G * 8;
    const f16* P = WSP(f16, WS_P); const float* HMD = WSP(float, WS_HMD); const float* HL = WSP(float, WS_HL); f16* Y = WSP(f16, WS_Y);
    const float* gn = inp(16) + (size_t)li * BW;
    for (int row = gw; row < M; row += NGW) {
#pragma unroll
        for (int hh = 0; hh < 4; ++hh) { const int c = hh * 256 + 4 * F.lane;
            const f32x4 a = *(const f32x4*)(HMD + (size_t)row * BW + c), bq = *(const f32x4*)(HMD + ((size_t)MT + row) * BW + c);
            const f32x4 s = a + bq; const float ss = wave_sum((s.x * s.x + s.y * s.y) + (s.z * s.z + s.w * s.w));
            const float rstd = rsqrtf(ss * (1.0f / 256.0f) + EPS);
            const f16x4 og = *(const f16x4*)(P + (size_t)row * LDP + PO + c); const f32x4 g = *(const f32x4*)(gn + c);
            u32x2 w; w.x = pk_f16((float)og[0] * s.x * rstd * g.x, (float)og[1] * s.y * rstd * g.y); w.y = pk_f16((float)og[2] * s.z * rstd * g.z, (float)og[3] * s.w * rstd * g.w);
            *(u32x2*)(Y + (size_t)row * BW + c) = w; }
    }
}

constexpr int REP_MIX = 1, REP_L1 = 1, REP_NA = 1, REP_ML = 1; constexpr int REP_GATE = 1, REP_RES = 1, REP_BAR = 0; constexpr int REP_PRO = 1, REP_G1 = 1, REP_G3 = 1, REP_ADALN = 1, REP_LRU0 = 1, REP_FIN = 1;
constexpr int NPL = 13, PH_FINAL = 1 + DEPTH * NPL, NPHASE = PH_FINAL + 1;
__device__ __forceinline__ void ph_gemm_swiglu(int li_v, int which_v) {
    Frame F = make_frame(); const int li = UNI(li_v), which = UNI(which_v);
    unsigned char* wl = F.ws + WS_W + (size_t)li * WL_SIZE; const int M = (which == 1 && li == DEPTH - 1) ? ML : MT;
    pg8::Gemm g{WSP(f16, WS_H), (const f16*)(wl + (which ? WL_W3 : WL_W1)), M, 2 * DFF, D, D}; pg8::StaticOrder S; S.init(M, 2 * DFF, F.G, F.bid);
    EpiSwiGLU E{WSP(f16, WS_P)}; pg8::gemm_phase<EpiSwiGLU, pg8::StaticOrder, true, true>(F.lds, g, S, E, F.tid);
}
__device__ __forceinline__ void ph_gemm_resid(int li_v, int which_v, float cmul = 1.0f) {
    Frame F = make_frame(); const int li = UNI(li_v), which = UNI(which_v);
    unsigned char* wl = F.ws + WS_W + (size_t)li * WL_SIZE;
    const float* modl = WSP(float, WS_MOD) + (size_t)li * 5 * NMODC + (2 + 3 * which) * D;
    const f16* A = which == 1 ? WSP(f16, WS_MH) : WSP(f16, WS_P); const f16* Bt = (const f16*)(wl + (which == 0 ? WL_W2 : which == 1 ? WL_WOUT : WL_W4));
    const int K = which == 1 ? D : DFF;
    pg8::Gemm g{A, Bt, ML, D, K, K}; pg8::StaticOrder S; S.init(ML, D, F.G, F.bid);
    const bool first = li == 0 && which == 0;
    const float* xl = first ? inp(0) : WSP(float, WS_X);
    EpiResid E{WSP(float, WS_X), modl, (which == 1 ? 1.0f : 0.5f) * cmul, xl, xl}; pg8::gemm_phase<EpiResid, pg8::StaticOrder, true, true>(F.lds, g, S, E, F.tid);
}
__device__ __forceinline__ void ph_gemm_resid_ctx(int li_v, int which_v) {
    Frame F = make_frame(); const int li = UNI(li_v), which = UNI(which_v);
    if (which >= 1 && li == DEPTH - 1) return;
    unsigned char* wl = F.ws + WS_W + (size_t)li * WL_SIZE;
    const float* modl = WSP(float, WS_MOD) + (size_t)li * 5 * NMODC + (2 + 3 * which) * D;
    const f16* A = which == 1 ? WSP(f16, WS_MH) : WSP(f16, WS_P); const f16* Bt = (const f16*)(wl + (which == 0 ? WL_W2 : which == 1 ? WL_WOUT : WL_W4));
    const int K = which == 1 ? D : DFF;
    pg8::Gemm g{A, Bt, MT, D, K / 4, K}; pg8::CtxSplitOrder S{F.bid};
    EpiResidPart E{WSP(float, WS_HL), modl, which == 1 ? 1.0f : 0.5f}; pg8::gemm_phase<EpiResidPart, pg8::CtxSplitOrder, false, true>(F.lds, g, S, E, F.tid);
}
__device__ __forceinline__ void ph_gemm_proj(int li_v) {
    Frame F = make_frame(); const int li = UNI(li_v);
    unsigned char* wl = F.ws + WS_W + (size_t)li * WL_SIZE;
    pg8::Gemm g{WSP(f16, WS_H), (const f16*)(wl + WL_WIN), MT, NPIN, D, D};
    EpiProj E{WSP(f16, WS_P), WSP(float, WS_G), WSP(float, WS_ROPE)};
    if (li == DEPTH - 1) { pg8::ProjLastOrder S{F.G, F.bid}; pg8::gemm_phase<EpiProj, pg8::ProjLastOrder, true, true>(F.lds, g, S, E, F.tid); }
    else { pg8::StaticOrder S; S.init(MT, NPIN, F.G, F.bid); pg8::gemm_phase<EpiProj, pg8::StaticOrder, true, true>(F.lds, g, S, E, F.tid); }
}
template <int MODE> __device__ __forceinline__ void ph_gemm_gate(int li_v) {
    Frame F = make_frame(); const int li = UNI(li_v);
    unsigned char* wl = F.ws + WS_W + (size_t)li * WL_SIZE; const int M = li == DEPTH - 1 ? ML : MT;
    const f16* Y = WSP(f16, WS_Y) + (size_t)MODE * MT * BW; const f16* wbr = (const f16*)(wl + WL_WBR) + (size_t)MODE * D * BW; const f16* gate = WSP(f16, WS_P) + GX + MODE * D;
    pg8::Gemm g{Y, wbr, M, D, BW, BW}; pg8::StaticOrder S; S.init(M, D, F.G, F.bid);
    EpiGate<MODE> E{gate, WSP(float, WS_MF), WSP(f16, WS_MH)}; pg8::gemm_phase<EpiGate<MODE>, pg8::StaticOrder, true, true>(F.lds, g, S, E, F.tid);
}
__device__ __forceinline__ void phase_lru_p0(int li_v) {
    Frame F = make_frame(); const int li = UNI(li_v);
    if (F.G >= 64) {
        if (F.bid < 4) mlstm_gate_scan(F, li, F.bid * 8 + F.wave);
        else if (F.bid >= 8) { F.bid -= 8; F.G -= 8; lru_block<0>(F, li, false); }
    } else { if (F.bid * 8 + F.wave < 32) mlstm_gate_scan(F, li, F.bid * 8 + F.wave); __syncthreads(); lru_block<0>(F, li, false); }
}
#ifndef MIXSEL
#define MIXSEL 7
#endif
__device__ __forceinline__ void ph_mix_mlstm(int li_v) {
    Frame F = make_frame(); const int li = UNI(li_v); const bool last = li == DEPTH - 1; const int half = F.G >> 1;
    if (F.bid >= half) return;
    for (int rep = 0; rep < REP_ML; ++rep) for (int u = F.bid; u < 128; u += half) { mlstm_unit5(F, li, u, !last); __syncthreads(); }
}
__device__ __forceinline__ void ph_mix_na(int li_v) {
    Frame F = make_frame(); const int li = UNI(li_v); const bool last = li == DEPTH - 1; const int half = F.G >> 1;
    if (F.bid < half) return;
    F.bid -= half; F.G -= half;
    for (int rep = 0; rep < REP_NA; ++rep) { const int nna = last ? 512 : 576;
      for (int it = F.bid; it < nna; it += F.G) { const bool lat = it < 512; const int x = lat ? it : it - 512;
          const int hp = x & 3, rr = lat ? (x >> 2) & 31 : (x >> 2) & 3, b = lat ? x >> 7 : x >> 4;
          na_item(F, li, lat, b, rr, hp); }
      __syncthreads(); }
}
__device__ __forceinline__ void ph_mix_lru(int li_v) {
    Frame F = make_frame(); const int li = UNI(li_v); const bool last = li == DEPTH - 1; const int half = F.G >> 1;
    const int total = last ? 4 * 32 * 8 : 4 * 36 * 8, nu = (total * 45 / 64) & ~7;
    if (F.bid < half) { F.G = half; for (int rep = 0; rep < REP_L1; ++rep) lru_block<1>(F, li, last, nu, total); }
    else { F.bid -= half; F.G -= half; for (int rep = 0; rep < REP_L1; ++rep) lru_block<1>(F, li, last, 0, nu); }
}
__device__ __forceinline__ void ph_mixers(int li_v) { ph_mix_mlstm(li_v); __syncthreads(); ph_mix_na(li_v); __syncthreads(); ph_mix_lru(li_v); }

__global__ void __launch_bounds__(512, 2) mega_fwd(Args args) {
    LAS unsigned char* lds = (LAS unsigned char*)lds_raw;
    const int tid = threadIdx.x;
    volatile LAS unsigned* MISC = (volatile LAS unsigned*)(lds + LDS_MISC);
    if (tid < 64) MISC[tid] = 0u;
    __syncthreads();
    unsigned* barw = (unsigned*)(args.ws + WS_CTL) + 4096;
    XcdBarrier bar; bar.bar = barw; bar.x = 0; bar.st = nullptr;
    const int lo = args.ph_lo, hi = args.ph_hi;
    if (hi - lo > 1) bar = xcd_barrier_post(barw, MISC + 8);
#define IN(k) (lo <= (k) && (k) < hi && ((PHSEL >> ((k) == 0 ? 16 : (k) == PH_FINAL ? 17 : ((k) - 1) % NPL)) & 1))
#define SEAM(k) do { if (lo <= (k) && (k) + 1 < hi) xcd_barrier(bar); } while (0)
    if (IN(0)) for (int rep = 0; rep < REP_PRO; ++rep) { phase_prologue(); __syncthreads(); }
    SEAM(0);
#pragma unroll 1
    for (int li = 0; li < DEPTH; ++li) {
        const int p0 = 1 + li * NPL;
        if (IN(p0 + 0)) for (int rep = 0; rep < REP_ADALN; ++rep) { phase_adaln(li, 0); __syncthreads(); }
        SEAM(p0 + 0); for (int rep = 0; rep < REP_BAR; ++rep) SEAM(p0 + 0);
        if (IN(p0 + 1)) for (int rep = 0; rep < REP_G1; ++rep) { ph_gemm_swiglu(li, 0); __syncthreads(); }
        SEAM(p0 + 1);
        if (IN(p0 + 2)) { ph_gemm_resid(li, 0); ph_gemm_resid_ctx(li, 0); }
        SEAM(p0 + 2);
        if (IN(p0 + 3)) phase_adaln(li, 1);
        SEAM(p0 + 3);
        if (IN(p0 + 4)) for (int rep = 0; rep < REP_G3; ++rep) { ph_gemm_proj(li); __syncthreads(); }
        SEAM(p0 + 4);
        if (IN(p0 + 5)) for (int rep = 0; rep < REP_LRU0; ++rep) { phase_lru_p0(li); __syncthreads(); }
        SEAM(p0 + 5);
        if (IN(p0 + 6)) for (int rep = 0; rep < REP_MIX; ++rep) { ph_mixers(li); __syncthreads(); }
        SEAM(p0 + 6);
        if (IN(p0 + 7)) for (int rep = 0; rep < REP_FIN; ++rep) { phase_finish(li); __syncthreads(); }
        SEAM(p0 + 7);
        if (IN(p0 + 8)) for (int rep = 0; rep < REP_GATE; ++rep) { ph_gemm_gate<0>(li); ph_gemm_gate<1>(li); ph_gemm_gate<2>(li); __syncthreads(); }
        SEAM(p0 + 8);
        if (IN(p0 + 9)) { ph_gemm_resid(li, 1); ph_gemm_resid_ctx(li, 1); }
        SEAM(p0 + 9);
        if (IN(p0 + 10)) phase_adaln(li, 2);
        SEAM(p0 + 10);
        if (IN(p0 + 11)) ph_gemm_swiglu(li, 1);
        SEAM(p0 + 11);
        if (IN(p0 + 12)) { ph_gemm_resid(li, 2); ph_gemm_resid_ctx(li, 2); }
        SEAM(p0 + 12);
    }
    if (IN(PH_FINAL)) phase_final();
#undef IN
#undef SEAM
}

extern "C" void kernel_launch(void* const* d_in, const int* in_sizes, int n_in, void* d_out, int out_size, void* d_ws, size_t ws_size, hipStream_t stream) {
    static int grid = 0;
    if (grid == 0) {
        if (n_in != 28 || ws_size < WS_END) { fprintf(stderr, "kernel_launch: unexpected n_in %d or ws_size %zu (< %zu)\n", n_in, ws_size, (size_t)WS_END); grid = -1; return; }
        int dev = 0, cus = 0, per_cu = 0;
        if (hipGetDevice(&dev) != hipSuccess || hipDeviceGetAttribute(&cus, hipDeviceAttributeMultiprocessorCount, dev) != hipSuccess) { grid = -1; return; }
        if (hipFuncSetAttribute((const void*)mega_fwd, hipFuncAttributeMaxDynamicSharedMemorySize, LDS_BYTES) != hipSuccess) { fprintf(stderr, "kernel_launch: hipFuncSetAttribute failed\n"); grid = -1; return; }
        if (hipOccupancyMaxActiveBlocksPerMultiprocessor(&per_cu, (const void*)mega_fwd, 512, LDS_BYTES) != hipSuccess || per_cu < 1) fprintf(stderr, "kernel_launch: occupancy query says %d\n", per_cu);
        (void)hipGetLastError();
        grid = cus;
    }
    if (grid < 0) return;
    (void)hipMemsetAsync((char*)d_ws + WS_CTL, 0, 2 * MiB, stream);
    Args a{};
    for (int i = 0; i < 28; ++i) a.in[i] = (const float*)d_in[i];
    a.out = (float*)d_out; a.ws = (unsigned char*)d_ws;
#if MK_ONE_LAUNCH
    a.ph_lo = 0; a.ph_hi = NPHASE;
    hipLaunchKernelGGL(mega_fwd, dim3(grid), dim3(512), LDS_BYTES, stream, a);
#else
    for (int p = 0; p < NPHASE; ++p) { a.ph_lo = p; a.ph_hi = p + 1; hipLaunchKernelGGL(mega_fwd, dim3(grid), dim3(512), LDS_BYTES, stream, a); }
#endif
}
```

```cpp
#include <hip/hip_runtime.h>
#include <cstdio>
#include <cstdint>

#define LAS __attribute__((address_space(3)))
typedef _Float16 f16;
typedef _Float16 f16x8 __attribute__((ext_vector_type(8)));
typedef _Float16 f16x4 __attribute__((ext_vector_type(4)));
typedef _Float16 f16x2 __attribute__((ext_vector_type(2)));
typedef float f32x4 __attribute__((ext_vector_type(4)));
typedef float f32x2 __attribute__((ext_vector_type(2)));
typedef unsigned u32x4 __attribute__((ext_vector_type(4)));
typedef unsigned u32x2 __attribute__((ext_vector_type(2)));

#ifndef PHSEL
#define PHSEL 0xFFFFF
#endif
#ifndef TPROBE
#define TPROBE 0
#endif
#ifndef MK_ONE_LAUNCH
#define MK_ONE_LAUNCH 1
#endif

constexpr int D = 2048, NB = 4, SEQ = 2048, CTXL = 256, DEPTH = 2, DFF = 5632, BW = 1024;
constexpr int ML = NB * SEQ, MC = NB * CTXL, MT = ML + MC;
constexpr int NMODC = 9 * D;
constexpr int PIN_SRC = 15376;
constexpr int NPIN = 15616;
constexpr int LDP = 15360;
constexpr int PQ = 0, PK = 1024, PV = 2048, PO = 3072, NQ = 4096, NK = 5120, NV = 6144, LX = 7168, LG = 8192, GX = 9216;
constexpr float EPS = 1e-6f;

constexpr size_t MiB = 1u << 20;
constexpr size_t WS_CTL = 0;
constexpr size_t WS_MOD = 1 * MiB;
constexpr size_t WS_ROPE = 2 * MiB;
constexpr size_t WS_G = 3 * MiB;
constexpr size_t WS_W = 4 * MiB;
constexpr size_t WL_W1 = 0, WL_W2 = 44 * MiB, WL_W3 = 66 * MiB, WL_W4 = 110 * MiB, WL_WIN = 132 * MiB, WL_WBR = 193 * MiB, WL_WOUT = 205 * MiB, WL_SIZE = 213 * MiB;
constexpr size_t WS_X = WS_W + 2 * WL_SIZE;
constexpr size_t WS_H = WS_X + 72 * MiB;
constexpr size_t WS_P = WS_H + 36 * MiB;
constexpr size_t WS_Y = WS_P + 270 * MiB;
constexpr size_t WS_HMD = WS_Y + 54 * MiB;
constexpr size_t WS_MH = WS_HMD + 72 * MiB;
constexpr size_t WS_PART = WS_MH + 36 * MiB;
constexpr size_t WS_WLRU = WS_PART + 32 * MiB;
constexpr size_t WS_LSUM = WS_WLRU + 2 * MiB;
constexpr size_t WS_GS = WS_LSUM + 3 * MiB;
constexpr size_t WS_LH = WS_GS + 2 * MiB;
constexpr size_t WS_LAC = WS_LH + 36 * MiB;
constexpr size_t WS_END = WS_LAC + 36 * MiB;

constexpr int LDS_BYTES = 147456;
constexpr int LDS_MISC = 147200;

__device__ __forceinline__ unsigned pk_f16(float lo, float hi) { f32x2 v = {lo, hi}; f16x2 h = __builtin_convertvector(v, f16x2); return __builtin_bit_cast(unsigned, h); }
__device__ __forceinline__ float bperm_f(int srclane, float v) { return __builtin_bit_cast(float, __builtin_amdgcn_ds_bpermute(srclane << 2, __builtin_bit_cast(int, v))); }
template <int CTRL> __device__ __forceinline__ float dpp_f(float v) { return __builtin_bit_cast(float, __builtin_amdgcn_update_dpp(0, __builtin_bit_cast(int, v), CTRL, 0xF, 0xF, true)); }
__device__ __forceinline__ float wave_sum(float v, int lane) {
    v += dpp_f<0xB1>(v); v += dpp_f<0x4E>(v); v += dpp_f<0x141>(v); v += dpp_f<0x140>(v);
    v += bperm_f(lane ^ 16, v); v += bperm_f(lane ^ 32, v);
    return v;
}
__device__ __forceinline__ float sigmoidf_(float x) { return __builtin_amdgcn_rcpf(1.0f + __expf(-x)); }
__device__ __forceinline__ float siluf_(float x) { return x * __builtin_amdgcn_rcpf(1.0f + __expf(-x)); }
__device__ __forceinline__ float gelu_tanh_(float x) { const float z = 0.7978845608028654f * (x + 0.044715f * x * x * x); const float e = __expf(2.0f * z); return 0.5f * x * (1.0f + (1.0f - 2.0f * __builtin_amdgcn_rcpf(e + 1.0f))); }
#define LDS_WAIT() asm volatile("s_waitcnt lgkmcnt(0)" ::: "memory")
__device__ __forceinline__ f32x4 mfma16(f16x8 a, f16x8 b, f32x4 c) { return __builtin_amdgcn_mfma_f32_16x16x32_f16(a, b, c, 0, 0, 0); }

typedef __fp16 fp16x4v __attribute__((__vector_size__(8)));
__device__ __forceinline__ f16x4 lds_tr4(const LAS f16* p) { return __builtin_bit_cast(f16x4, __builtin_amdgcn_ds_read_tr16_b64_v4f16((LAS fp16x4v*)p)); }

#define XB_TMO      128
#define XB_XCNT(j)  (256  + 64 * (j))
#define XB_XSUB(j)  (1280 + 64 * (j))
#define XB_XGEN(j)  (2304 + 64 * (j))
#define XB_TOP      3328
#define XB_TOPGEN   3392
#define XCD_BAR_WORDS 3456
#define XB_SPIN_CAP (1u << 25)
__device__ __forceinline__ unsigned xb_ld(unsigned* p)              { return __hip_atomic_load(p, __ATOMIC_RELAXED, __HIP_MEMORY_SCOPE_AGENT); }
__device__ __forceinline__ unsigned xb_add(unsigned* p, unsigned v) { return __hip_atomic_fetch_add(p, v, __ATOMIC_RELAXED, __HIP_MEMORY_SCOPE_AGENT); }
__device__ __forceinline__ unsigned xb_xcc_id() { return (unsigned)__builtin_amdgcn_s_getreg((3 << 11) | 20) & 0xFu; }
#define XB_SPIN(cond, bar) do { unsigned _sp = 0; while (cond) { __builtin_amdgcn_s_sleep(1); \
    if ((++_sp & 255u) == 0u) { if (xb_ld(&(bar)[XB_TMO])) break; if (_sp > XB_SPIN_CAP) { atomicAdd(&(bar)[XB_TMO], 1u); break; } } } } while (0)
struct XcdBarrier { unsigned* bar; unsigned x; volatile LAS unsigned* st; };
__device__ __forceinline__ XcdBarrier xcd_barrier_post(unsigned* bar, volatile LAS unsigned* st) {
    XcdBarrier b; b.bar = bar; b.x = xb_xcc_id(); b.st = st;
    if (threadIdx.x == 0) (void)xb_add(&bar[XB_XCNT(b.x)], 1u);
    return b;
}
__device__ __forceinline__ void xcd_barrier_complete(unsigned* bar, unsigned x, unsigned& nloc, unsigned& nx) {
    const unsigned G = gridDim.x * gridDim.y * gridDim.z;
    unsigned sum, cnt, mine, sp = 0u;
    for (;;) {
        sum = 0u; cnt = 0u; mine = 0u;
#pragma unroll
        for (unsigned j = 0; j < 16; ++j) { const unsigned c = xb_ld(&bar[XB_XCNT(j)]); sum += c; cnt += (c > 0u) ? 1u : 0u; mine = (j == x) ? c : mine; }
        if (sum == G) break;
        __builtin_amdgcn_s_sleep(1);
        if ((++sp & 255u) == 0u) { if (xb_ld(&bar[XB_TMO])) break; if (sp > XB_SPIN_CAP) { atomicAdd(&bar[XB_TMO], 1u); break; } }
    }
    nloc = mine > 0u ? mine : 1u; nx = cnt > 0u ? cnt : 1u;
}
__device__ __forceinline__ void xcd_barrier(const XcdBarrier& b) {
    asm volatile("s_waitcnt vmcnt(0)" ::: "memory");
    __syncthreads();
    if (threadIdx.x == 0) {
        unsigned* bar = b.bar;
        __builtin_amdgcn_s_waitcnt(0);
        unsigned nloc = b.st[0], nx = b.st[1];
        if (nloc == 0u) { xcd_barrier_complete(bar, b.x, nloc, nx); b.st[0] = nloc; b.st[1] = nx; }
        const unsigned old = xb_add(&bar[XB_XSUB(b.x)], 1u);
        const unsigned gen = old / nloc;
        if (old + 1u == (gen + 1u) * nloc) {
            __builtin_amdgcn_fence(__ATOMIC_RELEASE, "agent");
            asm volatile("s_waitcnt vmcnt(0)" ::: "memory");
            const unsigned og = xb_add(&bar[XB_TOP], 1u);
            const unsigned tg = og / nx;
            if (og + 1u == (tg + 1u) * nx) xb_add(&bar[XB_TOPGEN], 1u);
            else XB_SPIN(xb_ld(&bar[XB_TOPGEN]) == tg, bar);
            __builtin_amdgcn_fence(__ATOMIC_ACQUIRE, "agent");
            xb_add(&bar[XB_XGEN(b.x)], 1u);
            asm volatile("s_waitcnt vmcnt(0)" ::: "memory");
        } else {
            XB_SPIN(xb_ld(&bar[XB_XGEN(b.x)]) == gen, bar);
            __builtin_amdgcn_fence(__ATOMIC_ACQUIRE, "agent");
            asm volatile("s_waitcnt vmcnt(0)" ::: "memory");
        }
    }
    __syncthreads();
}

namespace pg8 {
constexpr int BM = 256, BK = 64, HALF = 128, HTB = HALF * BK * 2, STAGE_BYTES = 8 * HTB, NXCD = 8, WGM = 4;
__host__ __device__ __forceinline__ int lds_byte(int r, int c) { const int st = (r >> 4) * 2 + (c >> 5), rr = r & 15, cc = c & 31, ob = rr * 64 + cc * 2; return st * 1024 + (ob ^ (((ob >> 9) & 1) << 5)); }
__host__ __device__ __forceinline__ void stage_rc(int b, int& R, int& C) { const int st = b / 1024, sb = b % 1024, swz = sb ^ (((sb >> 9) & 1) << 5); R = (st >> 1) * 16 + swz / 64; C = (st & 1) * 32 + (swz % 64) / 2; }
__host__ __device__ __forceinline__ int perm32(int rho) { const int n = rho >> 4, i = rho & 15; return 8 * (i >> 2) + 4 * n + (i & 3); }
struct Unit { int pm, pn, kp; };
struct Gemm { const f16* A; const f16* Bt; int M, N, K, ld; };
struct StaticOrder {
    int nM, nN, nwg, G, c;
    __host__ __device__ void init(int M, int N, int G_, int c_) { nM = M / BM; nN = N / BM; nwg = nM * nN; G = G_; c = c_; }
    __host__ __device__ bool next(int i, Unit& u) const {
        const long L = (long)i * G + c; if (L >= nwg) return false;
        int wgid = (int)L; { const int q = nwg / NXCD, r = nwg % NXCD, xcd = wgid % NXCD, off = wgid / NXCD; wgid = (xcd < r ? xcd * (q + 1) : r * (q + 1) + (xcd - r) * q) + off; }
        const int nig = WGM * nN, gid = wgid / nig, fm = gid * WGM, gsz = (nM - fm) < WGM ? (nM - fm) : WGM;
        u.pm = fm + ((wgid % nig) % gsz); u.pn = (wgid % nig) / gsz; u.kp = 0; return true;
    }
    __device__ __forceinline__ void a_ready(const Unit&) const {}
    __device__ __forceinline__ void done(const Unit&) const {}
};
struct ProjLastOrder {
    int G, c;
    __device__ bool next(int i, Unit& u) const {
        const int L = i * G + c; u.kp = 0;
        if (L < 32 * 61) { const int w = (L % NXCD) * (32 * 61 / NXCD) + L / NXCD;
            const int grp = w / (WGM * 61), rem = w % (WGM * 61); u.pm = grp * WGM + rem % WGM; u.pn = rem / WGM; return true; }
        const int x = L - 32 * 61; if (x >= 4 * 21) return false;
        u.pm = 32 + (x & 3); const int t = x >> 2; u.pn = t < 8 ? 4 + t : (t < 20 ? 20 + (t - 8) : 60); return true;
    }
    __device__ __forceinline__ void a_ready(const Unit&) const {}
    __device__ __forceinline__ void done(const Unit&) const {}
};
struct CtxSplitOrder {
    int c, G;
    __device__ bool next(int i, Unit& u) const { const int L = i * G + c; if (L >= 128) return false; u.kp = L & 3; const int t = L >> 2; u.pm = 32 + (t >> 3); u.pn = t & 7; return true; }
    __device__ __forceinline__ void a_ready(const Unit&) const {}
    __device__ __forceinline__ void done(const Unit&) const {}
};
template <class Epi, class Sched, bool ALIGN_EPI = false, bool SP2 = false>
__device__ __forceinline__ void gemm_phase(LAS unsigned char* lds, const Gemm g, const Sched& S, const Epi& E, const int tid) {
    const int wid = __builtin_amdgcn_readfirstlane(tid >> 6), lane = tid & 63, wr = wid >> 2, wc = wid & 3, fr = lane & 15, fq = lane >> 4;
    const int K = g.K, nt = K / BK;
    unsigned voffA[2], voffB[2];
#pragma unroll
    for (int i = 0; i < 2; ++i) { int R, C; stage_rc(tid * 16 + i * 8192, R, C); const int Rb = Epi::PERM ? ((R & ~31) + perm32(R & 31)) : R;
        voffA[i] = (unsigned)(R * g.ld + C) * 2u; voffB[i] = (unsigned)(Rb * g.ld + C) * 2u; }
    const __amdgpu_buffer_rsrc_t rsA = __builtin_amdgcn_make_buffer_rsrc((void*)g.A, 0, 0x7ffff000, 0x00020000), rsB = __builtin_amdgcn_make_buffer_rsrc((void*)g.Bt, 0, 0x7ffff000, 0x00020000);
    const size_t kstep = (size_t)(BK * 2);
    const size_t hstep = (size_t)HALF * g.ld * 2;
    const size_t tstep = 2 * hstep;
    const unsigned ldsw = (unsigned)wid * 1024u;
    const int aoff = lds_byte(wr * 64 + fr, fq * 8), boff = lds_byte(wc * 32 + fr, fq * 8);
#define PG8_SA(b, h) (((b) * 2 + (h)) * HTB)
#define PG8_SB(b, h) ((4 + (b) * 2 + (h)) * HTB)
#define PG8_STAGE(bufoff, gbase, voff, rs, base0) do { const unsigned so_ = (unsigned)((const char*)(gbase) - (const char*)(base0)); _Pragma("unroll") for (int _i = 0; _i < 2; ++_i) \
        __builtin_amdgcn_raw_ptr_buffer_load_lds(rs, (LAS void*)(lds + (bufoff) + ldsw + _i * 8192), 16, (voff)[_i], so_, 0, 0); } while (0)
#define PG8_LDA(dst, b, h) do { _Pragma("unroll") for (int m = 0; m < 4; ++m) _Pragma("unroll") for (int k = 0; k < 2; ++k) dst[m][k] = *(const LAS f16x8*)(lds + PG8_SA(b, h) + aoff + m * 2048 + k * 1024); } while (0)
#define PG8_LDB(dst, b, h) do { _Pragma("unroll") for (int n = 0; n < 2; ++n) _Pragma("unroll") for (int k = 0; k < 2; ++k) dst[n][k] = *(const LAS f16x8*)(lds + PG8_SB(b, h) + boff + n * 2048 + k * 1024); } while (0)
#define PG8_MMA(ai, bj, At, Bt) do { __builtin_amdgcn_s_setprio(1); _Pragma("unroll") for (int m = 0; m < 4; ++m) _Pragma("unroll") for (int n = 0; n < 2; ++n) _Pragma("unroll") for (int k = 0; k < 2; ++k) \
        acc[ai][bj][m][n] = __builtin_amdgcn_mfma_f32_16x16x32_f16(Bt[n][k], At[m][k], acc[ai][bj][m][n], 0, 0, 0); __builtin_amdgcn_s_setprio(0); } while (0)
#define PG8_WAIT_V(n) asm volatile("s_waitcnt vmcnt(" #n ")" ::: "memory")
#define PG8_WAIT_L(n) asm volatile("s_waitcnt lgkmcnt(" #n ")" ::: "memory")
#define PG8_BAR __builtin_amdgcn_s_barrier()
#define PG8_SCHED __builtin_amdgcn_sched_barrier(0)
    Unit cur, nxt; int ui = 0;
    if (!S.next(0, cur)) return;
    f32x4 acc[2][2][4][2];
#pragma unroll
    for (int a = 0; a < 2; ++a)
#pragma unroll
        for (int b = 0; b < 2; ++b)
#pragma unroll
            for (int m = 0; m < 4; ++m)
#pragma unroll
                for (int n = 0; n < 2; ++n) acc[a][b][m][n] = (f32x4){0.f, 0.f, 0.f, 0.f};
    f16x8 At[4][2], B0[2][2], B1[2][2];
    const char* cA = (const char*)g.A + (size_t)cur.pm * tstep + (size_t)cur.kp * K * 2; const char* cB = (const char*)g.Bt + (size_t)cur.pn * tstep + (size_t)cur.kp * K * 2;
    S.a_ready(cur);
    if constexpr (SP2) {
        PG8_STAGE(PG8_SB(0, 0), cB, voffB, rsB, g.Bt); PG8_STAGE(PG8_SB(0, 1), cB + hstep, voffB, rsB, g.Bt); PG8_STAGE(PG8_SA(0, 0), cA, voffA, rsA, g.A); PG8_STAGE(PG8_SA(0, 1), cA + hstep, voffA, rsA, g.A);
        if (wr == 1) PG8_BAR;
        PG8_WAIT_V(2); PG8_BAR;
        PG8_STAGE(PG8_SB(1, 0), cB + kstep, voffB, rsB, g.Bt); PG8_STAGE(PG8_SA(1, 0), cA + kstep, voffA, rsA, g.A); PG8_STAGE(PG8_SB(1, 1), cB + hstep + kstep, voffB, rsB, g.Bt);
        PG8_WAIT_V(6); PG8_BAR;
    } else {
        PG8_STAGE(PG8_SB(0, 0), cB, voffB, rsB, g.Bt); PG8_STAGE(PG8_SA(0, 0), cA, voffA, rsA, g.A); PG8_STAGE(PG8_SB(0, 1), cB + hstep, voffB, rsB, g.Bt); PG8_STAGE(PG8_SA(0, 1), cA + hstep, voffA, rsA, g.A);
        if (wr == 1) PG8_BAR;
        PG8_WAIT_V(4); PG8_BAR;
        PG8_STAGE(PG8_SB(1, 0), cB + kstep, voffB, rsB, g.Bt); PG8_STAGE(PG8_SA(1, 0), cA + kstep, voffA, rsA, g.A); PG8_STAGE(PG8_SB(1, 1), cB + hstep + kstep, voffB, rsB, g.Bt);
        PG8_WAIT_V(6); PG8_BAR;
    }
    for (;;) {
        const bool has_next = S.next(ui + 1, nxt);
        const char* nA = has_next ? (const char*)g.A + (size_t)nxt.pm * tstep + (size_t)nxt.kp * K * 2 : cA; const char* nB = has_next ? (const char*)g.Bt + (size_t)nxt.pn * tstep + (size_t)nxt.kp * K * 2 : cB;
        for (int t = 0; t < nt; t += 2) {
            const bool last = (t == nt - 2);
            const char* a1 = cA + (size_t)(t + 1) * kstep;
            const char* a2 = last ? nA : cA + (size_t)(t + 2) * kstep; const char* b2 = last ? nB : cB + (size_t)(t + 2) * kstep;
            const char* a3 = a2 + kstep; const char* b3 = b2 + kstep;
            if (last && has_next) S.a_ready(nxt);
            if constexpr (SP2) {
            PG8_LDB(B0, 0, 0); PG8_LDB(B1, 0, 1); PG8_SCHED; PG8_LDA(At, 0, 0); PG8_STAGE(PG8_SA(1, 1), a1 + hstep, voffA, rsA, g.A);
            PG8_WAIT_V(8); PG8_WAIT_L(0); PG8_BAR; PG8_MMA(0, 0, At, B0); PG8_MMA(0, 1, At, B1); PG8_BAR; PG8_SCHED;
            PG8_LDA(At, 0, 1); PG8_STAGE(PG8_SB(0, 0), b2, voffB, rsB, g.Bt); PG8_STAGE(PG8_SB(0, 1), b2 + hstep, voffB, rsB, g.Bt); PG8_STAGE(PG8_SA(0, 0), a2, voffA, rsA, g.A);
            PG8_WAIT_V(8); PG8_WAIT_L(0); PG8_BAR; PG8_MMA(1, 0, At, B0); PG8_MMA(1, 1, At, B1); PG8_BAR; PG8_SCHED;
            PG8_LDB(B0, 1, 0); PG8_LDB(B1, 1, 1); PG8_SCHED; PG8_LDA(At, 1, 0); PG8_STAGE(PG8_SA(0, 1), a2 + hstep, voffA, rsA, g.A);
            PG8_WAIT_V(8); PG8_WAIT_L(0); PG8_BAR; PG8_MMA(0, 0, At, B0); PG8_MMA(0, 1, At, B1); PG8_BAR; PG8_SCHED;
            PG8_LDA(At, 1, 1); PG8_STAGE(PG8_SB(1, 0), b3, voffB, rsB, g.Bt); PG8_STAGE(PG8_SB(1, 1), b3 + hstep, voffB, rsB, g.Bt); PG8_STAGE(PG8_SA(1, 0), a3, voffA, rsA, g.A);
            PG8_WAIT_V(8); PG8_WAIT_L(0); PG8_BAR; PG8_MMA(1, 0, At, B0); PG8_MMA(1, 1, At, B1); PG8_BAR; PG8_SCHED;
            } else {
            PG8_LDB(B0, 0, 0); PG8_SCHED; PG8_LDA(At, 0, 0); PG8_STAGE(PG8_SA(1, 1), a1 + hstep, voffA, rsA, g.A);
            PG8_WAIT_L(8); PG8_BAR; PG8_WAIT_L(0); PG8_MMA(0, 0, At, B0); PG8_BAR; PG8_SCHED;
            PG8_LDB(B1, 0, 1); PG8_STAGE(PG8_SB(0, 0), b2, voffB, rsB, g.Bt);
            PG8_BAR; PG8_WAIT_L(0); PG8_MMA(0, 1, At, B1); PG8_BAR;
            PG8_LDA(At, 0, 1); PG8_STAGE(PG8_SA(0, 0), a2, voffA, rsA, g.A);
            PG8_BAR; PG8_WAIT_L(0); PG8_MMA(1, 0, At, B0); PG8_BAR; PG8_SCHED;
            PG8_STAGE(PG8_SB(0, 1), b2 + hstep, voffB, rsB, g.Bt);
            PG8_WAIT_V(6); PG8_BAR; PG8_MMA(1, 1, At, B1); PG8_BAR;
            PG8_LDB(B0, 1, 0); PG8_SCHED; PG8_LDA(At, 1, 0); PG8_STAGE(PG8_SA(0, 1), a2 + hstep, voffA, rsA, g.A);
            PG8_WAIT_L(8); PG8_BAR; PG8_WAIT_L(0); PG8_MMA(0, 0, At, B0); PG8_BAR; PG8_SCHED;
            PG8_LDB(B1, 1, 1); PG8_STAGE(PG8_SB(1, 0), b3, voffB, rsB, g.Bt);
            PG8_BAR; PG8_WAIT_L(0); PG8_MMA(0, 1, At, B1); PG8_BAR;
            PG8_LDA(At, 1, 1); PG8_STAGE(PG8_SA(1, 0), a3, voffA, rsA, g.A);
            PG8_BAR; PG8_WAIT_L(0); PG8_MMA(1, 0, At, B0); PG8_BAR; PG8_SCHED;
            PG8_STAGE(PG8_SB(1, 1), b3 + hstep, voffB, rsB, g.Bt);
            PG8_WAIT_V(6); PG8_BAR; PG8_MMA(1, 1, At, B1); PG8_BAR;
            }
        }
        if constexpr (ALIGN_EPI) { if (wr == 0) PG8_BAR; }
        E(acc, cur, wr, wc, fr, fq); S.done(cur);
        if (!has_next) break;
#pragma unroll
        for (int a = 0; a < 2; ++a)
#pragma unroll
            for (int b = 0; b < 2; ++b)
#pragma unroll
                for (int m = 0; m < 4; ++m)
#pragma unroll
                    for (int n = 0; n < 2; ++n) acc[a][b][m][n] = (f32x4){0.f, 0.f, 0.f, 0.f};
        cur = nxt; cA = nA; cB = nB; ++ui;
        if constexpr (ALIGN_EPI) { if (wr == 1) PG8_BAR; }
    }
    PG8_WAIT_V(0);
    if constexpr (!ALIGN_EPI) { if (wr == 0) PG8_BAR; }
    PG8_BAR;
#undef PG8_SA
#undef PG8_SB
#undef PG8_STAGE
#undef PG8_LDA
#undef PG8_LDB
#undef PG8_MMA
#undef PG8_WAIT_V
#undef PG8_WAIT_L
#undef PG8_BAR
#undef PG8_SCHED
}
}
using pg8::Unit;
constexpr int HALF = pg8::HALF, BM = pg8::BM;

struct EpiSwiGLU {
    static constexpr bool PERM = true;
    f16* O;
    __device__ __forceinline__ void operator()(const f32x4 (&acc)[2][2][4][2], const Unit& u, int wr, int wc, int fr, int fq) const {
        asm volatile("" : "+v"(fr), "+v"(fq));
        const int row0 = u.pm * BM + wr * 64 + fr, col0 = u.pn * HALF + wc * 32 + 8 * fq;
#pragma unroll
        for (int ai = 0; ai < 2; ++ai)
#pragma unroll
            for (int m = 0; m < 4; ++m) {
                f16* rowp = O + (size_t)(row0 + ai * HALF + m * 16) * DFF + col0;
                const f32x4 g0 = acc[ai][0][m][0], g1 = acc[ai][0][m][1], u0 = acc[ai][1][m][0], u1 = acc[ai][1][m][1];
                u32x4 w;
                w.x = pk_f16(siluf_(g0[0]) * u0[0], siluf_(g0[1]) * u0[1]); w.y = pk_f16(siluf_(g0[2]) * u0[2], siluf_(g0[3]) * u0[3]);
                w.z = pk_f16(siluf_(g1[0]) * u1[0], siluf_(g1[1]) * u1[1]); w.w = pk_f16(siluf_(g1[2]) * u1[2], siluf_(g1[3]) * u1[3]);
                *(u32x4*)rowp = w;
            }
    }
};
struct EpiResid {
    static constexpr bool PERM = true;
    f16* X; const float* modg;
    int halfc; const float* Xin32;
    __device__ __forceinline__ void operator()(const f32x4 (&acc)[2][2][4][2], const Unit& u, int wr, int wc, int fr, int fq) const {
        asm volatile("" : "+v"(fr), "+v"(fq));
        const int row0 = u.pm * BM + wr * 64 + fr, col0 = u.pn * BM + wc * 32 + 8 * fq;
        const int bidx = u.pm < 32 ? (u.pm >> 3) : 4;
        const float* gp = modg + (size_t)bidx * NMODC + col0; const float coef = halfc ? 0.5f : 1.0f;
        f32x4 gv[2][2];
#pragma unroll
        for (int bj = 0; bj < 2; ++bj)
#pragma unroll
            for (int n = 0; n < 2; ++n) gv[bj][n] = *(const f32x4*)(gp + bj * HALF + n * 4) * coef;
#pragma unroll
        for (int ai = 0; ai < 2; ++ai)
#pragma unroll
            for (int m = 0; m < 4; ++m) { const size_t ro = (size_t)(row0 + ai * HALF + m * 16) * D + col0;
#pragma unroll
                for (int bj = 0; bj < 2; ++bj) { f32x4 x0, x1;
                    if (Xin32) { x0 = *(const f32x4*)(Xin32 + ro + bj * HALF); x1 = *(const f32x4*)(Xin32 + ro + bj * HALF + 4); }
                    else { const f16x8 h8 = *(const f16x8*)(X + ro + bj * HALF); x0 = (f32x4){(float)h8[0], (float)h8[1], (float)h8[2], (float)h8[3]}; x1 = (f32x4){(float)h8[4], (float)h8[5], (float)h8[6], (float)h8[7]}; }
                    x0 = x0 + gv[bj][0] * acc[ai][bj][m][0]; x1 = x1 + gv[bj][1] * acc[ai][bj][m][1];
                    u32x4 w; w.x = pk_f16(x0[0], x0[1]); w.y = pk_f16(x0[2], x0[3]); w.z = pk_f16(x1[0], x1[1]); w.w = pk_f16(x1[2], x1[3]);
                    *(u32x4*)(X + ro + bj * HALF) = w; } }
    }
};
struct EpiResidPart {
    static constexpr bool PERM = false;
    float* PART; const float* modg; float coef;
    __device__ __forceinline__ void operator()(const f32x4 (&acc)[2][2][4][2], const Unit& u, int wr, int wc, int fr, int fq) const {
        asm volatile("" : "+v"(fr), "+v"(fq));
        const int row0 = (u.pm - 32) * BM + wr * 64 + fr, col0 = u.pn * BM + wc * 32 + 4 * fq;
        const float* gp = modg + (size_t)4 * NMODC + col0;
        f32x4 gv[2][2];
#pragma unroll
        for (int bj = 0; bj < 2; ++bj)
#pragma unroll
            for (int n = 0; n < 2; ++n) gv[bj][n] = *(const f32x4*)(gp + bj * HALF + n * 16) * coef;
#pragma unroll
        for (int ai = 0; ai < 2; ++ai)
#pragma unroll
            for (int m = 0; m < 4; ++m) { float* rowp = PART + ((size_t)u.kp * MC + row0 + ai * HALF + m * 16) * D + col0;
#pragma unroll
                for (int bj = 0; bj < 2; ++bj)
#pragma unroll
                    for (int n = 0; n < 2; ++n) *(f32x4*)(rowp + bj * HALF + n * 16) = gv[bj][n] * acc[ai][bj][m][n]; }
    }
};
struct EpiProj {
    static constexpr bool PERM = true;
    f16* P; float* G; const float* rope;
    __device__ __forceinline__ void operator()(const f32x4 (&acc)[2][2][4][2], const Unit& u, int wr, int wc, int fr, int fq) const {
        asm volatile("" : "+v"(fr), "+v"(fq));
        const int row0 = u.pm * BM + wr * 64 + fr; const int pn = u.pn;
        if (pn == 60) {
            if (wc == 0 && fq < 2) {
#pragma unroll
                for (int ai = 0; ai < 2; ++ai)
#pragma unroll
                    for (int m = 0; m < 4; ++m) { float* gp = G + (size_t)(row0 + ai * HALF + m * 16) * 16 + 8 * fq;
                        *(f32x4*)gp = acc[ai][0][m][0]; *(f32x4*)(gp + 4) = acc[ai][0][m][1]; }
            }
            return;
        }
        const int col0 = pn * BM + wc * 32 + 8 * fq;
        int mode = 0; float scl = 1.0f;
        if (pn < 8) { mode = (u.pm < 32) ? 1 : 2; scl = (pn >= 4) ? 0.0625f : 1.0f; }
        else if (pn >= 12 && pn < 16) mode = 3;
        else if (pn >= 16 && pn < 20) { mode = 2; scl = 0.08838834764831845f; }
        else if (pn >= 32 && pn < 36) mode = 4;
        else if (pn >= 36) mode = 3;
#pragma unroll
        for (int ai = 0; ai < 2; ++ai)
#pragma unroll
            for (int m = 0; m < 4; ++m) {
                const int row = row0 + ai * HALF + m * 16;
                f16* rowp = P + (size_t)row * LDP + col0;
#pragma unroll
                for (int bj = 0; bj < 2; ++bj) {
                    f32x4 v0 = acc[ai][bj][m][0], v1 = acc[ai][bj][m][1];
                    if (mode == 1) {
                        const int t = row & (SEQ - 1); const int pos = bj == 0 ? (t >> 6) : (t & 63);
                        const float* cp = rope + pos * 64 + 16 * wc + 4 * fq;
                        const f32x4 c = *(const f32x4*)cp, s = *(const f32x4*)(cp + 4096);
                        f32x4 o0, o1;
                        o0[0] = v0[0] * c[0] - v0[1] * s[0]; o0[1] = v0[0] * s[0] + v0[1] * c[0];
                        o0[2] = v0[2] * c[1] - v0[3] * s[1]; o0[3] = v0[2] * s[1] + v0[3] * c[1];
                        o1[0] = v1[0] * c[2] - v1[1] * s[2]; o1[1] = v1[0] * s[2] + v1[1] * c[2];
                        o1[2] = v1[2] * c[3] - v1[3] * s[3]; o1[3] = v1[2] * s[3] + v1[3] * c[3];
                        v0 = o0 * scl; v1 = o1 * scl;
                    } else if (mode == 2) { v0 = v0 * scl; v1 = v1 * scl; }
                    else if (mode == 3) {
#pragma unroll
                        for (int e = 0; e < 4; ++e) { v0[e] = sigmoidf_(v0[e]); v1[e] = sigmoidf_(v1[e]); }
                    } else if (mode == 4) {
#pragma unroll
                        for (int e = 0; e < 4; ++e) { v0[e] = gelu_tanh_(v0[e]); v1[e] = gelu_tanh_(v1[e]); }
                    }
                    u32x4 w; w.x = pk_f16(v0[0], v0[1]); w.y = pk_f16(v0[2], v0[3]); w.z = pk_f16(v1[0], v1[1]); w.w = pk_f16(v1[2], v1[3]);
                    *(u32x4*)(rowp + bj * HALF) = w;
                }
            }
    }
};
template <int MODE> struct EpiGate {
    static constexpr bool PERM = true;
    const f16* gate;
    f16* MH;
    __device__ __forceinline__ void operator()(const f32x4 (&acc)[2][2][4][2], const Unit& u, int wr, int wc, int fr, int fq) const {
        asm volatile("" : "+v"(fr), "+v"(fq));
        const int row0 = u.pm * BM + wr * 64 + fr, col0 = u.pn * BM + wc * 32 + 8 * fq;
#pragma unroll
        for (int ai = 0; ai < 2; ++ai)
#pragma unroll
            for (int m = 0; m < 4; ++m) {
                const int row = row0 + ai * HALF + m * 16;
#pragma unroll
                for (int bj = 0; bj < 2; ++bj) {
                    const f16x8 gh = *(const f16x8*)(gate + (size_t)row * LDP + col0 + bj * HALF);
                    f16* mp = MH + (size_t)row * D + col0 + bj * HALF;
                    f32x4 v0 = acc[ai][bj][m][0], v1 = acc[ai][bj][m][1];
#pragma unroll
                    for (int e = 0; e < 4; ++e) { v0[e] *= (float)gh[e]; v1[e] *= (float)gh[4 + e]; }
                    if (MODE >= 1) { const f16x8 pm_ = *(const f16x8*)mp;
#pragma unroll
                        for (int e = 0; e < 4; ++e) { v0[e] += (float)pm_[e]; v1[e] += (float)pm_[4 + e]; } }
                    { u32x4 w; w.x = pk_f16(v0[0], v0[1]); w.y = pk_f16(v0[2], v0[3]); w.z = pk_f16(v1[0], v1[1]); w.w = pk_f16(v1[2], v1[3]); *(u32x4*)mp = w; }
                }
            }
    }
};

struct Args { const float* in[28]; float* out; unsigned char* ws; int ph_lo, ph_hi; };
struct Frame {
    LAS unsigned char* lds; int tid, lane, wave, G, bid;
    float* out; unsigned char* ws;
};
typedef const Args __attribute__((address_space(4)))* KArgs;
__device__ __forceinline__ KArgs kargs() { return (KArgs)__builtin_amdgcn_kernarg_segment_ptr(); }
__device__ __forceinline__ const float* inp(int k) { return kargs()->in[k]; }
extern __shared__ __attribute__((aligned(16))) unsigned char lds_raw[];
__device__ __forceinline__ Frame make_frame() {
    Frame F; F.lds = (LAS unsigned char*)lds_raw; int t = threadIdx.x; asm volatile("" : "+v"(t));
    F.tid = t; F.lane = F.tid & 63; F.wave = __builtin_amdgcn_readfirstlane(F.tid >> 6);
    int g = gridDim.x, b = blockIdx.x; asm volatile("" : "+s"(g), "+s"(b)); F.G = g; F.bid = b;
    KArgs ka = kargs(); asm volatile("" : "+s"(ka)); F.out = ka->out; F.ws = ka->ws; return F;
}
#define UNI(x) __builtin_amdgcn_readfirstlane(x)
#define WSP(T, off) ((T*)(F.ws + (off)))

template <int MAP> __device__ __forceinline__ int dest_row(int c) {
    if (MAP == 0) return c;
    if (MAP == 1) { const int bj = c >= DFF ? 1 : 0, j = c - bj * DFF; return (j >> 7) * 256 + bj * 128 + (j & 127); }
    if (c < 2048) { const int base = c & 1024, x = c & 255, hh = (c >> 8) & 3, bj = x >> 7, within = x & 127, e = within >> 6, i = within & 63; return base + hh * 256 + bj * 128 + 2 * i + e; }
    if (c < 4096) return c;
    if (c < 4112) return 15360 + (c - 4096);
    return c - 16;
}
template <int MAP> __device__ __forceinline__ void transpose_item2(const float* W, int ldw, int k0, int c0, f16* WT, int Kdim, LAS float* scr, int lane) {
    const int col4 = (lane & 7) * 4; const bool cv = c0 + col4 < ldw;
    f32x4 v[8];
#pragma unroll
    for (int it = 0; it < 8; ++it) { const int r = it * 8 + (lane >> 3); v[it] = cv ? __builtin_nontemporal_load((const f32x4*)(W + (size_t)(k0 + r) * ldw + c0 + col4)) : (f32x4){0.f, 0.f, 0.f, 0.f}; }
#pragma unroll
    for (int it = 0; it < 8; ++it) { const int r = it * 8 + (lane >> 3); LAS float* d = scr + r * 33 + col4; d[0] = v[it].x; d[1] = v[it].y; d[2] = v[it].z; d[3] = v[it].w; }
    LDS_WAIT();
    const int c = lane & 7;
#pragma unroll
    for (int j = 0; j < 4; ++j) { const int n = (lane >> 3) + 8 * j; const LAS float* sp = scr + (8 * c) * 33 + n;
        u32x4 o; o.x = pk_f16(sp[0 * 33], sp[1 * 33]); o.y = pk_f16(sp[2 * 33], sp[3 * 33]); o.z = pk_f16(sp[4 * 33], sp[5 * 33]); o.w = pk_f16(sp[6 * 33], sp[7 * 33]);
        if (c0 + n < ldw) __builtin_nontemporal_store(o, (u32x4*)(WT + (size_t)dest_row<MAP>(c0 + n) * Kdim + k0 + 8 * c)); }
    LDS_WAIT();
}
constexpr int CV_W1 = 32 * 352, CV_W2 = 88 * 64, CV_WIN = 32 * 481, CV_WBR = 3 * 16 * 64, CV_WOUT = 32 * 64, CV_LRU = 256;
constexpr int CV_PER_L = 2 * CV_W1 + 2 * CV_W2 + CV_WIN + CV_WBR + CV_WOUT + CV_LRU;
__device__ __forceinline__ void convert_item(Frame& F, int l, int r, LAS float* scr) {
    unsigned char* wl = F.ws + WS_W + (size_t)l * WL_SIZE;
    if (r < 2 * CV_W1) { const int which = r / CV_W1; r %= CV_W1;
        transpose_item2<1>(inp(which ? 11 : 9) + (size_t)l * D * 2 * DFF, 2 * DFF, (r / 352) * 64, (r % 352) * 32, (f16*)(wl + (which ? WL_W3 : WL_W1)), D, scr, F.lane); return; }
    r -= 2 * CV_W1;
    if (r < 2 * CV_W2) { const int which = r / CV_W2; r %= CV_W2;
        transpose_item2<0>(inp(which ? 12 : 10) + (size_t)l * DFF * D, D, (r / 64) * 64, (r % 64) * 32, (f16*)(wl + (which ? WL_W4 : WL_W2)), DFF, scr, F.lane); return; }
    r -= 2 * CV_W2;
    if (r < CV_WIN) { transpose_item2<2>(inp(13) + (size_t)l * D * PIN_SRC, PIN_SRC, (r / 481) * 64, (r % 481) * 32, (f16*)(wl + WL_WIN), D, scr, F.lane); return; }
    r -= CV_WIN;
    if (r < CV_WBR) { const int n = r / 1024; r %= 1024;
        transpose_item2<0>(inp(25) + ((size_t)l * 3 + n) * BW * D, D, (r / 64) * 64, (r % 64) * 32, (f16*)(wl + WL_WBR) + (size_t)n * D * BW, BW, scr, F.lane); return; }
    r -= CV_WBR;
    if (r < CV_WOUT) { transpose_item2<0>(inp(26) + (size_t)l * D * D, D, (r / 64) * 64, (r % 64) * 32, (f16*)(wl + WL_WOUT), D, scr, F.lane); return; }
    r -= CV_WOUT;
    { const int mat = r >> 7, ng = (r >> 3) & 15, kb = (r >> 2) & 1, nb = r & 3;
      transpose_item2<0>(inp(mat ? 22 : 20) + ((size_t)l * 16 + ng) * 128 * 128, 128, kb * 64, nb * 32, WSP(f16, WS_WLRU) + (((size_t)l * 2 + mat) * 16 + ng) * 128 * 128, 128, scr, F.lane); }
}
constexpr int CO_A = CV_W1 + CV_W2 + CV_WIN + CV_LRU;
constexpr int CO_L0 = CV_PER_L, CO_TOT = 2 * CV_PER_L;
__device__ __forceinline__ void ord_item(Frame& F, int o, LAS float* scr) {
    const int l = o >= CO_L0 ? 1 : 0; int x = o - l * CO_L0;
    constexpr int N_W3 = CV_W1, N_W2 = 2 * CV_W1, N_W4 = 2 * CV_W1 + CV_W2, N_WIN = 2 * CV_W1 + 2 * CV_W2, N_WBR = N_WIN + CV_WIN, N_WOUT = N_WBR + CV_WBR, N_LRU = N_WOUT + CV_WOUT;
    int r;
    if (x < CV_W1) r = x;
    else if ((x -= CV_W1) < CV_W2) r = N_W2 + x;
    else if ((x -= CV_W2) < CV_WIN) r = N_WIN + x;
    else if ((x -= CV_WIN) < CV_LRU) r = N_LRU + x;
    else if ((x -= CV_LRU) < CV_WBR) r = N_WBR + x;
    else if ((x -= CV_WBR) < CV_WOUT) r = N_WOUT + x;
    else if ((x -= CV_WOUT) < CV_W1) r = N_W3 + x;
    else { x -= CV_W1; r = N_W4 + x; }
    convert_item(F, l, r, scr);
}
__device__ __forceinline__ void ph_convert_idle(int nunits, int q, int start) {
    Frame F = make_frame();
    if (F.G != 256) return;
    LAS float* scr = (LAS float*)(F.lds + F.wave * 16384);
    const int first_idle = nunits - ((nunits + F.G - 1) / F.G - 1) * F.G; if (F.bid < first_idle) return;
    const int nidle = F.G - first_idle, j = F.bid - first_idle, lim = min(start + nidle * 8 * q, CO_TOT);
#pragma unroll 1
    for (int t = 0; t < q; ++t) { const int o = start + (t * nidle + j) * 8 + F.wave; if (o < lim) ord_item(F, o, scr); }
}
__device__ __forceinline__ void ph_convert_all(int start, int end) {
    Frame F = make_frame();
    if (F.G != 256) return;
    LAS float* scr = (LAS float*)(F.lds + F.wave * 16384);
    for (int o = start + F.bid * 8 + F.wave; o < end; o += F.G * 8) ord_item(F, o, scr);
}
constexpr int CS1 = CO_A, CS2 = CS1 + 208 * 48, CS3 = CS2 + 128 * 24, CS4 = CS3 + 108 * 48, CS5 = CS4 + 224 * 48, CS6 = CS5 + 224 * 24, CS7 = CS6 + 128 * 24, CS8 = CS7 + 208 * 48,
              CT1 = CS8 + 128 * 24, CT2 = CT1 + 208 * 48, CT3 = CT2 + 128 * 24, CO_W3END = CO_TOT - CV_W2;
static_assert(CS4 >= CO_A + CV_WBR && CS6 >= CO_A + CV_WBR + CV_WOUT && CS7 >= CO_L0 - CV_W2 && CS8 >= CO_L0, "layer-0 deadlines");
static_assert(CT1 >= CO_L0 + CV_W1 && CT2 >= CO_L0 + CV_W1 + CV_W2 && CT3 >= CO_L0 + CO_A + CV_WBR + CV_WOUT && CT3 <= CO_W3END && CO_W3END + 128 * 48 >= CO_TOT, "layer-1 deadlines");
__device__ __forceinline__ void phase_prologue() {
    Frame F = make_frame();
    const int gw = F.bid * 8 + F.wave, NGW = F.G * 8;
    const int gt = F.bid * 512 + F.tid, NGT = F.G * 512;
    { const f32x4* cs = (const f32x4*)inp(2); u32x2* X = WSP(u32x2, WS_X) + (size_t)ML * D / 4; for (int i = gt; i < MC * D / 4; i += NGT) { const f32x4 v = cs[i]; u32x2 w; w.x = pk_f16(v.x, v.y); w.y = pk_f16(v.z, v.w); X[i] = w; } }
    { float* rope = WSP(float, WS_ROPE);
      for (int i = gt; i < 4096; i += NGT) { const int pos = i >> 6, j = i & 63; const float inv = powf(10000.0f, -(float)j / 64.0f); const float a = (float)pos * inv; rope[i] = cosf(a); rope[4096 + i] = sinf(a); }
      for (int l = 0; l < DEPTH; ++l) { u32x4* z = (u32x4*)(F.ws + WS_W + (size_t)l * WL_SIZE + WL_WIN + (size_t)15376 * D * 2);
          for (int i = gt; i < 240 * D * 2 / 16; i += NGT) z[i] = (u32x4){0u, 0u, 0u, 0u}; } }
    LAS float* scr = (LAS float*)(F.lds + F.wave * 16384);
    LAS float* sa = (LAS float*)(F.lds + F.wave * 16384 + 8448);
    for (int it = F.bid; it < DEPTH * 72; it += F.G) {
        const int l = it / 72, cg = it % 72, n0 = cg * 256 + 4 * F.lane, k0 = F.wave * 256;
        for (int i = F.lane; i < 5 * 256; i += 64) { const int bi = i >> 8, k = i & 255; const float c = bi < 4 ? inp(1)[bi * D + k0 + k] : inp(3)[k0 + k]; sa[i] = siluf_(c); }
        LDS_WAIT();
        const float* Wm = inp(4) + (size_t)l * D * NMODC + (size_t)k0 * NMODC + n0;
        f32x4 acc[5];
#pragma unroll
        for (int bi = 0; bi < 5; ++bi) acc[bi] = (f32x4){0.f, 0.f, 0.f, 0.f};
#pragma unroll 8
        for (int kk = 0; kk < 256; ++kk) { const f32x4 w = __builtin_nontemporal_load((const f32x4*)(Wm + (size_t)kk * NMODC));
#pragma unroll
            for (int bi = 0; bi < 5; ++bi) acc[bi] = acc[bi] + w * sa[bi * 256 + kk]; }
#pragma unroll
        for (int bi = 0; bi < 5; ++bi) *(LAS f32x4*)(scr + bi * 256 + 4 * F.lane) = acc[bi];
        __syncthreads();
        for (int i = F.tid; i < 5 * 256; i += 512) { const int bi = i >> 8, col = i & 255; float sum = inp(5)[(size_t)l * NMODC + cg * 256 + col];
#pragma unroll
            for (int w = 0; w < 8; ++w) sum += ((LAS float*)(F.lds + w * 16384))[bi * 256 + col];
            WSP(float, WS_MOD)[((size_t)l * 5 + bi) * NMODC + cg * 256 + col] = sum; }
        __syncthreads();
    }
    if (F.G == 256) {
        constexpr int NHI = 30352;
        if (F.bid >= 144) { for (int o = (F.bid - 144) * 8 + F.wave; o < NHI; o += 112 * 8) ord_item(F, o, scr); }
        else { for (int o = NHI + F.bid * 8 + F.wave; o < CO_A; o += 144 * 8) ord_item(F, o, scr); }
    } else { for (int o = gw; o < CO_TOT; o += NGW) ord_item(F, o, scr); }
}

__device__ __forceinline__ void phase_adaln(int li_v, int which_v) {
    Frame F = make_frame(); const int li = UNI(li_v), which = UNI(which_v);
    const float* gain = inp(6 + which) + (size_t)li * D; const int chunk_shift = 3 * which; const int M = (which == 2 && li == DEPTH - 1) ? ML : MT;
    const int gw = F.bid * 8 + F.wave, NGW = F.G * 8;
    const bool first = li == 0 && which == 0;
    const f16* XH = WSP(f16, WS_X); f16* H = WSP(f16, WS_H);
#pragma unroll 1
    for (int pass = 0; pass < 2; ++pass) {
        int bidx, rbeg, rend, rstep;
        if (pass == 0) { const int wpb = NGW / NB; if (wpb == 0) { bidx = -1; rbeg = rend = rstep = 0; } else { bidx = gw / wpb; rbeg = bidx * SEQ + gw % wpb; rend = (bidx + 1) * SEQ; rstep = wpb; if (bidx >= NB) { bidx = -1; } } }
        else { bidx = 4; rbeg = ML + gw; rend = M; rstep = NGW; }
        if (bidx < 0 || rbeg >= rend) continue;
        const float* modb = WSP(float, WS_MOD) + ((size_t)li * 5 + bidx) * NMODC + chunk_shift * D;
        f32x4 gm[4][2], sh[4][2];
#pragma unroll
        for (int j = 0; j < 4; ++j)
#pragma unroll
            for (int hh = 0; hh < 2; ++hh) { const int c = (64 * j + F.lane) * 8 + 4 * hh; gm[j][hh] = *(const f32x4*)(gain + c) * (*(const f32x4*)(modb + D + c) + 1.0f); sh[j][hh] = *(const f32x4*)(modb + c); }
#pragma unroll 1
        for (int row = rbeg; row < rend; row += rstep) {
            f32x4 v[4][2]; float ss = 0.f;
            if (first && row < ML) { const f32x4* xr = (const f32x4*)(inp(0) + (size_t)row * D) + 2 * F.lane;
#pragma unroll
                for (int j = 0; j < 4; ++j) { v[j][0] = xr[128 * j]; v[j][1] = xr[128 * j + 1]; } }
            else { const f16x8* xr = (const f16x8*)(XH + (size_t)row * D) + F.lane;
#pragma unroll
                for (int j = 0; j < 4; ++j) { const f16x8 h8 = __builtin_nontemporal_load(xr + 64 * j);
                    v[j][0] = (f32x4){(float)h8[0], (float)h8[1], (float)h8[2], (float)h8[3]}; v[j][1] = (f32x4){(float)h8[4], (float)h8[5], (float)h8[6], (float)h8[7]}; } }
            if (row >= ML && !first) {
                const f32x4* pr = (const f32x4*)(WSP(float, WS_PART) + (size_t)(row - ML) * D) + 2 * F.lane;
#pragma unroll
                for (int kp = 0; kp < 4; ++kp)
#pragma unroll
                    for (int j = 0; j < 4; ++j) { v[j][0] = v[j][0] + pr[(size_t)kp * MC * D / 4 + 128 * j]; v[j][1] = v[j][1] + pr[(size_t)kp * MC * D / 4 + 128 * j + 1]; }
                u32x4* xw = (u32x4*)(WSP(f16, WS_X) + (size_t)row * D) + F.lane;
#pragma unroll
                for (int j = 0; j < 4; ++j) { u32x4 w; w.x = pk_f16(v[j][0].x, v[j][0].y); w.y = pk_f16(v[j][0].z, v[j][0].w); w.z = pk_f16(v[j][1].x, v[j][1].y); w.w = pk_f16(v[j][1].z, v[j][1].w); xw[64 * j] = w; }
            }
#pragma unroll
            for (int j = 0; j < 4; ++j)
#pragma unroll
                for (int hh = 0; hh < 2; ++hh) ss += (v[j][hh].x * v[j][hh].x + v[j][hh].y * v[j][hh].y) + (v[j][hh].z * v[j][hh].z + v[j][hh].w * v[j][hh].w);
            const float rstd = rsqrtf(wave_sum(ss, F.lane) * (1.0f / D) + EPS);
            u32x4* o = (u32x4*)(H + (size_t)row * D) + F.lane;
#pragma unroll
            for (int j = 0; j < 4; ++j) { const f32x4 y0 = v[j][0] * rstd * gm[j][0] + sh[j][0], y1 = v[j][1] * rstd * gm[j][1] + sh[j][1];
                u32x4 w; w.x = pk_f16(y0.x, y0.y); w.y = pk_f16(y0.z, y0.w); w.z = pk_f16(y1.x, y1.y); w.w = pk_f16(y1.z, y1.w); o[64 * j] = w; }
        }
    }
}
__device__ __forceinline__ void phase_final() {
    Frame F = make_frame();
    const int gw = F.bid * 8 + F.wave, NGW = F.G * 8;
    const f16* X = WSP(f16, WS_X); const float* gain = inp(27);
    for (int row = gw; row < ML; row += NGW) {
        const f16x4* xr = (const f16x4*)(X + (size_t)row * D) + F.lane;
        f32x4 v[8]; float ss = 0.f;
#pragma unroll
        for (int j = 0; j < 8; ++j) { const f16x4 h4 = xr[64 * j]; v[j] = (f32x4){(float)h4[0], (float)h4[1], (float)h4[2], (float)h4[3]}; ss += (v[j].x * v[j].x + v[j].y * v[j].y) + (v[j].z * v[j].z + v[j].w * v[j].w); }
        const float rstd = rsqrtf(wave_sum(ss, F.lane) * (1.0f / D) + EPS);
        f32x4* o = (f32x4*)(F.out + (size_t)row * D) + F.lane;
#pragma unroll
        for (int j = 0; j < 8; ++j) { const int c = (64 * j + F.lane) * 4; f32x4 r_ = v[j] * rstd * *(const f32x4*)(gain + c);
#if TPROBE
            { const float* tp = (const float*)(F.ws + WS_CTL) + 2048; r_ = r_ * (1.0f + sqrtf(tp[0] * 1e-3f)); if (row == 0 && c == 0) r_.x += tp[1] * 1e3f; }
#endif
            o[64 * j] = r_; }
    }
}


template <int PASS> __device__ __forceinline__ void lru_block(Frame& F, int li, bool latent_only, int ufirst = 0, int ulimit = 1 << 30) {
    LAS f16* Xc = (LAS f16*)F.lds;
    LAS float* Hs = (LAS float*)(F.lds + 17408);
    const f16* P = WSP(f16, WS_P); float* SUM = WSP(float, WS_LSUM);
    const int lane0 = F.lane, wave = F.wave, tid0 = F.tid; int tid = tid0, c8 = (tid0 & 15) * 8;
    const int nunits = min(latent_only ? 4 * 32 * 8 : 4 * 36 * 8, ulimit);
#define LRU_UNIT(it) (latent_only ? ((it) / 256) * 288 + 32 + ((it) % 256) : (it))
#define LRU_ROW0(u) ((((u) >> 3) % 36) < 4 ? ML + ((u) / 288) * CTXL + (((u) >> 3) % 36) * 64 : ((u) / 288) * SEQ + ((((u) >> 3) % 36) - 4) * 64)
#define LRU_SBEG(u) ((((u) >> 3) % 36) < 4 ? ML + ((u) / 288) * CTXL : ((u) / 288) * SEQ)
#define LRU_SEND(u) (LRU_SBEG(u) + ((((u) >> 3) % 36) < 4 ? CTXL : SEQ))
    f16x8 raw[2][4];
#define LRU_PREFETCH(u) do { const int row0_ = LRU_ROW0(u), sb_ = LRU_SBEG(u), se_ = LRU_SEND(u), g_ = (u) & 7; \
        _Pragma("unroll") for (int it_ = 0; it_ < 2; ++it_) { const int row_ = row0_ + ((it_ * 512 + tid) >> 4); \
            _Pragma("unroll") for (int j_ = 0; j_ < 4; ++j_) { const int rr_ = row_ + j_ - 1; raw[it_][j_] = (f16x8){0, 0, 0, 0, 0, 0, 0, 0}; \
                if (rr_ >= sb_ && rr_ < se_) raw[it_][j_] = *(const f16x8*)(P + (size_t)rr_ * LDP + LX + g_ * 128 + c8); } } } while (0)
    int gprev = -1;
    f16x8 wa[2][4], wx[2][4]; float bav[2], bxv[2], sp[2];
    if (ufirst + F.bid < nunits) LRU_PREFETCH(LRU_UNIT(ufirst + F.bid));
#pragma unroll 1
    for (int itu = ufirst + F.bid; itu < nunits; itu += F.G) {
        const int unit = LRU_UNIT(itu);
        int lane = lane0; tid = tid0; asm volatile("" : "+v"(lane), "+v"(tid));
        const int fr = lane & 15, fq = lane >> 4; c8 = (tid & 15) * 8;
        const int g = unit & 7, seg = (unit >> 3) % 36, b = unit / 288;
        const bool isctx = seg < 4; const int row0 = LRU_ROW0(unit);
        if (g != gprev) {
            gprev = g;
#pragma unroll
            for (int q = 0; q < 2; ++q) { const int c = wave * 2 + q, n = c >> 3, jt = c & 7, ch = g * 128 + 16 * jt + fr;
                const f16* wt = WSP(f16, WS_WLRU) + ((((size_t)li * 2 + 0) * 2 + n) * 8 + g) * 128 * 128 + (size_t)(16 * jt + fr) * 128 + 8 * fq;
#pragma unroll
                for (int ks = 0; ks < 4; ++ks) { wa[q][ks] = *(const f16x8*)(wt + 32 * ks); wx[q][ks] = *(const f16x8*)(wt + (size_t)2 * 8 * 128 * 128 + 32 * ks); }
                bav[q] = inp(21)[(size_t)li * 2 * BW + n * BW + ch]; bxv[q] = inp(23)[(size_t)li * 2 * BW + n * BW + ch];
                sp[q] = log1pf(expf(-inp(24)[(size_t)li * 2 * BW + n * BW + ch])); }
        }
        const float* cw = inp(18) + (size_t)li * 4 * BW + g * 128 + c8; const float* cb = inp(19) + (size_t)li * BW + g * 128 + c8;
#pragma unroll
        for (int it = 0; it < 2; ++it) { const int t = (it * 512 + tid) >> 4;
            float y[8];
#pragma unroll
            for (int e = 0; e < 8; ++e) { y[e] = cb[e];
#pragma unroll
                for (int j = 0; j < 4; ++j) y[e] += cw[j * BW + e] * (float)raw[it][j][e]; }
            u32x4 w; w.x = pk_f16(y[0], y[1]); w.y = pk_f16(y[2], y[3]); w.z = pk_f16(y[4], y[5]); w.w = pk_f16(y[6], y[7]);
            *(LAS u32x4*)(Xc + t * 136 + c8) = w; }
        __syncthreads();
        if (itu + F.G < nunits) LRU_PREFETCH(LRU_UNIT(itu + F.G));
#pragma unroll
        for (int q = 0; q < 2; ++q) {
            const int c = wave * 2 + q, n = c >> 3, jt = c & 7, ch = g * 128 + 16 * jt + fr;
            float carry = 0.f, aprod = 1.f;
            if (PASS == 1) {
                const float* sb = SUM + ((size_t)b * 36 * 2 + n) * 2048 + ch * 2;
                const int cnt = n == 0 ? seg : (isctx ? 3 - seg : 39 - seg);
                f32x2 pv[9];
#pragma unroll
                for (int e = 0; e < 9; ++e) { const int p = fq * 9 + e; const int s2 = n == 0 ? p : (isctx ? 3 - p : (p < 4 ? 3 - p : 39 - p));
                    pv[e] = (f32x2){1.f, 0.f}; if (p < cnt) pv[e] = *(const f32x2*)(sb + (size_t)s2 * 4096); }
                float Al = 1.f, Ul = 0.f;
#pragma unroll
                for (int e = 0; e < 9; ++e) { Ul = Ul * pv[e].x + pv[e].y; Al *= pv[e].x; }
#pragma unroll
                for (int gg = 0; gg < 4; ++gg) { const float Ag = __shfl(Al, gg * 16 + fr), Ug = __shfl(Ul, gg * 16 + fr); carry = carry * Ag + Ug; }
                __builtin_amdgcn_sched_barrier(0);
            }
            float av_[4][4], uv_[4][4];
#pragma unroll
            for (int tt = 0; tt < 4; ++tt) {
                f32x4 racc = (f32x4){0.f, 0.f, 0.f, 0.f}, iacc = (f32x4){0.f, 0.f, 0.f, 0.f};
#pragma unroll
                for (int ks = 0; ks < 4; ++ks) { const f16x8 a = *(const LAS f16x8*)(Xc + (16 * tt + fr) * 136 + 32 * ks + 8 * fq); racc = mfma16(a, wa[q][ks], racc); iacc = mfma16(a, wx[q][ks], iacc); }
#pragma unroll
                for (int r = 0; r < 4; ++r) { const int t = 16 * tt + 4 * fq + r; const float rg = sigmoidf_(racc[r] + bav[q]), ig = sigmoidf_(iacc[r] + bxv[q]);
                    const float log_a = -8.0f * rg * sp[q]; av_[tt][r] = __expf(log_a);
                    const float y2 = 2.0f * log_a;
                    const float om = y2 > -0.125f ? -y2 * (1.0f + y2 * (0.5f + y2 * (0.16666667f + y2 * (0.041666668f + y2 * 0.0083333338f)))) : 1.0f - __expf(y2);
                    uv_[tt][r] = __builtin_amdgcn_sqrtf(om) * ig * (float)Xc[t * 136 + 16 * jt + fr]; }
                if (tt & 1) __builtin_amdgcn_sched_barrier(0);
            }
#pragma unroll
            for (int k = 0; k < 4; ++k) {
                const int tt = n ? 3 - k : k;
                float a4[4], u4[4];
#pragma unroll
                for (int r = 0; r < 4; ++r) { a4[r] = n ? av_[3 - k][r] : av_[k][r]; u4[r] = n ? uv_[3 - k][r] : uv_[k][r]; }
                float Al = 1.f, Ul = 0.f;
#pragma unroll
                for (int rr = 0; rr < 4; ++rr) { const float ar = n ? a4[3 - rr] : a4[rr], ur = n ? u4[3 - rr] : u4[rr]; Ul = Ul * ar + ur; Al *= ar; }
                float preA = 1.f, preU = 0.f, totA = 1.f, totU = 0.f;
#pragma unroll
                for (int gg = 0; gg < 4; ++gg) { const int gsrc = n ? 3 - gg : gg; const float Ag = __shfl(Al, gsrc * 16 + fr), Ug = __shfl(Ul, gsrc * 16 + fr);
                    const bool before = n ? (gsrc > fq) : (gsrc < fq);
                    if (before) { preU = preU * Ag + Ug; preA *= Ag; }
                    totU = totU * Ag + Ug; totA *= Ag; }
                float hrun = carry * preA + preU, arun = aprod * preA;
#pragma unroll
                for (int rr = 0; rr < 4; ++rr) { const float ar = n ? a4[3 - rr] : a4[rr], ur = n ? u4[3 - rr] : u4[rr]; hrun = ar * hrun + ur; arun *= ar;
                    const int e_ = (n * 64 + 16 * tt + 4 * fq + (n ? 3 - rr : rr)) * 128 + 16 * jt + fr;
                    if (PASS == 1) Hs[e_] = hrun;
                    else { ((LAS f16*)Hs)[e_] = (f16)hrun; ((LAS f16*)Hs)[16384 + e_] = (f16)arun; } }
                carry = carry * totA + totU; aprod *= totA;
            }
            if (PASS == 0 && fq == 0) { f32x2 v = {aprod, carry}; *(f32x2*)(SUM + (((size_t)b * 36 + seg) * 2 + n) * 2048 + ch * 2) = v; }
            __builtin_amdgcn_sched_barrier(0);
        }
        __syncthreads();
        if (PASS == 0) {
            f16* LH = WSP(f16, WS_LH); f16* LAC = WSP(f16, WS_LAC);
#pragma unroll
            for (int it = 0; it < 2; ++it) { const int t = (it * 512 + tid) >> 4; const size_t ro = ((size_t)(row0 + t) * 2) * BW + g * 128 + c8;
#pragma unroll
                for (int n = 0; n < 2; ++n) { *(u32x4*)(LH + ro + n * BW) = *(const LAS u32x4*)((LAS f16*)Hs + (n * 64 + t) * 128 + c8); *(u32x4*)(LAC + ro + n * BW) = *(const LAS u32x4*)((LAS f16*)Hs + 16384 + (n * 64 + t) * 128 + c8); } }
            __syncthreads();
        }
        if (PASS == 1) {
            f16* Y = WSP(f16, WS_Y) + (size_t)2 * MT * BW;
#pragma unroll
            for (int it = 0; it < 2; ++it) { const int t = (it * 512 + tid) >> 4; const int row = row0 + t;
                const f16x8 gg = *(const f16x8*)(P + (size_t)row * LDP + LG + g * 128 + c8);
                float y[8];
#pragma unroll
                for (int e = 0; e < 8; ++e) y[e] = (Hs[t * 128 + c8 + e] + Hs[(64 + t) * 128 + c8 + e]) * (float)gg[e];
                u32x4 w; w.x = pk_f16(y[0], y[1]); w.y = pk_f16(y[2], y[3]); w.z = pk_f16(y[4], y[5]); w.w = pk_f16(y[6], y[7]);
                *(u32x4*)(Y + (size_t)row * BW + g * 128 + c8) = w; }
            __syncthreads();
        }
    }
#undef LRU_UNIT
#undef LRU_ROW0
#undef LRU_SBEG
#undef LRU_SEND
#undef LRU_PREFETCH
}


__device__ __forceinline__ void lru_fix_block(Frame& F, int li, bool latent_only, int ufirst, int ulimit) {
    LAS float* cs = (LAS float*)F.lds;
    const f16* P = WSP(f16, WS_P); const float* SUM = WSP(float, WS_LSUM); const f16* LH = WSP(f16, WS_LH); const f16* LAC = WSP(f16, WS_LAC); f16* Y = WSP(f16, WS_Y) + (size_t)2 * MT * BW;
    const int tid = F.tid, c8 = (tid & 15) * 8;
    const int nunits = min(latent_only ? 4 * 32 * 8 : 4 * 36 * 8, ulimit);
#pragma unroll 1
    for (int itu = ufirst + F.bid; itu < nunits; itu += F.G) {
        const int unit = latent_only ? (itu / 256) * 288 + 32 + (itu % 256) : itu;
        const int g = unit & 7, seg = (unit >> 3) % 36, b = unit / 288; const bool isctx = seg < 4;
        const int row0 = isctx ? ML + b * CTXL + seg * 64 : b * SEQ + (seg - 4) * 64;
        if (tid < 256) { const int n = tid >> 7, ch = g * 128 + (tid & 127);
            const float* sb = SUM + ((size_t)b * 36 * 2 + n) * 2048 + ch * 2;
            const int cnt = n == 0 ? seg : (isctx ? 3 - seg : 39 - seg);
            float carry = 0.f;
#pragma unroll 5
            for (int p = 0; p < 35; ++p) { const int s2 = n == 0 ? p : (isctx ? 3 - p : (p < 4 ? 3 - p : 39 - p)); f32x2 v = {1.f, 0.f}; if (p < cnt) v = *(const f32x2*)(sb + (size_t)s2 * 4096); carry = carry * v.x + v.y; }
            cs[tid] = carry; }
        __syncthreads();
#pragma unroll
        for (int it = 0; it < 2; ++it) { const int t = (it * 512 + tid) >> 4; const int row = row0 + t; const size_t ro = ((size_t)row * 2) * BW + g * 128 + c8;
            const f16x8 hf = *(const f16x8*)(LH + ro), hb = *(const f16x8*)(LH + ro + BW), af = *(const f16x8*)(LAC + ro), ab = *(const f16x8*)(LAC + ro + BW);
            const f16x8 gg = *(const f16x8*)(P + (size_t)row * LDP + LG + g * 128 + c8);
            float y[8];
#pragma unroll
            for (int e = 0; e < 8; ++e) y[e] = ((float)hf[e] + (float)af[e] * cs[c8 + e] + (float)hb[e] + (float)ab[e] * cs[128 + c8 + e]) * (float)gg[e];
            u32x4 w; w.x = pk_f16(y[0], y[1]); w.y = pk_f16(y[2], y[3]); w.z = pk_f16(y[4], y[5]); w.w = pk_f16(y[6], y[7]);
            *(u32x4*)(Y + (size_t)row * BW + g * 128 + c8) = w; }
        __syncthreads();
    }
}

__device__ __forceinline__ void na_item(Frame& F, int li, bool lat, int b, int rr, int hpair, int& staged_hp) {
    constexpr int KB = 34816, VB = 36864, BUF = KB + VB;
    const int lane = F.lane, wave = F.wave, fr = lane & 15, fq = lane >> 4, tid = F.tid;
    const int i = wave & 3, hs = wave >> 2, h = hpair * 2 + hs;
    const f16* P = WSP(f16, WS_P); f16* Y = WSP(f16, WS_Y) + (size_t)1 * MT * BW;
    LAS float* rtab = (LAS float*)(F.lds + 2 * BUF);
    if (staged_hp != hpair) { staged_hp = hpair; for (int i_ = tid; i_ < 2 * 465; i_ += 512) rtab[i_] = inp(17)[((size_t)li * 8 + hpair * 2) * 465 + i_]; }
    const LAS float* rpb = rtab + hs * 465;
    const int q0row = lat ? b * SEQ + rr * 64 + 16 * i : ML + b * CTXL + rr * 64 + 16 * i;
    f16x8 qf[4];
#pragma unroll
    for (int ks = 0; ks < 4; ++ks) qf[ks] = *(const f16x8*)(P + (size_t)(q0row + fr) * LDP + NQ + h * 128 + 32 * ks + 8 * fq);
    f32x4 oacc[8];
#pragma unroll
    for (int dt = 0; dt < 8; ++dt) oacc[dt] = (f32x4){0.f, 0.f, 0.f, 0.f};
    float m_run = -INFINITY, l_run = 0.f;
    const int c0 = min(max(16 * i - 8, 0), 32), rs = min(max(rr - 4, 0), 24), qc = 16 * i + fr, cs = min(max(qc - 8, 0), 48);
    const int nstep = lat ? 12 : 4, nwin = lat ? 8 : 0;
#define NA_ROWBASE(st) ((st) < nwin ? b * SEQ + (rs + (st)) * 64 : ML + b * CTXL + ((st) - nwin) * 64)
    f16x8 preA[8], preB[8];
    const __amdgpu_buffer_rsrc_t rsP = __builtin_amdgcn_make_buffer_rsrc((void*)P, 0, 0x7ffff000, 0x00020000);
    const unsigned na_vo = (unsigned)(((tid >> 4) * LDP + (tid & 15) * 8) * 2);
#define NA_LOAD(pre, st) do { const unsigned so_ = (unsigned)__builtin_amdgcn_readfirstlane(NA_ROWBASE(st)) * (unsigned)(LDP * 2) + (unsigned)(hpair * 2 * 128 * 2); _Pragma("unroll") for (int it_ = 0; it_ < 8; ++it_) \
        pre[it_] = __builtin_bit_cast(f16x8, __builtin_amdgcn_raw_buffer_load_b128(rsP, na_vo, so_ + (unsigned)((32 * (it_ & 1) * LDP + ((it_ >> 2) ? NV : NK) + ((it_ >> 1) & 1) * 128) * 2), 0)); } while (0)
#define NA_STORE(pre, buf) do { _Pragma("unroll") for (int it_ = 0; it_ < 8; ++it_) { const int id_ = it_ * 512 + tid, rem_ = id_ & 2047, hs_ = rem_ >> 10, key_ = (rem_ >> 4) & 63, ch_ = rem_ & 15; \
        LAS f16* d_ = (LAS f16*)(F.lds + (buf) * BUF + ((id_ >> 11) ? KB + (hs_ * 64 + key_) * 288 : (hs_ * 64 + key_) * 272)) + ch_ * 8; *(LAS f16x8*)d_ = pre[it_]; } } while (0)
    NA_LOAD(preA, 0); NA_LOAD(preB, 1); NA_STORE(preA, 0);
    __syncthreads();
#pragma unroll 1
    for (int st2 = 0; st2 < nstep; st2 += 2) {
#pragma unroll
      for (int par = 0; par < 2; ++par) {
        const int st = st2 + par, cur = par;
        const bool win = st < nwin;
        float bv[8];
        { const LAS float* rrow = rpb + min(rs + st - rr + 7, 14) * 31;
#pragma unroll
            for (int nt = 0; nt < 2; ++nt)
#pragma unroll
                for (int r = 0; r < 4; ++r) { const int kc = c0 + 16 * nt + 4 * fq + r; bv[nt * 4 + r] = rrow[min(max(kc - qc + 15, 0), 30)]; } }
        __builtin_amdgcn_sched_barrier(0);
        { const int stn = min(st + 2, nstep - 1); if (par == 0) NA_LOAD(preA, stn); else NA_LOAD(preB, stn); }
        __builtin_amdgcn_sched_barrier(0);
        const LAS f16* Kb = (const LAS f16*)(F.lds + cur * BUF) + hs * 64 * 136;
        const LAS f16* Vb = (const LAS f16*)(F.lds + cur * BUF + KB) + hs * 64 * 144;
        const int nsub = win ? 1 : 2;
#pragma unroll 1
        for (int sub = 0; sub < nsub; ++sub) {
            const int koff = win ? c0 : 32 * sub;
            f16x8 kf[2][4];
#pragma unroll
            for (int nt = 0; nt < 2; ++nt)
#pragma unroll
                for (int ks = 0; ks < 4; ++ks) kf[nt][ks] = *(const LAS f16x8*)(Kb + (koff + 16 * nt + fr) * 136 + 32 * ks + 8 * fq);
            f32x4 sacc[2];
#pragma unroll
            for (int nt = 0; nt < 2; ++nt) { sacc[nt] = (f32x4){0.f, 0.f, 0.f, 0.f};
#pragma unroll
                for (int ks = 0; ks < 4; ++ks) sacc[nt] = mfma16(kf[nt][ks], qf[ks], sacc[nt]); }
            float sv[8]; float bm = -INFINITY;
#pragma unroll
            for (int nt = 0; nt < 2; ++nt)
#pragma unroll
                for (int r = 0; r < 4; ++r) { const int kc = c0 + 16 * nt + 4 * fq + r; const bool valid = !win || (kc >= cs && kc < cs + 16);
                    const float x = valid ? sacc[nt][r] + (win ? bv[nt * 4 + r] : 0.f) : -INFINITY;
                    sv[nt * 4 + r] = x; bm = fmaxf(bm, x); }
            bm = fmaxf(bm, bperm_f(lane ^ 16, bm)); bm = fmaxf(bm, bperm_f(lane ^ 32, bm));
            const float m_new = fmaxf(m_run, bm), alpha = __expf(m_run - m_new);
            float ps = 0.f;
#pragma unroll
            for (int e = 0; e < 8; ++e) { sv[e] = __expf(sv[e] - m_new); ps += sv[e]; }
            ps += bperm_f(lane ^ 16, ps); ps += bperm_f(lane ^ 32, ps);
            l_run = l_run * alpha + ps; m_run = m_new;
            f16x8 pf;
#pragma unroll
            for (int e = 0; e < 8; ++e) pf[e] = (f16)sv[e];
            const LAS f16* vb = Vb + (koff + 4 * fq + (fr >> 2)) * 144 + 4 * (fr & 3);
#pragma unroll
            for (int dt = 0; dt < 8; ++dt) { oacc[dt] = oacc[dt] * alpha;
                const f16x4 alo = lds_tr4(vb + 16 * dt), ahi = lds_tr4(vb + 16 * 144 + 16 * dt);
                const f16x8 a = __builtin_shufflevector(alo, ahi, 0, 1, 2, 3, 4, 5, 6, 7);
                oacc[dt] = mfma16(a, pf, oacc[dt]); }
        }
        if (st + 1 < nstep) { if (par == 0) NA_STORE(preB, 1); else NA_STORE(preA, 0); }
        __syncthreads();
      }
    }
#undef NA_ROWBASE
#undef NA_LOAD
#undef NA_STORE
    const float inv = 1.0f / l_run;
    LAS f16* Ot = (LAS f16*)(F.lds + wave * 4352);
#pragma unroll
    for (int dt = 0; dt < 8; ++dt) { u32x2 w; w.x = pk_f16(oacc[dt][0] * inv, oacc[dt][1] * inv); w.y = pk_f16(oacc[dt][2] * inv, oacc[dt][3] * inv);
        *(LAS u32x2*)(Ot + fr * 136 + 16 * dt + 4 * fq) = w; }
    { const int row = lane >> 2, seg = lane & 3;
#pragma unroll
      for (int c = 0; c < 4; ++c) { const u32x4 w = *(const LAS u32x4*)(Ot + row * 136 + seg * 32 + c * 8);
          *(u32x4*)(Y + (size_t)(q0row + row) * BW + h * 128 + seg * 32 + c * 8) = w; } }
    __syncthreads();
}


__device__ __forceinline__ void mlstm_gate_scan(Frame& F, int li, int seq) {
    const int dir = seq & 1, h = (seq >> 1) & 3, b = seq >> 3, lane = F.lane;
    const float* G = WSP(float, WS_G); float* GS = WSP(float, WS_GS) + (size_t)seq * 36 * 320; float* GD = WSP(float, WS_GS + 3 * 512 * 1024) + seq * 36;
    const float bi_ = inp(14)[(li * 2 + dir) * 4 + h], bf_ = inp(15)[(li * 2 + dir) * 4 + h];
    float m_prev = -INFINITY;
#pragma unroll 1
    for (int j = 0; j < 36; ++j) {
        const bool isctx = j < 4; const int base = isctx ? ML + b * CTXL : b * SEQ, len = isctx ? CTXL : SEQ, off = isctx ? j * 64 : (j - 4) * 64;
        const int row = base + (dir ? len - 1 - (off + lane) : off + lane);
        const float igv = G[(size_t)row * 16 + dir * 8 + h] + bi_; const float fp = G[(size_t)row * 16 + dir * 8 + 4 + h] + bf_;
        float cum = fminf(fp, 0.f) - log1pf(expf(-fabsf(fp)));
#pragma unroll
        for (int d = 1; d < 64; d <<= 1) { const float t = bperm_f((lane - d) & 63, cum); if (lane >= d) cum += t; }
        const float a = igv - cum; float R = a;
#pragma unroll
        for (int d = 1; d < 64; d <<= 1) { const float t = bperm_f((lane - d) & 63, R); if (lane >= d) R = fmaxf(R, t); }
        R = fmaxf(R, m_prev);
        const float mrow = cum + R, m_new = __shfl(mrow, 63), cl = __shfl(cum, 63);
        float* o = GS + j * 320 + lane;
        o[0] = a; o[64] = R; o[128] = expf(m_prev - R); o[192] = expf(-mrow); o[256] = expf(cl + a - m_new);
        if (lane == 0) GD[j] = expf(cl + m_prev - m_new);
        m_prev = m_new;
    }
}


__device__ __forceinline__ void mlstm_unit5(Frame& F, int li, int unit, bool ctx_out) {
    const int vs = unit & 3, dir = (unit >> 2) & 1, h = (unit >> 3) & 3, b = unit >> 5, seq = unit >> 2;
    constexpr int QS = 0, KS = 33792, VS = 67584, SC = 78848, C16 = 88064, VEC = 130304, NVT = 5, VP = 88;
    LAS f16* Qs = (LAS f16*)(F.lds + QS); LAS f16* Ks = (LAS f16*)(F.lds + KS); LAS f16* Vs = (LAS f16*)(F.lds + VS);
    LAS f16* Sc = (LAS f16*)(F.lds + SC); LAS f16* Cs = (LAS f16*)(F.lds + C16);
    LAS float* gv = (LAS float*)(F.lds + VEC);
    LAS float* av = gv; LAS float* Rv = gv + 64; LAS float* interv = gv + 128; LAS float* eneg = gv + 192; LAS f16* w16 = (LAS f16*)(gv + 320); LAS float* misc = gv + 352;
    const f16* P = WSP(f16, WS_P); f16* HMD = WSP(f16, WS_HMD) + (size_t)dir * MT * BW;
    const float* GS = WSP(float, WS_GS) + (size_t)seq * 36 * 320; const float* GD = WSP(float, WS_GS + 3 * 512 * 1024) + seq * 36;
    const int lane = F.lane, wave = F.wave, fr = lane & 15, fq = lane >> 4, tid = F.tid;
    for (int i = tid; i < 80 * 264; i += 512) Cs[i] = (f16)0.f;
    for (int i = tid; i < 64 * 16; i += 512) Vs[(i >> 4) * VP + 64 + (i & 15)] = ((i & 15) == 0) ? (f16)1.f : (f16)0.f;
    f32x4 Cacc[NVT][2];
#pragma unroll
    for (int vt = 0; vt < NVT; ++vt)
#pragma unroll
        for (int nt = 0; nt < 2; ++nt) Cacc[vt][nt] = (f32x4){0.f, 0.f, 0.f, 0.f};
#define MROWJ(j, s) (((j) < 4 ? ML + b * CTXL : b * SEQ) + (dir ? ((j) < 4 ? CTXL : SEQ) - 1 - (((j) < 4 ? (j) * 64 : ((j) - 4) * 64) + (s)) : ((j) < 4 ? (j) * 64 : ((j) - 4) * 64) + (s)))
    f16x8 qreg[4], kreg[4], vreg; float greg = 0.f, dreg = 0.f;
#define ML_PREFETCH(j) do { \
        _Pragma("unroll") for (int it = 0; it < 4; ++it) { const int i_ = it * 512 + tid, s_ = i_ >> 5, c8_ = i_ & 31; const size_t ro_ = (size_t)MROWJ(j, s_) * LDP + h * 256 + c8_ * 8; \
            qreg[it] = *(const f16x8*)(P + ro_ + PQ); kreg[it] = *(const f16x8*)(P + ro_ + PK); } \
        vreg = *(const f16x8*)(P + (size_t)MROWJ(j, tid >> 3) * LDP + PV + h * 256 + vs * 64 + (tid & 7) * 8); \
        if (tid < 320) greg = GS[(j) * 320 + tid]; \
        if (tid == 320) dreg = GD[j]; } while (0)
    ML_PREFETCH(0);
    __syncthreads();
#pragma unroll 1
    for (int j = 0; j < 36; ++j) {
        const bool isctx = j < 4;
#pragma unroll
        for (int it = 0; it < 4; ++it) { const int i = it * 512 + tid, s = i >> 5, c8 = i & 31;
            *(LAS f16x8*)(Qs + s * 264 + c8 * 8) = qreg[it]; *(LAS f16x8*)(Ks + s * 264 + c8 * 8) = kreg[it]; }
        *(LAS f16x8*)(Vs + (tid >> 3) * VP + (tid & 7) * 8) = vreg;
        if (tid < 320) { gv[tid] = greg; if (tid >= 256) w16[tid - 256] = (f16)greg; }
        if (tid == 320) misc[0] = dreg;
        __syncthreads();
        if (j + 1 < 36) ML_PREFETCH(j + 1);
        const bool need_out = !isctx || ctx_out;
        f32x4 nacc[NVT];
        if (need_out) {
            if (wave >= 4) {
                const int i = wave - 4; f32x4 sacc[4];
#pragma unroll
                for (int st = 0; st < 4; ++st) sacc[st] = (f32x4){0.f, 0.f, 0.f, 0.f};
#pragma unroll
                for (int ks = 0; ks < 8; ++ks) { const f16x8 a = *(const LAS f16x8*)(Qs + (16 * i + fr) * 264 + 32 * ks + 8 * fq);
#pragma unroll
                    for (int st = 0; st < 4; ++st) { const f16x8 bq = *(const LAS f16x8*)(Ks + (16 * st + fr) * 264 + 32 * ks + 8 * fq); sacc[st] = mfma16(a, bq, sacc[st]); } }
                const f32x4 Rt = *(const LAS f32x4*)(Rv + 16 * i + 4 * fq);
#pragma unroll
                for (int st = 0; st < 4; ++st) { const int sidx = 16 * st + fr; const float as = av[sidx];
#pragma unroll
                    for (int r = 0; r < 4; ++r) { const int t = 16 * i + 4 * fq + r; const float e = __expf(fminf(as - Rt[r], 0.f)); const float msk = sidx <= t ? 1.f : 0.f;
                        Sc[t * 72 + sidx] = (f16)(sacc[st][r] * msk * e); } }
            } else {
                const int i = wave;
#pragma unroll
                for (int vt = 0; vt < NVT; ++vt) nacc[vt] = (f32x4){0.f, 0.f, 0.f, 0.f};
#pragma unroll
                for (int ks = 0; ks < 8; ++ks) { const f16x8 a = *(const LAS f16x8*)(Qs + (16 * i + fr) * 264 + 32 * ks + 8 * fq);
#pragma unroll
                    for (int vt = 0; vt < NVT; ++vt) { const f16x8 bc = *(const LAS f16x8*)(Cs + (16 * vt + fr) * 264 + 32 * ks + 8 * fq); nacc[vt] = mfma16(a, bc, nacc[vt]); } }
#pragma unroll
                for (int r = 0; r < 4; ++r) { const float sc_ = interv[16 * i + 4 * fq + r];
#pragma unroll
                    for (int vt = 0; vt < NVT; ++vt) nacc[vt][r] *= sc_; }
            }
        }
        __syncthreads();
        f16x8 vf[2][NVT];
#pragma unroll
        for (int k2 = 0; k2 < 2; ++k2)
#pragma unroll
            for (int vt = 0; vt < NVT; ++vt) { const LAS f16* p = Vs + (32 * k2 + 8 * fq + (fr >> 2)) * VP + 16 * vt + 4 * (fr & 3);
                const f16x4 lo = lds_tr4(p), hi = lds_tr4(p + 4 * VP); vf[k2][vt] = __builtin_shufflevector(lo, hi, 0, 1, 2, 3, 4, 5, 6, 7); }
        if (need_out && wave < 4) {
            const int i = wave;
#pragma unroll
            for (int k2 = 0; k2 < 2; ++k2) { const f16x8 a = *(const LAS f16x8*)(Sc + (16 * i + fr) * 72 + 32 * k2 + 8 * fq);
#pragma unroll
                for (int vt = 0; vt < NVT; ++vt) nacc[vt] = mfma16(a, vf[k2][vt], nacc[vt]); }
#pragma unroll
            for (int r = 0; r < 4; ++r) { const int t = 16 * i + 4 * fq + r; const float dn = __shfl(nacc[4][r], lane & 48); const float inv = __builtin_amdgcn_rcpf(fmaxf(fabsf(dn), eneg[t]));
                f16* hp = HMD + (size_t)MROWJ(j, t) * BW + h * 256 + vs * 64 + fr;
                hp[0] = (f16)(nacc[0][r] * inv); hp[16] = (f16)(nacc[1][r] * inv); hp[32] = (f16)(nacc[2][r] * inv); hp[48] = (f16)(nacc[3][r] * inv); }
        }
        { const float decay = misc[0];
#pragma unroll
          for (int vt = 0; vt < NVT; ++vt)
#pragma unroll
              for (int nt = 0; nt < 2; ++nt) Cacc[vt][nt] = Cacc[vt][nt] * decay;
#pragma unroll
          for (int k2 = 0; k2 < 2; ++k2) { const f16x8 wf = *(const LAS f16x8*)(w16 + 32 * k2 + 8 * fq);
#pragma unroll
              for (int nt = 0; nt < 2; ++nt) { const LAS f16* p = Ks + (32 * k2 + 8 * fq + (fr >> 2)) * 264 + 32 * wave + 16 * nt + 4 * (fr & 3);
                  const f16x4 lo = lds_tr4(p), hi = lds_tr4(p + 4 * 264); const f16x8 bk = __builtin_shufflevector(lo, hi, 0, 1, 2, 3, 4, 5, 6, 7);
#pragma unroll
                  for (int vt = 0; vt < NVT; ++vt) Cacc[vt][nt] = mfma16(vf[k2][vt] * wf, bk, Cacc[vt][nt]); } }
#pragma unroll
          for (int vt = 0; vt < NVT; ++vt)
#pragma unroll
              for (int nt = 0; nt < 2; ++nt)
#pragma unroll
                  for (int r = 0; r < 4; ++r) Cs[(16 * vt + 4 * fq + r) * 264 + 32 * wave + 16 * nt + fr] = (f16)Cacc[vt][nt][r]; }
        __syncthreads();
    }
#undef MROWJ
#undef ML_PREFETCH
}

__device__ __forceinline__ void phase_finish(int li_v) {
    Frame F = make_frame(); const int li = UNI(li_v); const int M = li == DEPTH - 1 ? ML : MT;
    const int gw = F.bid * 8 + F.wave, NGW = F.G * 8;
    const f16* P = WSP(f16, WS_P); const f16* HMD = WSP(f16, WS_HMD); const float* HL = WSP(float, WS_PART); f16* Y = WSP(f16, WS_Y);
    const float* gn = inp(16) + (size_t)li * BW;
    for (int row = gw; row < M; row += NGW) {
#pragma unroll
        for (int hh = 0; hh < 4; ++hh) { const int c = hh * 256 + 4 * F.lane;
            const f16x4 a = *(const f16x4*)(HMD + (size_t)row * BW + c), bq = *(const f16x4*)(HMD + ((size_t)MT + row) * BW + c);
            const f32x4 s = (f32x4){(float)a[0] + (float)bq[0], (float)a[1] + (float)bq[1], (float)a[2] + (float)bq[2], (float)a[3] + (float)bq[3]}; const float ss = wave_sum((s.x * s.x + s.y * s.y) + (s.z * s.z + s.w * s.w), F.lane);
            const float rstd = rsqrtf(ss * (1.0f / 256.0f) + EPS);
            const f16x4 og = *(const f16x4*)(P + (size_t)row * LDP + PO + c); const f32x4 g = *(const f32x4*)(gn + c);
            u32x2 w; w.x = pk_f16((float)og[0] * s.x * rstd * g.x, (float)og[1] * s.y * rstd * g.y); w.y = pk_f16((float)og[2] * s.z * rstd * g.z, (float)og[3] * s.w * rstd * g.w);
            *(u32x2*)(Y + (size_t)row * BW + c) = w; }
    }
}

constexpr int REP_MIX = 1, REP_L1 = 1, REP_NA = 1, REP_ML = 1; constexpr int REP_GATE = 1, REP_RES = 1, REP_BAR = 0; constexpr int REP_PRO = 1, REP_G1 = 1, REP_G3 = 1, REP_ADALN = 1, REP_LRU0 = 1, REP_FIN = 1;
constexpr int NPL = 13, PH_FINAL = 1 + DEPTH * NPL, NPHASE = PH_FINAL + 1;
__device__ __forceinline__ void ph_gemm_swiglu(int li_v, int which_v) {
    Frame F = make_frame(); const int li = UNI(li_v), which = UNI(which_v);
    unsigned char* wl = F.ws + WS_W + (size_t)li * WL_SIZE; const int M = (which == 1 && li == DEPTH - 1) ? ML : MT;
    pg8::Gemm g{WSP(f16, WS_H), (const f16*)(wl + (which ? WL_W3 : WL_W1)), M, 2 * DFF, D, D}; pg8::StaticOrder S; S.init(M, 2 * DFF, F.G, F.bid);
    EpiSwiGLU E{WSP(f16, WS_P)}; pg8::gemm_phase<EpiSwiGLU, pg8::StaticOrder, true, true>(F.lds, g, S, E, F.tid);
}
__device__ __forceinline__ void ph_gemm_resid(int li_v, int which_v, float cmul = 1.0f) {
    Frame F = make_frame(); const int li = UNI(li_v), which = UNI(which_v);
    unsigned char* wl = F.ws + WS_W + (size_t)li * WL_SIZE;
    const float* modl = WSP(float, WS_MOD) + (size_t)li * 5 * NMODC + (2 + 3 * which) * D;
    const f16* A = which == 1 ? WSP(f16, WS_MH) : WSP(f16, WS_P); const f16* Bt = (const f16*)(wl + (which == 0 ? WL_W2 : which == 1 ? WL_WOUT : WL_W4));
    const int K = which == 1 ? D : DFF;
    pg8::Gemm g{A, Bt, ML, D, K, K}; pg8::StaticOrder S; S.init(ML, D, F.G, F.bid);
    const bool first = li == 0 && which == 0;
    EpiResid E{WSP(f16, WS_X), modl, which == 1 ? 0 : 1, first ? inp(0) : nullptr}; pg8::gemm_phase<EpiResid, pg8::StaticOrder, true, true>(F.lds, g, S, E, F.tid);
}
__device__ __forceinline__ void ph_gemm_resid_ctx(int li_v, int which_v) {
    Frame F = make_frame(); const int li = UNI(li_v), which = UNI(which_v);
    if (which >= 1 && li == DEPTH - 1) return;
    unsigned char* wl = F.ws + WS_W + (size_t)li * WL_SIZE;
    const float* modl = WSP(float, WS_MOD) + (size_t)li * 5 * NMODC + (2 + 3 * which) * D;
    const f16* A = which == 1 ? WSP(f16, WS_MH) : WSP(f16, WS_P); const f16* Bt = (const f16*)(wl + (which == 0 ? WL_W2 : which == 1 ? WL_WOUT : WL_W4));
    const int K = which == 1 ? D : DFF;
    pg8::Gemm g{A, Bt, MT, D, K / 4, K}; pg8::CtxSplitOrder S{F.bid, F.G};
    EpiResidPart E{WSP(float, WS_PART), modl, which == 1 ? 1.0f : 0.5f}; pg8::gemm_phase<EpiResidPart, pg8::CtxSplitOrder, false, true>(F.lds, g, S, E, F.tid);
}
__device__ __forceinline__ void ph_gemm_proj(int li_v) {
    Frame F = make_frame(); const int li = UNI(li_v);
    unsigned char* wl = F.ws + WS_W + (size_t)li * WL_SIZE;
    pg8::Gemm g{WSP(f16, WS_H), (const f16*)(wl + WL_WIN), MT, NPIN, D, D};
    EpiProj E{WSP(f16, WS_P), WSP(float, WS_G), WSP(float, WS_ROPE)};
    if (li == DEPTH - 1) { pg8::ProjLastOrder S{F.G, F.bid}; pg8::gemm_phase<EpiProj, pg8::ProjLastOrder, true, true>(F.lds, g, S, E, F.tid); }
    else { pg8::StaticOrder S; S.init(MT, NPIN, F.G, F.bid); pg8::gemm_phase<EpiProj, pg8::StaticOrder, true, true>(F.lds, g, S, E, F.tid); }
}
template <int MODE, int BR> __device__ __forceinline__ void ph_gemm_gate(int li_v) {
    Frame F = make_frame(); const int li = UNI(li_v);
    unsigned char* wl = F.ws + WS_W + (size_t)li * WL_SIZE; const int M = li == DEPTH - 1 ? ML : MT;
    const f16* Y = WSP(f16, WS_Y) + (size_t)BR * MT * BW; const f16* wbr = (const f16*)(wl + WL_WBR) + (size_t)BR * D * BW; const f16* gate = WSP(f16, WS_P) + GX + BR * D;
    pg8::Gemm g{Y, wbr, M, D, BW, BW}; pg8::StaticOrder S; S.init(M, D, F.G, F.bid);
    EpiGate<MODE> E{gate, WSP(f16, WS_MH)}; pg8::gemm_phase<EpiGate<MODE>, pg8::StaticOrder, true, true>(F.lds, g, S, E, F.tid);
}
__device__ __forceinline__ void phase_lru_p0(int li_v) {
    Frame F = make_frame(); const int li = UNI(li_v);
    if (F.G >= 64) {
        if (F.bid < 4) mlstm_gate_scan(F, li, F.bid * 8 + F.wave);
        else if (F.bid >= 8) { F.bid -= 8; F.G -= 8; lru_block<0>(F, li, false); }
    } else { if (F.bid * 8 + F.wave < 32) mlstm_gate_scan(F, li, F.bid * 8 + F.wave); __syncthreads(); lru_block<0>(F, li, false); }
}
#ifndef MIXSEL
#define MIXSEL 7
#endif
__device__ __forceinline__ void ph_mix_mlstm(int li_v) {
    Frame F = make_frame(); const int li = UNI(li_v); const bool last = li == DEPTH - 1; const int half = F.G >> 1;
    if (F.bid >= half) return;
    for (int rep = 0; rep < REP_ML; ++rep) for (int u = F.bid; u < 128; u += half) { mlstm_unit5(F, li, u, !last); __syncthreads(); }
}
__device__ __forceinline__ void ph_mix_na(int li_v) {
    Frame F = make_frame(); const int li = UNI(li_v); const bool last = li == DEPTH - 1; const int half = F.G >> 1;
    if (F.bid < half) return;
    F.bid -= half; F.G -= half;
    int staged_hp = -1;
    for (int rep = 0; rep < REP_NA; ++rep) { const int nna = last ? 512 : 576;
      for (int it = F.bid; it < nna; it += F.G) { const bool lat = it < 512; const int x = lat ? it : it - 512;
          const int hp = x & 3, rr = lat ? (x >> 2) & 31 : (x >> 2) & 3, b = lat ? x >> 7 : x >> 4;
          na_item(F, li, lat, b, rr, hp, staged_hp); }
      __syncthreads(); }
}
__device__ __forceinline__ void ph_mix_lru(int li_v) {
    Frame F = make_frame(); const int li = UNI(li_v); const bool last = li == DEPTH - 1; const int half = F.G >> 1;
    const int total = last ? 4 * 32 * 8 : 4 * 36 * 8, nu = total;
    if (F.bid < half) { F.G = half; for (int rep = 0; rep < REP_L1; ++rep) lru_fix_block(F, li, last, nu, total); }
    else { F.bid -= half; F.G -= half; for (int rep = 0; rep < REP_L1; ++rep) lru_fix_block(F, li, last, 0, nu); }
}
__device__ __forceinline__ void ph_mixers(int li_v) { ph_mix_mlstm(li_v); __syncthreads(); ph_mix_na(li_v); __syncthreads(); ph_mix_lru(li_v); }

__global__ void __launch_bounds__(512, 2) mega_fwd(Args args) {
    LAS unsigned char* lds = (LAS unsigned char*)lds_raw;
    const int tid = threadIdx.x;
    volatile LAS unsigned* MISC = (volatile LAS unsigned*)(lds + LDS_MISC);
    if (tid < 64) MISC[tid] = 0u;
    __syncthreads();
    unsigned* barw = (unsigned*)(args.ws + WS_CTL) + 4096;
    XcdBarrier bar; bar.bar = barw; bar.x = 0; bar.st = nullptr;
    const int lo = args.ph_lo, hi = args.ph_hi;
    if (hi - lo > 1) bar = xcd_barrier_post(barw, MISC + 8);
#define IN(k) (lo <= (k) && (k) < hi && ((PHSEL >> ((k) == 0 ? 16 : (k) == PH_FINAL ? 17 : ((k) - 1) % NPL)) & 1))
#if TPROBE
    volatile LAS unsigned long long* TACC = (volatile LAS unsigned long long*)(lds + LDS_MISC + 128);
    const bool tprobe = blockIdx.x == 0 && tid == 0;
    if (tprobe) { TACC[0] = 0ull; TACC[1] = 0ull; }
#define TBEG() do { if (tprobe) TACC[2] = __builtin_amdgcn_s_memrealtime(); } while (0)
#define TEND(g) do { if (tprobe) TACC[g] = TACC[g] + (__builtin_amdgcn_s_memrealtime() - TACC[2]); } while (0)
#else
#define TBEG() do {} while (0)
#define TEND(g) do {} while (0)
#endif
#define SEAM(k) do { if (lo <= (k) && (k) + 1 < hi) { TBEG(); xcd_barrier(bar); TEND(1); } } while (0)
    if (IN(0)) for (int rep = 0; rep < REP_PRO; ++rep) { phase_prologue(); __syncthreads(); }
    SEAM(0);
#pragma unroll 1
    for (int li = 0; li < DEPTH; ++li) {
        const int p0 = 1 + li * NPL;
        if (IN(p0 + 0)) phase_adaln(li, 0);
        SEAM(p0 + 0); for (int rep = 0; rep < REP_BAR; ++rep) SEAM(p0 + 0);
        TBEG();
        if (IN(p0 + 1)) { ph_gemm_swiglu(li, 0); __syncthreads(); ph_convert_idle(36 * 44, 6, li == 0 ? CS1 : CT1); }
        if (IN(p0 + 1)) TEND(0);
        SEAM(p0 + 1);
        TBEG();
        if (IN(p0 + 2)) { ph_gemm_resid(li, 0); ph_gemm_resid_ctx(li, 0); __syncthreads(); ph_convert_idle(128, 3, li == 0 ? CS2 : CT2); }
        if (IN(p0 + 2)) TEND(0);
        SEAM(p0 + 2);
        if (IN(p0 + 3)) phase_adaln(li, 1);
        SEAM(p0 + 3);
        TBEG();
        if (IN(p0 + 4)) { ph_gemm_proj(li); __syncthreads(); if (li == 0) ph_convert_idle(36 * 61, 6, CS3); }
        if (IN(p0 + 4)) TEND(0);
        SEAM(p0 + 4);
        if (IN(p0 + 5)) for (int rep = 0; rep < REP_LRU0; ++rep) { phase_lru_p0(li); __syncthreads(); }
        SEAM(p0 + 5);
        if (IN(p0 + 6)) for (int rep = 0; rep < REP_MIX; ++rep) { ph_mixers(li); __syncthreads(); }
        SEAM(p0 + 6);
        TBEG();
        if (IN(p0 + 7)) { phase_finish(li); __syncthreads(); ph_gemm_gate<0, 1>(li); ph_gemm_gate<1, 2>(li); __syncthreads(); if (li == 0) ph_convert_idle(288, 6, CS4); }
        if (IN(p0 + 7)) TEND(0);
        SEAM(p0 + 7);
        TBEG();
        if (IN(p0 + 8)) { ph_gemm_gate<2, 0>(li); __syncthreads(); if (li == 0) ph_convert_idle(288, 3, CS5); }
        if (IN(p0 + 8)) TEND(0);
        SEAM(p0 + 8);
        TBEG();
        if (IN(p0 + 9)) { ph_gemm_resid(li, 1); ph_gemm_resid_ctx(li, 1); __syncthreads(); if (li == 0) ph_convert_idle(128, 3, CS6); }
        if (IN(p0 + 9)) TEND(0);
        SEAM(p0 + 9);
        if (IN(p0 + 10)) { phase_adaln(li, 2); if (li == DEPTH - 1) { __syncthreads(); ph_convert_all(CT3, CO_W3END); } }
        SEAM(p0 + 10);
        TBEG();
        if (IN(p0 + 11)) { ph_gemm_swiglu(li, 1); __syncthreads(); if (li == 0) ph_convert_idle(36 * 44, 6, CS7); else ph_convert_idle(32 * 44, 6, CO_W3END); }
        if (IN(p0 + 11)) TEND(0);
        SEAM(p0 + 11);
        TBEG();
        if (IN(p0 + 12)) { ph_gemm_resid(li, 2); ph_gemm_resid_ctx(li, 2); __syncthreads(); if (li == 0) ph_convert_idle(128, 3, CS8); }
        if (IN(p0 + 12)) TEND(0);
        SEAM(p0 + 12);
    }
#if TPROBE
    if (tprobe) { float* tp = (float*)(args.ws + WS_CTL) + 2048; tp[0] = (float)TACC[0] * 1e-8f; tp[1] = (float)TACC[1] * 1e-8f; __builtin_amdgcn_fence(__ATOMIC_RELEASE, "agent"); }
    __syncthreads(); xcd_barrier(bar);
#endif
    if (IN(PH_FINAL)) phase_final();
#undef IN
#undef SEAM
}

extern "C" void kernel_launch(void* const* d_in, const int* in_sizes, int n_in, void* d_out, int out_size, void* d_ws, size_t ws_size, hipStream_t stream) {
    static int grid = 0;
    if (grid == 0) {
        if (n_in != 28 || ws_size < WS_END) { fprintf(stderr, "kernel_launch: unexpected n_in %d or ws_size %zu (< %zu)\n", n_in, ws_size, (size_t)WS_END); grid = -1; return; }
        int dev = 0, cus = 0, per_cu = 0;
        if (hipGetDevice(&dev) != hipSuccess || hipDeviceGetAttribute(&cus, hipDeviceAttributeMultiprocessorCount, dev) != hipSuccess) { grid = -1; return; }
        if (hipFuncSetAttribute((const void*)mega_fwd, hipFuncAttributeMaxDynamicSharedMemorySize, LDS_BYTES) != hipSuccess) { fprintf(stderr, "kernel_launch: hipFuncSetAttribute failed\n"); grid = -1; return; }
        if (hipOccupancyMaxActiveBlocksPerMultiprocessor(&per_cu, (const void*)mega_fwd, 512, LDS_BYTES) != hipSuccess || per_cu < 1) fprintf(stderr, "kernel_launch: occupancy query says %d\n", per_cu);
        (void)hipGetLastError();
        grid = cus;
    }
    if (grid < 0) return;
    (void)hipMemsetAsync((char*)d_ws + WS_CTL + 16384, 0, 16384, stream);
    Args a{};
    for (int i = 0; i < 28; ++i) a.in[i] = (const float*)d_in[i];
    a.out = (float*)d_out; a.ws = (unsigned char*)d_ws;
#if MK_ONE_LAUNCH
    a.ph_lo = 0; a.ph_hi = NPHASE;
    hipLaunchKernelGGL(mega_fwd, dim3(grid), dim3(512), LDS_BYTES, stream, a);
#else
    for (int p = 0; p < NPHASE; ++p) { a.ph_lo = p; a.ph_hi = p + 1; hipLaunchKernelGGL(mega_fwd, dim3(grid), dim3(512), LDS_BYTES, stream, a); }
#endif
}
```

```cpp
#include <hip/hip_runtime.h>
#include <cstdio>
#include <cstdint>

#define LAS __attribute__((address_space(3)))
typedef _Float16 f16;
typedef _Float16 f16x8 __attribute__((ext_vector_type(8)));
typedef _Float16 f16x4 __attribute__((ext_vector_type(4)));
typedef _Float16 f16x2 __attribute__((ext_vector_type(2)));
typedef float f32x4 __attribute__((ext_vector_type(4)));
typedef float f32x2 __attribute__((ext_vector_type(2)));
typedef unsigned u32x4 __attribute__((ext_vector_type(4)));
typedef unsigned u32x2 __attribute__((ext_vector_type(2)));

#ifndef PHSEL
#define PHSEL 0xFFFFF
#endif
#ifndef TPROBE
#define TPROBE 0
#endif
#ifndef MK_ONE_LAUNCH
#define MK_ONE_LAUNCH 1
#endif

constexpr int D = 2048, NB = 4, SEQ = 2048, CTXL = 256, DEPTH = 2, DFF = 5632, BW = 1024;
constexpr int ML = NB * SEQ, MC = NB * CTXL, MT = ML + MC;
constexpr int NMODC = 9 * D;
constexpr int PIN_SRC = 15376;
constexpr int NPIN = 15616;
constexpr int LDP = 15360;
constexpr int PQ = 0, PK = 1024, PV = 2048, PO = 3072, NQ = 4096, NK = 5120, NV = 6144, LX = 7168, LG = 8192, GX = 9216;
constexpr float EPS = 1e-6f;

constexpr size_t MiB = 1u << 20;
constexpr size_t WS_CTL = 0;
constexpr size_t WS_MOD = 1 * MiB;
constexpr size_t WS_ROPE = 2 * MiB;
constexpr size_t WS_G = 3 * MiB;
constexpr size_t WS_W = 4 * MiB;
constexpr size_t WL_W1 = 0, WL_W2 = 44 * MiB, WL_W3 = 66 * MiB, WL_W4 = 110 * MiB, WL_WIN = 132 * MiB, WL_WBR = 193 * MiB, WL_WOUT = 205 * MiB, WL_SIZE = 213 * MiB;
constexpr size_t WS_X = WS_W + 2 * WL_SIZE;
constexpr size_t WS_H = WS_X + 72 * MiB;
constexpr size_t WS_P = WS_H + 36 * MiB;
constexpr size_t WS_Y = WS_P + 270 * MiB;
constexpr size_t WS_HMD = WS_Y + 54 * MiB;
constexpr size_t WS_MH = WS_HMD + 72 * MiB;
constexpr size_t WS_PART = WS_MH + 36 * MiB;
constexpr size_t WS_WLRU = WS_PART + 32 * MiB;
constexpr size_t WS_LSUM = WS_WLRU + 2 * MiB;
constexpr size_t WS_GS = WS_LSUM + 3 * MiB;
constexpr size_t WS_LH = WS_GS + 2 * MiB;
constexpr size_t WS_LAC = WS_LH + 36 * MiB;
constexpr size_t WS_END = WS_LAC + 36 * MiB;

constexpr int LDS_BYTES = 147456;
constexpr int LDS_MISC = 147200;

__device__ __forceinline__ unsigned pk_f16(float lo, float hi) { f32x2 v = {lo, hi}; f16x2 h = __builtin_convertvector(v, f16x2); return __builtin_bit_cast(unsigned, h); }
__device__ __forceinline__ float bperm_f(int srclane, float v) { return __builtin_bit_cast(float, __builtin_amdgcn_ds_bpermute(srclane << 2, __builtin_bit_cast(int, v))); }
template <int CTRL> __device__ __forceinline__ float dpp_f(float v) { return __builtin_bit_cast(float, __builtin_amdgcn_update_dpp(0, __builtin_bit_cast(int, v), CTRL, 0xF, 0xF, true)); }
__device__ __forceinline__ float wave_sum(float v, int lane) {
    v += dpp_f<0xB1>(v); v += dpp_f<0x4E>(v); v += dpp_f<0x141>(v); v += dpp_f<0x140>(v);
    v += bperm_f(lane ^ 16, v); v += bperm_f(lane ^ 32, v);
    return v;
}
__device__ __forceinline__ float sigmoidf_(float x) { return __builtin_amdgcn_rcpf(1.0f + __expf(-x)); }
__device__ __forceinline__ float siluf_(float x) { return x * __builtin_amdgcn_rcpf(1.0f + __expf(-x)); }
__device__ __forceinline__ float gelu_tanh_(float x) { const float z = 0.7978845608028654f * (x + 0.044715f * x * x * x); const float e = __expf(2.0f * z); return 0.5f * x * (1.0f + (1.0f - 2.0f * __builtin_amdgcn_rcpf(e + 1.0f))); }
#define LDS_WAIT() asm volatile("s_waitcnt lgkmcnt(0)" ::: "memory")
__device__ __forceinline__ f32x4 mfma16(f16x8 a, f16x8 b, f32x4 c) { return __builtin_amdgcn_mfma_f32_16x16x32_f16(a, b, c, 0, 0, 0); }

typedef __fp16 fp16x4v __attribute__((__vector_size__(8)));
__device__ __forceinline__ f16x4 lds_tr4(const LAS f16* p) { return __builtin_bit_cast(f16x4, __builtin_amdgcn_ds_read_tr16_b64_v4f16((LAS fp16x4v*)p)); }

#define XB_TMO      128
#define XB_XCNT(j)  (256  + 64 * (j))
#define XB_XSUB(j)  (1280 + 64 * (j))
#define XB_XGEN(j)  (2304 + 64 * (j))
#define XB_TOP      3328
#define XB_TOPGEN   3392
#define XCD_BAR_WORDS 3456
#define XB_SPIN_CAP (1u << 25)
__device__ __forceinline__ unsigned xb_ld(unsigned* p)              { return __hip_atomic_load(p, __ATOMIC_RELAXED, __HIP_MEMORY_SCOPE_AGENT); }
__device__ __forceinline__ unsigned xb_add(unsigned* p, unsigned v) { return __hip_atomic_fetch_add(p, v, __ATOMIC_RELAXED, __HIP_MEMORY_SCOPE_AGENT); }
__device__ __forceinline__ unsigned xb_xcc_id() { return (unsigned)__builtin_amdgcn_s_getreg((3 << 11) | 20) & 0xFu; }
#define XB_SPIN(cond, bar) do { unsigned _sp = 0; while (cond) { __builtin_amdgcn_s_sleep(1); \
    if ((++_sp & 255u) == 0u) { if (xb_ld(&(bar)[XB_TMO])) break; if (_sp > XB_SPIN_CAP) { atomicAdd(&(bar)[XB_TMO], 1u); break; } } } } while (0)
struct XcdBarrier { unsigned* bar; unsigned x; volatile LAS unsigned* st; };
__device__ __forceinline__ XcdBarrier xcd_barrier_post(unsigned* bar, volatile LAS unsigned* st) {
    XcdBarrier b; b.bar = bar; b.x = xb_xcc_id(); b.st = st;
    if (threadIdx.x == 0) (void)xb_add(&bar[XB_XCNT(b.x)], 1u);
    return b;
}
__device__ __forceinline__ void xcd_barrier_complete(unsigned* bar, unsigned x, unsigned& nloc, unsigned& nx) {
    const unsigned G = gridDim.x * gridDim.y * gridDim.z;
    unsigned sum, cnt, mine, sp = 0u;
    for (;;) {
        sum = 0u; cnt = 0u; mine = 0u;
#pragma unroll
        for (unsigned j = 0; j < 16; ++j) { const unsigned c = xb_ld(&bar[XB_XCNT(j)]); sum += c; cnt += (c > 0u) ? 1u : 0u; mine = (j == x) ? c : mine; }
        if (sum == G) break;
        __builtin_amdgcn_s_sleep(1);
        if ((++sp & 255u) == 0u) { if (xb_ld(&bar[XB_TMO])) break; if (sp > XB_SPIN_CAP) { atomicAdd(&bar[XB_TMO], 1u); break; } }
    }
    nloc = mine > 0u ? mine : 1u; nx = cnt > 0u ? cnt : 1u;
}
__device__ __forceinline__ void xcd_barrier(const XcdBarrier& b) {
    asm volatile("s_waitcnt vmcnt(0)" ::: "memory");
    __syncthreads();
    if (threadIdx.x == 0) {
        unsigned* bar = b.bar;
        __builtin_amdgcn_s_waitcnt(0);
        unsigned nloc = b.st[0], nx = b.st[1];
        if (nloc == 0u) { xcd_barrier_complete(bar, b.x, nloc, nx); b.st[0] = nloc; b.st[1] = nx; }
        const unsigned old = xb_add(&bar[XB_XSUB(b.x)], 1u);
        const unsigned gen = old / nloc;
        if (old + 1u == (gen + 1u) * nloc) {
            __builtin_amdgcn_fence(__ATOMIC_RELEASE, "agent");
            asm volatile("s_waitcnt vmcnt(0)" ::: "memory");
            const unsigned og = xb_add(&bar[XB_TOP], 1u);
            const unsigned tg = og / nx;
            if (og + 1u == (tg + 1u) * nx) xb_add(&bar[XB_TOPGEN], 1u);
            else XB_SPIN(xb_ld(&bar[XB_TOPGEN]) == tg, bar);
            __builtin_amdgcn_fence(__ATOMIC_ACQUIRE, "agent");
            xb_add(&bar[XB_XGEN(b.x)], 1u);
            asm volatile("s_waitcnt vmcnt(0)" ::: "memory");
        } else {
            XB_SPIN(xb_ld(&bar[XB_XGEN(b.x)]) == gen, bar);
            __builtin_amdgcn_fence(__ATOMIC_ACQUIRE, "agent");
            asm volatile("s_waitcnt vmcnt(0)" ::: "memory");
        }
    }
    __syncthreads();
}

namespace pg8 {
constexpr int BM = 256, BK = 64, HALF = 128, HTB = HALF * BK * 2, STAGE_BYTES = 8 * HTB, NXCD = 8, WGM = 4;
__host__ __device__ __forceinline__ int lds_byte(int r, int c) { const int st = (r >> 4) * 2 + (c >> 5), rr = r & 15, cc = c & 31, ob = rr * 64 + cc * 2; return st * 1024 + (ob ^ (((ob >> 9) & 1) << 5)); }
__host__ __device__ __forceinline__ void stage_rc(int b, int& R, int& C) { const int st = b / 1024, sb = b % 1024, swz = sb ^ (((sb >> 9) & 1) << 5); R = (st >> 1) * 16 + swz / 64; C = (st & 1) * 32 + (swz % 64) / 2; }
__host__ __device__ __forceinline__ int perm32(int rho) { const int n = rho >> 4, i = rho & 15; return 8 * (i >> 2) + 4 * n + (i & 3); }
struct Unit { int pm, pn, kp; };
struct Gemm { const f16* A; const f16* Bt; int M, N, K, ld; };
struct StaticOrder {
    int nM, nN, nwg, G, c;
    __host__ __device__ void init(int M, int N, int G_, int c_) { nM = M / BM; nN = N / BM; nwg = nM * nN; G = G_; c = c_; }
    __host__ __device__ bool next(int i, Unit& u) const {
        const long L = (long)i * G + c; if (L >= nwg) return false;
        int wgid = (int)L; { const int q = nwg / NXCD, r = nwg % NXCD, xcd = wgid % NXCD, off = wgid / NXCD; wgid = (xcd < r ? xcd * (q + 1) : r * (q + 1) + (xcd - r) * q) + off; }
        const int nig = WGM * nN, gid = wgid / nig, fm = gid * WGM, gsz = (nM - fm) < WGM ? (nM - fm) : WGM;
        u.pm = fm + ((wgid % nig) % gsz); u.pn = (wgid % nig) / gsz; u.kp = 0; return true;
    }
    __device__ __forceinline__ void a_ready(const Unit&) const {}
    __device__ __forceinline__ void done(const Unit&) const {}
};
struct ProjLastOrder {
    int G, c;
    __device__ bool next(int i, Unit& u) const {
        const int L = i * G + c; u.kp = 0;
        if (L < 32 * 61) { const int w = (L % NXCD) * (32 * 61 / NXCD) + L / NXCD;
            const int grp = w / (WGM * 61), rem = w % (WGM * 61); u.pm = grp * WGM + rem % WGM; u.pn = rem / WGM; return true; }
        const int x = L - 32 * 61; if (x >= 4 * 21) return false;
        u.pm = 32 + (x & 3); const int t = x >> 2; u.pn = t < 8 ? 4 + t : (t < 20 ? 20 + (t - 8) : 60); return true;
    }
    __device__ __forceinline__ void a_ready(const Unit&) const {}
    __device__ __forceinline__ void done(const Unit&) const {}
};
struct CtxSplitOrder {
    int c, G;
    __device__ bool next(int i, Unit& u) const { const int L = i * G + c; if (L >= 128) return false; u.kp = L & 3; const int t = L >> 2; u.pm = 32 + (t >> 3); u.pn = t & 7; return true; }
    __device__ __forceinline__ void a_ready(const Unit&) const {}
    __device__ __forceinline__ void done(const Unit&) const {}
};
template <class Epi, class Sched, bool ALIGN_EPI = false, bool SP2 = false>
__device__ __forceinline__ void gemm_phase(LAS unsigned char* lds, const Gemm g, const Sched& S, const Epi& E, const int tid) {
    const int wid = __builtin_amdgcn_readfirstlane(tid >> 6), lane = tid & 63, wr = wid >> 2, wc = wid & 3, fr = lane & 15, fq = lane >> 4;
    const int K = g.K, nt = K / BK;
    unsigned voffA[2], voffB[2];
#pragma unroll
    for (int i = 0; i < 2; ++i) { int R, C; stage_rc(tid * 16 + i * 8192, R, C); const int Rb = Epi::PERM ? ((R & ~31) + perm32(R & 31)) : R;
        voffA[i] = (unsigned)(R * g.ld + C) * 2u; voffB[i] = (unsigned)(Rb * g.ld + C) * 2u; }
    const __amdgpu_buffer_rsrc_t rsA = __builtin_amdgcn_make_buffer_rsrc((void*)g.A, 0, 0x7ffff000, 0x00020000), rsB = __builtin_amdgcn_make_buffer_rsrc((void*)g.Bt, 0, 0x7ffff000, 0x00020000);
    const size_t kstep = (size_t)(BK * 2);
    const size_t hstep = (size_t)HALF * g.ld * 2;
    const size_t tstep = 2 * hstep;
    const unsigned ldsw = (unsigned)wid * 1024u;
    const int aoff = lds_byte(wr * 64 + fr, fq * 8), boff = lds_byte(wc * 32 + fr, fq * 8);
#define PG8_SA(b, h) (((b) * 2 + (h)) * HTB)
#define PG8_SB(b, h) ((4 + (b) * 2 + (h)) * HTB)
#define PG8_STAGE(bufoff, gbase, voff, rs, base0) do { const unsigned so_ = (unsigned)((const char*)(gbase) - (const char*)(base0)); _Pragma("unroll") for (int _i = 0; _i < 2; ++_i) \
        __builtin_amdgcn_raw_ptr_buffer_load_lds(rs, (LAS void*)(lds + (bufoff) + ldsw + _i * 8192), 16, (voff)[_i], so_, 0, 0); } while (0)
#define PG8_LDA(dst, b, h) do { _Pragma("unroll") for (int m = 0; m < 4; ++m) _Pragma("unroll") for (int k = 0; k < 2; ++k) dst[m][k] = *(const LAS f16x8*)(lds + PG8_SA(b, h) + aoff + m * 2048 + k * 1024); } while (0)
#define PG8_LDB(dst, b, h) do { _Pragma("unroll") for (int n = 0; n < 2; ++n) _Pragma("unroll") for (int k = 0; k < 2; ++k) dst[n][k] = *(const LAS f16x8*)(lds + PG8_SB(b, h) + boff + n * 2048 + k * 1024); } while (0)
#define PG8_MMA(ai, bj, At, Bt) do { __builtin_amdgcn_s_setprio(1); _Pragma("unroll") for (int m = 0; m < 4; ++m) _Pragma("unroll") for (int n = 0; n < 2; ++n) _Pragma("unroll") for (int k = 0; k < 2; ++k) \
        acc[ai][bj][m][n] = __builtin_amdgcn_mfma_f32_16x16x32_f16(Bt[n][k], At[m][k], acc[ai][bj][m][n], 0, 0, 0); __builtin_amdgcn_s_setprio(0); } while (0)
#define PG8_WAIT_V(n) asm volatile("s_waitcnt vmcnt(" #n ")" ::: "memory")
#define PG8_WAIT_L(n) asm volatile("s_waitcnt lgkmcnt(" #n ")" ::: "memory")
#define PG8_BAR __builtin_amdgcn_s_barrier()
#define PG8_SCHED __builtin_amdgcn_sched_barrier(0)
    Unit cur, nxt; int ui = 0;
    if (!S.next(0, cur)) return;
    f32x4 acc[2][2][4][2];
#pragma unroll
    for (int a = 0; a < 2; ++a)
#pragma unroll
        for (int b = 0; b < 2; ++b)
#pragma unroll
            for (int m = 0; m < 4; ++m)
#pragma unroll
                for (int n = 0; n < 2; ++n) acc[a][b][m][n] = (f32x4){0.f, 0.f, 0.f, 0.f};
    f16x8 At[4][2], B0[2][2], B1[2][2];
    const char* cA = (const char*)g.A + (size_t)cur.pm * tstep + (size_t)cur.kp * K * 2; const char* cB = (const char*)g.Bt + (size_t)cur.pn * tstep + (size_t)cur.kp * K * 2;
    S.a_ready(cur);
    if constexpr (SP2) {
        PG8_STAGE(PG8_SB(0, 0), cB, voffB, rsB, g.Bt); PG8_STAGE(PG8_SB(0, 1), cB + hstep, voffB, rsB, g.Bt); PG8_STAGE(PG8_SA(0, 0), cA, voffA, rsA, g.A); PG8_STAGE(PG8_SA(0, 1), cA + hstep, voffA, rsA, g.A);
        if (wr == 1) PG8_BAR;
        PG8_WAIT_V(2); PG8_BAR;
        PG8_STAGE(PG8_SB(1, 0), cB + kstep, voffB, rsB, g.Bt); PG8_STAGE(PG8_SA(1, 0), cA + kstep, voffA, rsA, g.A); PG8_STAGE(PG8_SB(1, 1), cB + hstep + kstep, voffB, rsB, g.Bt);
        PG8_WAIT_V(6); PG8_BAR;
    } else {
        PG8_STAGE(PG8_SB(0, 0), cB, voffB, rsB, g.Bt); PG8_STAGE(PG8_SA(0, 0), cA, voffA, rsA, g.A); PG8_STAGE(PG8_SB(0, 1), cB + hstep, voffB, rsB, g.Bt); PG8_STAGE(PG8_SA(0, 1), cA + hstep, voffA, rsA, g.A);
        if (wr == 1) PG8_BAR;
        PG8_WAIT_V(4); PG8_BAR;
        PG8_STAGE(PG8_SB(1, 0), cB + kstep, voffB, rsB, g.Bt); PG8_STAGE(PG8_SA(1, 0), cA + kstep, voffA, rsA, g.A); PG8_STAGE(PG8_SB(1, 1), cB + hstep + kstep, voffB, rsB, g.Bt);
        PG8_WAIT_V(6); PG8_BAR;
    }
    for (;;) {
        const bool has_next = S.next(ui + 1, nxt);
        const char* nA = has_next ? (const char*)g.A + (size_t)nxt.pm * tstep + (size_t)nxt.kp * K * 2 : cA; const char* nB = has_next ? (const char*)g.Bt + (size_t)nxt.pn * tstep + (size_t)nxt.kp * K * 2 : cB;
        for (int t = 0; t < nt; t += 2) {
            const bool last = (t == nt - 2);
            const char* a1 = cA + (size_t)(t + 1) * kstep;
            const char* a2 = last ? nA : cA + (size_t)(t + 2) * kstep; const char* b2 = last ? nB : cB + (size_t)(t + 2) * kstep;
            const char* a3 = a2 + kstep; const char* b3 = b2 + kstep;
            if (last && has_next) S.a_ready(nxt);
            if constexpr (SP2) {
            PG8_LDB(B0, 0, 0); PG8_LDB(B1, 0, 1); PG8_SCHED; PG8_LDA(At, 0, 0); PG8_STAGE(PG8_SA(1, 1), a1 + hstep, voffA, rsA, g.A);
            PG8_WAIT_V(8); PG8_WAIT_L(0); PG8_BAR; PG8_MMA(0, 0, At, B0); PG8_MMA(0, 1, At, B1); PG8_BAR; PG8_SCHED;
            PG8_LDA(At, 0, 1); PG8_STAGE(PG8_SB(0, 0), b2, voffB, rsB, g.Bt); PG8_STAGE(PG8_SB(0, 1), b2 + hstep, voffB, rsB, g.Bt); PG8_STAGE(PG8_SA(0, 0), a2, voffA, rsA, g.A);
            PG8_WAIT_V(8); PG8_WAIT_L(0); PG8_BAR; PG8_MMA(1, 0, At, B0); PG8_MMA(1, 1, At, B1); PG8_BAR; PG8_SCHED;
            PG8_LDB(B0, 1, 0); PG8_LDB(B1, 1, 1); PG8_SCHED; PG8_LDA(At, 1, 0); PG8_STAGE(PG8_SA(0, 1), a2 + hstep, voffA, rsA, g.A);
            PG8_WAIT_V(8); PG8_WAIT_L(0); PG8_BAR; PG8_MMA(0, 0, At, B0); PG8_MMA(0, 1, At, B1); PG8_BAR; PG8_SCHED;
            PG8_LDA(At, 1, 1); PG8_STAGE(PG8_SB(1, 0), b3, voffB, rsB, g.Bt); PG8_STAGE(PG8_SB(1, 1), b3 + hstep, voffB, rsB, g.Bt); PG8_STAGE(PG8_SA(1, 0), a3, voffA, rsA, g.A);
            PG8_WAIT_V(8); PG8_WAIT_L(0); PG8_BAR; PG8_MMA(1, 0, At, B0); PG8_MMA(1, 1, At, B1); PG8_BAR; PG8_SCHED;
            } else {
            PG8_LDB(B0, 0, 0); PG8_SCHED; PG8_LDA(At, 0, 0); PG8_STAGE(PG8_SA(1, 1), a1 + hstep, voffA, rsA, g.A);
            PG8_WAIT_L(8); PG8_BAR; PG8_WAIT_L(0); PG8_MMA(0, 0, At, B0); PG8_BAR; PG8_SCHED;
            PG8_LDB(B1, 0, 1); PG8_STAGE(PG8_SB(0, 0), b2, voffB, rsB, g.Bt);
            PG8_BAR; PG8_WAIT_L(0); PG8_MMA(0, 1, At, B1); PG8_BAR;
            PG8_LDA(At, 0, 1); PG8_STAGE(PG8_SA(0, 0), a2, voffA, rsA, g.A);
            PG8_BAR; PG8_WAIT_L(0); PG8_MMA(1, 0, At, B0); PG8_BAR; PG8_SCHED;
            PG8_STAGE(PG8_SB(0, 1), b2 + hstep, voffB, rsB, g.Bt);
            PG8_WAIT_V(6); PG8_BAR; PG8_MMA(1, 1, At, B1); PG8_BAR;
            PG8_LDB(B0, 1, 0); PG8_SCHED; PG8_LDA(At, 1, 0); PG8_STAGE(PG8_SA(0, 1), a2 + hstep, voffA, rsA, g.A);
            PG8_WAIT_L(8); PG8_BAR; PG8_WAIT_L(0); PG8_MMA(0, 0, At, B0); PG8_BAR; PG8_SCHED;
            PG8_LDB(B1, 1, 1); PG8_STAGE(PG8_SB(1, 0), b3, voffB, rsB, g.Bt);
            PG8_BAR; PG8_WAIT_L(0); PG8_MMA(0, 1, At, B1); PG8_BAR;
            PG8_LDA(At, 1, 1); PG8_STAGE(PG8_SA(1, 0), a3, voffA, rsA, g.A);
            PG8_BAR; PG8_WAIT_L(0); PG8_MMA(1, 0, At, B0); PG8_BAR; PG8_SCHED;
            PG8_STAGE(PG8_SB(1, 1), b3 + hstep, voffB, rsB, g.Bt);
            PG8_WAIT_V(6); PG8_BAR; PG8_MMA(1, 1, At, B1); PG8_BAR;
            }
        }
        if constexpr (ALIGN_EPI) { if (wr == 0) PG8_BAR; }
        E(acc, cur, wr, wc, fr, fq); S.done(cur);
        if (!has_next) break;
#pragma unroll
        for (int a = 0; a < 2; ++a)
#pragma unroll
            for (int b = 0; b < 2; ++b)
#pragma unroll
                for (int m = 0; m < 4; ++m)
#pragma unroll
                    for (int n = 0; n < 2; ++n) acc[a][b][m][n] = (f32x4){0.f, 0.f, 0.f, 0.f};
        cur = nxt; cA = nA; cB = nB; ++ui;
        if constexpr (ALIGN_EPI) { if (wr == 1) PG8_BAR; }
    }
    PG8_WAIT_V(0);
    if constexpr (!ALIGN_EPI) { if (wr == 0) PG8_BAR; }
    PG8_BAR;
#undef PG8_SA
#undef PG8_SB
#undef PG8_STAGE
#undef PG8_LDA
#undef PG8_LDB
#undef PG8_MMA
#undef PG8_WAIT_V
#undef PG8_WAIT_L
#undef PG8_BAR
#undef PG8_SCHED
}
}
using pg8::Unit;
constexpr int HALF = pg8::HALF, BM = pg8::BM;

struct EpiSwiGLU {
    static constexpr bool PERM = true;
    f16* O;
    __device__ __forceinline__ void operator()(const f32x4 (&acc)[2][2][4][2], const Unit& u, int wr, int wc, int fr, int fq) const {
        asm volatile("" : "+v"(fr), "+v"(fq));
        const int row0 = u.pm * BM + wr * 64 + fr, col0 = u.pn * HALF + wc * 32 + 8 * fq;
#pragma unroll
        for (int ai = 0; ai < 2; ++ai)
#pragma unroll
            for (int m = 0; m < 4; ++m) {
                f16* rowp = O + (size_t)(row0 + ai * HALF + m * 16) * DFF + col0;
                const f32x4 g0 = acc[ai][0][m][0], g1 = acc[ai][0][m][1], u0 = acc[ai][1][m][0], u1 = acc[ai][1][m][1];
                u32x4 w;
                w.x = pk_f16(siluf_(g0[0]) * u0[0], siluf_(g0[1]) * u0[1]); w.y = pk_f16(siluf_(g0[2]) * u0[2], siluf_(g0[3]) * u0[3]);
                w.z = pk_f16(siluf_(g1[0]) * u1[0], siluf_(g1[1]) * u1[1]); w.w = pk_f16(siluf_(g1[2]) * u1[2], siluf_(g1[3]) * u1[3]);
                *(u32x4*)rowp = w;
            }
    }
};
struct EpiResid {
    static constexpr bool PERM = true;
    f16* X; const float* modg;
    int halfc; const float* Xin32;
    __device__ __forceinline__ void operator()(const f32x4 (&acc)[2][2][4][2], const Unit& u, int wr, int wc, int fr, int fq) const {
        asm volatile("" : "+v"(fr), "+v"(fq));
        const int row0 = u.pm * BM + wr * 64 + fr, col0 = u.pn * BM + wc * 32 + 8 * fq;
        const int bidx = u.pm < 32 ? (u.pm >> 3) : 4;
        const float* gp = modg + (size_t)bidx * NMODC + col0; const float coef = halfc ? 0.5f : 1.0f;
        f32x4 gv[2][2];
#pragma unroll
        for (int bj = 0; bj < 2; ++bj)
#pragma unroll
            for (int n = 0; n < 2; ++n) gv[bj][n] = *(const f32x4*)(gp + bj * HALF + n * 4) * coef;
#pragma unroll
        for (int ai = 0; ai < 2; ++ai)
#pragma unroll
            for (int m = 0; m < 4; ++m) { const size_t ro = (size_t)(row0 + ai * HALF + m * 16) * D + col0;
#pragma unroll
                for (int bj = 0; bj < 2; ++bj) { f32x4 x0, x1;
                    if (Xin32) { x0 = *(const f32x4*)(Xin32 + ro + bj * HALF); x1 = *(const f32x4*)(Xin32 + ro + bj * HALF + 4); }
                    else { const f16x8 h8 = *(const f16x8*)(X + ro + bj * HALF); x0 = (f32x4){(float)h8[0], (float)h8[1], (float)h8[2], (float)h8[3]}; x1 = (f32x4){(float)h8[4], (float)h8[5], (float)h8[6], (float)h8[7]}; }
                    x0 = x0 + gv[bj][0] * acc[ai][bj][m][0]; x1 = x1 + gv[bj][1] * acc[ai][bj][m][1];
                    u32x4 w; w.x = pk_f16(x0[0], x0[1]); w.y = pk_f16(x0[2], x0[3]); w.z = pk_f16(x1[0], x1[1]); w.w = pk_f16(x1[2], x1[3]);
                    *(u32x4*)(X + ro + bj * HALF) = w; } }
    }
};
struct EpiResidPart {
    static constexpr bool PERM = false;
    float* PART; const float* modg; float coef;
    __device__ __forceinline__ void operator()(const f32x4 (&acc)[2][2][4][2], const Unit& u, int wr, int wc, int fr, int fq) const {
        asm volatile("" : "+v"(fr), "+v"(fq));
        const int row0 = (u.pm - 32) * BM + wr * 64 + fr, col0 = u.pn * BM + wc * 32 + 4 * fq;
        const float* gp = modg + (size_t)4 * NMODC + col0;
        f32x4 gv[2][2];
#pragma unroll
        for (int bj = 0; bj < 2; ++bj)
#pragma unroll
            for (int n = 0; n < 2; ++n) gv[bj][n] = *(const f32x4*)(gp + bj * HALF + n * 16) * coef;
#pragma unroll
        for (int ai = 0; ai < 2; ++ai)
#pragma unroll
            for (int m = 0; m < 4; ++m) { float* rowp = PART + ((size_t)u.kp * MC + row0 + ai * HALF + m * 16) * D + col0;
#pragma unroll
                for (int bj = 0; bj < 2; ++bj)
#pragma unroll
                    for (int n = 0; n < 2; ++n) *(f32x4*)(rowp + bj * HALF + n * 16) = gv[bj][n] * acc[ai][bj][m][n]; }
    }
};
struct EpiProj {
    static constexpr bool PERM = true;
    f16* P; float* G; const float* rope;
    __device__ __forceinline__ void operator()(const f32x4 (&acc)[2][2][4][2], const Unit& u, int wr, int wc, int fr, int fq) const {
        asm volatile("" : "+v"(fr), "+v"(fq));
        const int row0 = u.pm * BM + wr * 64 + fr; const int pn = u.pn;
        if (pn == 60) {
            if (wc == 0 && fq < 2) {
#pragma unroll
                for (int ai = 0; ai < 2; ++ai)
#pragma unroll
                    for (int m = 0; m < 4; ++m) { float* gp = G + (size_t)(row0 + ai * HALF + m * 16) * 16 + 8 * fq;
                        *(f32x4*)gp = acc[ai][0][m][0]; *(f32x4*)(gp + 4) = acc[ai][0][m][1]; }
            }
            return;
        }
        const int col0 = pn * BM + wc * 32 + 8 * fq;
        int mode = 0; float scl = 1.0f;
        if (pn < 8) { mode = (u.pm < 32) ? 1 : 2; scl = (pn >= 4) ? 0.0625f : 1.0f; }
        else if (pn >= 12 && pn < 16) mode = 3;
        else if (pn >= 16 && pn < 20) { mode = 2; scl = 0.08838834764831845f; }
        else if (pn >= 32 && pn < 36) mode = 4;
        else if (pn >= 36) mode = 3;
#pragma unroll
        for (int ai = 0; ai < 2; ++ai)
#pragma unroll
            for (int m = 0; m < 4; ++m) {
                const int row = row0 + ai * HALF + m * 16;
                f16* rowp = P + (size_t)row * LDP + col0;
#pragma unroll
                for (int bj = 0; bj < 2; ++bj) {
                    f32x4 v0 = acc[ai][bj][m][0], v1 = acc[ai][bj][m][1];
                    if (mode == 1) {
                        const int t = row & (SEQ - 1); const int pos = bj == 0 ? (t >> 6) : (t & 63);
                        const float* cp = rope + pos * 64 + 16 * wc + 4 * fq;
                        const f32x4 c = *(const f32x4*)cp, s = *(const f32x4*)(cp + 4096);
                        f32x4 o0, o1;
                        o0[0] = v0[0] * c[0] - v0[1] * s[0]; o0[1] = v0[0] * s[0] + v0[1] * c[0];
                        o0[2] = v0[2] * c[1] - v0[3] * s[1]; o0[3] = v0[2] * s[1] + v0[3] * c[1];
                        o1[0] = v1[0] * c[2] - v1[1] * s[2]; o1[1] = v1[0] * s[2] + v1[1] * c[2];
                        o1[2] = v1[2] * c[3] - v1[3] * s[3]; o1[3] = v1[2] * s[3] + v1[3] * c[3];
                        v0 = o0 * scl; v1 = o1 * scl;
                    } else if (mode == 2) { v0 = v0 * scl; v1 = v1 * scl; }
                    else if (mode == 3) {
#pragma unroll
                        for (int e = 0; e < 4; ++e) { v0[e] = sigmoidf_(v0[e]); v1[e] = sigmoidf_(v1[e]); }
                    } else if (mode == 4) {
#pragma unroll
                        for (int e = 0; e < 4; ++e) { v0[e] = gelu_tanh_(v0[e]); v1[e] = gelu_tanh_(v1[e]); }
                    }
                    u32x4 w; w.x = pk_f16(v0[0], v0[1]); w.y = pk_f16(v0[2], v0[3]); w.z = pk_f16(v1[0], v1[1]); w.w = pk_f16(v1[2], v1[3]);
                    *(u32x4*)(rowp + bj * HALF) = w;
                }
            }
    }
};
template <int MODE> struct EpiGate {
    static constexpr bool PERM = true;
    const f16* gate;
    f16* MH;
    __device__ __forceinline__ void operator()(const f32x4 (&acc)[2][2][4][2], const Unit& u, int wr, int wc, int fr, int fq) const {
        asm volatile("" : "+v"(fr), "+v"(fq));
        const int row0 = u.pm * BM + wr * 64 + fr, col0 = u.pn * BM + wc * 32 + 8 * fq;
#pragma unroll
        for (int ai = 0; ai < 2; ++ai)
#pragma unroll
            for (int m = 0; m < 4; ++m) {
                const int row = row0 + ai * HALF + m * 16;
#pragma unroll
                for (int bj = 0; bj < 2; ++bj) {
                    const f16x8 gh = *(const f16x8*)(gate + (size_t)row * LDP + col0 + bj * HALF);
                    f16* mp = MH + (size_t)row * D + col0 + bj * HALF;
                    f32x4 v0 = acc[ai][bj][m][0], v1 = acc[ai][bj][m][1];
#pragma unroll
                    for (int e = 0; e < 4; ++e) { v0[e] *= (float)gh[e]; v1[e] *= (float)gh[4 + e]; }
                    if (MODE >= 1) { const f16x8 pm_ = *(const f16x8*)mp;
#pragma unroll
                        for (int e = 0; e < 4; ++e) { v0[e] += (float)pm_[e]; v1[e] += (float)pm_[4 + e]; } }
                    { u32x4 w; w.x = pk_f16(v0[0], v0[1]); w.y = pk_f16(v0[2], v0[3]); w.z = pk_f16(v1[0], v1[1]); w.w = pk_f16(v1[2], v1[3]); *(u32x4*)mp = w; }
                }
            }
    }
};

struct Args { const float* in[28]; float* out; unsigned char* ws; int ph_lo, ph_hi; };
struct Frame {
    LAS unsigned char* lds; int tid, lane, wave, G, bid;
    float* out; unsigned char* ws;
};
typedef const Args __attribute__((address_space(4)))* KArgs;
__device__ __forceinline__ KArgs kargs() { return (KArgs)__builtin_amdgcn_kernarg_segment_ptr(); }
__device__ __forceinline__ const float* inp(int k) { return kargs()->in[k]; }
extern __shared__ __attribute__((aligned(16))) unsigned char lds_raw[];
__device__ __forceinline__ Frame make_frame() {
    Frame F; F.lds = (LAS unsigned char*)lds_raw; int t = threadIdx.x; asm volatile("" : "+v"(t));
    F.tid = t; F.lane = F.tid & 63; F.wave = __builtin_amdgcn_readfirstlane(F.tid >> 6);
    int g = gridDim.x, b = blockIdx.x; asm volatile("" : "+s"(g), "+s"(b)); F.G = g; F.bid = b;
    KArgs ka = kargs(); asm volatile("" : "+s"(ka)); F.out = ka->out; F.ws = ka->ws; return F;
}
#define UNI(x) __builtin_amdgcn_readfirstlane(x)
#define WSP(T, off) ((T*)(F.ws + (off)))

template <int MAP> __device__ __forceinline__ int dest_row(int c) {
    if (MAP == 0) return c;
    if (MAP == 1) { const int bj = c >= DFF ? 1 : 0, j = c - bj * DFF; return (j >> 7) * 256 + bj * 128 + (j & 127); }
    if (c < 2048) { const int base = c & 1024, x = c & 255, hh = (c >> 8) & 3, bj = x >> 7, within = x & 127, e = within >> 6, i = within & 63; return base + hh * 256 + bj * 128 + 2 * i + e; }
    if (c < 4096) return c;
    if (c < 4112) return 15360 + (c - 4096);
    return c - 16;
}
template <int MAP> __device__ __forceinline__ void transpose_item2(const float* W, int ldw, int k0, int c0, f16* WT, int Kdim, LAS float* scr, int lane) {
    const int col4 = (lane & 7) * 4; const bool cv = c0 + col4 < ldw;
    f32x4 v[8];
#pragma unroll
    for (int it = 0; it < 8; ++it) { const int r = it * 8 + (lane >> 3); v[it] = cv ? __builtin_nontemporal_load((const f32x4*)(W + (size_t)(k0 + r) * ldw + c0 + col4)) : (f32x4){0.f, 0.f, 0.f, 0.f}; }
#pragma unroll
    for (int it = 0; it < 8; ++it) { const int r = it * 8 + (lane >> 3); LAS float* d = scr + r * 33 + col4; d[0] = v[it].x; d[1] = v[it].y; d[2] = v[it].z; d[3] = v[it].w; }
    LDS_WAIT();
    const int c = lane & 7;
#pragma unroll
    for (int j = 0; j < 4; ++j) { const int n = (lane >> 3) + 8 * j; const LAS float* sp = scr + (8 * c) * 33 + n;
        u32x4 o; o.x = pk_f16(sp[0 * 33], sp[1 * 33]); o.y = pk_f16(sp[2 * 33], sp[3 * 33]); o.z = pk_f16(sp[4 * 33], sp[5 * 33]); o.w = pk_f16(sp[6 * 33], sp[7 * 33]);
        if (c0 + n < ldw) __builtin_nontemporal_store(o, (u32x4*)(WT + (size_t)dest_row<MAP>(c0 + n) * Kdim + k0 + 8 * c)); }
    LDS_WAIT();
}
constexpr int CV_W1 = 32 * 352, CV_W2 = 88 * 64, CV_WIN = 32 * 481, CV_WBR = 3 * 16 * 64, CV_WOUT = 32 * 64, CV_LRU = 256;
constexpr int CV_PER_L = 2 * CV_W1 + 2 * CV_W2 + CV_WIN + CV_WBR + CV_WOUT + CV_LRU;
__device__ __forceinline__ void convert_item(Frame& F, int l, int r, LAS float* scr) {
    unsigned char* wl = F.ws + WS_W + (size_t)l * WL_SIZE;
    if (r < 2 * CV_W1) { const int which = r / CV_W1; r %= CV_W1;
        transpose_item2<1>(inp(which ? 11 : 9) + (size_t)l * D * 2 * DFF, 2 * DFF, (r / 352) * 64, (r % 352) * 32, (f16*)(wl + (which ? WL_W3 : WL_W1)), D, scr, F.lane); return; }
    r -= 2 * CV_W1;
    if (r < 2 * CV_W2) { const int which = r / CV_W2; r %= CV_W2;
        transpose_item2<0>(inp(which ? 12 : 10) + (size_t)l * DFF * D, D, (r / 64) * 64, (r % 64) * 32, (f16*)(wl + (which ? WL_W4 : WL_W2)), DFF, scr, F.lane); return; }
    r -= 2 * CV_W2;
    if (r < CV_WIN) { transpose_item2<2>(inp(13) + (size_t)l * D * PIN_SRC, PIN_SRC, (r / 481) * 64, (r % 481) * 32, (f16*)(wl + WL_WIN), D, scr, F.lane); return; }
    r -= CV_WIN;
    if (r < CV_WBR) { const int n = r / 1024; r %= 1024;
        transpose_item2<0>(inp(25) + ((size_t)l * 3 + n) * BW * D, D, (r / 64) * 64, (r % 64) * 32, (f16*)(wl + WL_WBR) + (size_t)n * D * BW, BW, scr, F.lane); return; }
    r -= CV_WBR;
    if (r < CV_WOUT) { transpose_item2<0>(inp(26) + (size_t)l * D * D, D, (r / 64) * 64, (r % 64) * 32, (f16*)(wl + WL_WOUT), D, scr, F.lane); return; }
    r -= CV_WOUT;
    { const int mat = r >> 7, ng = (r >> 3) & 15, kb = (r >> 2) & 1, nb = r & 3;
      transpose_item2<0>(inp(mat ? 22 : 20) + ((size_t)l * 16 + ng) * 128 * 128, 128, kb * 64, nb * 32, WSP(f16, WS_WLRU) + (((size_t)l * 2 + mat) * 16 + ng) * 128 * 128, 128, scr, F.lane); }
}
constexpr int CO_A = CV_W1 + CV_W2 + CV_WIN + CV_LRU;
constexpr int CO_L0 = CV_PER_L, CO_TOT = 2 * CV_PER_L;
__device__ __forceinline__ void ord_item(Frame& F, int o, LAS float* scr) {
    const int l = o >= CO_L0 ? 1 : 0; int x = o - l * CO_L0;
    constexpr int N_W3 = CV_W1, N_W2 = 2 * CV_W1, N_W4 = 2 * CV_W1 + CV_W2, N_WIN = 2 * CV_W1 + 2 * CV_W2, N_WBR = N_WIN + CV_WIN, N_WOUT = N_WBR + CV_WBR, N_LRU = N_WOUT + CV_WOUT;
    int r;
    if (x < CV_W1) r = x;
    else if ((x -= CV_W1) < CV_W2) r = N_W2 + x;
    else if ((x -= CV_W2) < CV_WIN) r = N_WIN + x;
    else if ((x -= CV_WIN) < CV_LRU) r = N_LRU + x;
    else if ((x -= CV_LRU) < CV_WBR) r = N_WBR + x;
    else if ((x -= CV_WBR) < CV_WOUT) r = N_WOUT + x;
    else if ((x -= CV_WOUT) < CV_W1) r = N_W3 + x;
    else { x -= CV_W1; r = N_W4 + x; }
    convert_item(F, l, r, scr);
}
__device__ __forceinline__ void ph_convert_idle(int nunits, int q, int start) {
    Frame F = make_frame();
    if (F.G != 256) return;
    LAS float* scr = (LAS float*)(F.lds + F.wave * 16384);
    const int first_idle = nunits - ((nunits + F.G - 1) / F.G - 1) * F.G; if (F.bid < first_idle) return;
    const int nidle = F.G - first_idle, j = F.bid - first_idle, lim = min(start + nidle * 8 * q, CO_TOT);
#pragma unroll 1
    for (int t = 0; t < q; ++t) { const int o = start + (t * nidle + j) * 8 + F.wave; if (o < lim) ord_item(F, o, scr); }
}
__device__ __forceinline__ void ph_convert_all(int start, int end) {
    Frame F = make_frame();
    if (F.G != 256) return;
    LAS float* scr = (LAS float*)(F.lds + F.wave * 16384);
    for (int o = start + F.bid * 8 + F.wave; o < end; o += F.G * 8) ord_item(F, o, scr);
}
constexpr int CS1 = CO_A, CS2 = CS1 + 208 * 48, CS3 = CS2 + 128 * 24, CS4 = CS3 + 108 * 48, CS5 = CS4 + 224 * 48, CS6 = CS5 + 224 * 24, CS7 = CS6 + 128 * 24, CS8 = CS7 + 208 * 48,
              CT1 = CS8 + 128 * 24, CT2 = CT1 + 208 * 48, CT3 = CT2 + 128 * 24, CO_W3END = CO_TOT - CV_W2;
static_assert(CS4 >= CO_A + CV_WBR && CS6 >= CO_A + CV_WBR + CV_WOUT && CS7 >= CO_L0 - CV_W2 && CS8 >= CO_L0, "layer-0 deadlines");
static_assert(CT1 >= CO_L0 + CV_W1 && CT2 >= CO_L0 + CV_W1 + CV_W2 && CT3 >= CO_L0 + CO_A + CV_WBR + CV_WOUT && CT3 <= CO_W3END && CO_W3END + 128 * 48 >= CO_TOT, "layer-1 deadlines");
__device__ __forceinline__ void phase_prologue() {
    Frame F = make_frame();
    const int gw = F.bid * 8 + F.wave, NGW = F.G * 8;
    const int gt = F.bid * 512 + F.tid, NGT = F.G * 512;
    { const f32x4* cs = (const f32x4*)inp(2); u32x2* X = WSP(u32x2, WS_X) + (size_t)ML * D / 4; for (int i = gt; i < MC * D / 4; i += NGT) { const f32x4 v = cs[i]; u32x2 w; w.x = pk_f16(v.x, v.y); w.y = pk_f16(v.z, v.w); X[i] = w; } }
    { float* rope = WSP(float, WS_ROPE);
      for (int i = gt; i < 4096; i += NGT) { const int pos = i >> 6, j = i & 63; const float inv = powf(10000.0f, -(float)j / 64.0f); const float a = (float)pos * inv; rope[i] = cosf(a); rope[4096 + i] = sinf(a); }
      for (int l = 0; l < DEPTH; ++l) { u32x4* z = (u32x4*)(F.ws + WS_W + (size_t)l * WL_SIZE + WL_WIN + (size_t)15376 * D * 2);
          for (int i = gt; i < 240 * D * 2 / 16; i += NGT) z[i] = (u32x4){0u, 0u, 0u, 0u}; } }
    LAS float* scr = (LAS float*)(F.lds + F.wave * 16384);
    LAS float* sa = (LAS float*)(F.lds + F.wave * 16384 + 8448);
    for (int it = F.bid; it < DEPTH * 72; it += F.G) {
        const int l = it / 72, cg = it % 72, n0 = cg * 256 + 4 * F.lane, k0 = F.wave * 256;
        for (int i = F.lane; i < 5 * 256; i += 64) { const int bi = i >> 8, k = i & 255; const float c = bi < 4 ? inp(1)[bi * D + k0 + k] : inp(3)[k0 + k]; sa[i] = siluf_(c); }
        LDS_WAIT();
        const float* Wm = inp(4) + (size_t)l * D * NMODC + (size_t)k0 * NMODC + n0;
        f32x4 acc[5];
#pragma unroll
        for (int bi = 0; bi < 5; ++bi) acc[bi] = (f32x4){0.f, 0.f, 0.f, 0.f};
#pragma unroll 8
        for (int kk = 0; kk < 256; ++kk) { const f32x4 w = __builtin_nontemporal_load((const f32x4*)(Wm + (size_t)kk * NMODC));
#pragma unroll
            for (int bi = 0; bi < 5; ++bi) acc[bi] = acc[bi] + w * sa[bi * 256 + kk]; }
#pragma unroll
        for (int bi = 0; bi < 5; ++bi) *(LAS f32x4*)(scr + bi * 256 + 4 * F.lane) = acc[bi];
        __syncthreads();
        for (int i = F.tid; i < 5 * 256; i += 512) { const int bi = i >> 8, col = i & 255; float sum = inp(5)[(size_t)l * NMODC + cg * 256 + col];
#pragma unroll
            for (int w = 0; w < 8; ++w) sum += ((LAS float*)(F.lds + w * 16384))[bi * 256 + col];
            WSP(float, WS_MOD)[((size_t)l * 5 + bi) * NMODC + cg * 256 + col] = sum; }
        __syncthreads();
    }
    if (F.G == 256) {
        constexpr int NHI = 30352;
        if (F.bid >= 144) { for (int o = (F.bid - 144) * 8 + F.wave; o < NHI; o += 112 * 8) ord_item(F, o, scr); }
        else { for (int o = NHI + F.bid * 8 + F.wave; o < CO_A; o += 144 * 8) ord_item(F, o, scr); }
    } else { for (int o = gw; o < CO_TOT; o += NGW) ord_item(F, o, scr); }
}

__device__ __forceinline__ void phase_adaln(int li_v, int which_v) {
    Frame F = make_frame(); const int li = UNI(li_v), which = UNI(which_v);
    const float* gain = inp(6 + which) + (size_t)li * D; const int chunk_shift = 3 * which; const int M = (which == 2 && li == DEPTH - 1) ? ML : MT;
    const int gw = F.bid * 8 + F.wave, NGW = F.G * 8;
    const bool first = li == 0 && which == 0;
    const f16* XH = WSP(f16, WS_X); f16* H = WSP(f16, WS_H);
#pragma unroll 1
    for (int pass = 0; pass < 2; ++pass) {
        int bidx, rbeg, rend, rstep;
        if (pass == 0) { const int wpb = NGW / NB; if (wpb == 0) { bidx = -1; rbeg = rend = rstep = 0; } else { bidx = gw / wpb; rbeg = bidx * SEQ + gw % wpb; rend = (bidx + 1) * SEQ; rstep = wpb; if (bidx >= NB) { bidx = -1; } } }
        else { bidx = 4; rbeg = ML + gw; rend = M; rstep = NGW; }
        if (bidx < 0 || rbeg >= rend) continue;
        const float* modb = WSP(float, WS_MOD) + ((size_t)li * 5 + bidx) * NMODC + chunk_shift * D;
        f32x4 gm[4][2], sh[4][2];
#pragma unroll
        for (int j = 0; j < 4; ++j)
#pragma unroll
            for (int hh = 0; hh < 2; ++hh) { const int c = (64 * j + F.lane) * 8 + 4 * hh; gm[j][hh] = *(const f32x4*)(gain + c) * (*(const f32x4*)(modb + D + c) + 1.0f); sh[j][hh] = *(const f32x4*)(modb + c); }
#pragma unroll 1
        for (int row = rbeg; row < rend; row += rstep) {
            f32x4 v[4][2]; float ss = 0.f;
            if (first && row < ML) { const f32x4* xr = (const f32x4*)(inp(0) + (size_t)row * D) + 2 * F.lane;
#pragma unroll
                for (int j = 0; j < 4; ++j) { v[j][0] = xr[128 * j]; v[j][1] = xr[128 * j + 1]; } }
            else { const f16x8* xr = (const f16x8*)(XH + (size_t)row * D) + F.lane;
#pragma unroll
                for (int j = 0; j < 4; ++j) { const f16x8 h8 = __builtin_nontemporal_load(xr + 64 * j);
                    v[j][0] = (f32x4){(float)h8[0], (float)h8[1], (float)h8[2], (float)h8[3]}; v[j][1] = (f32x4){(float)h8[4], (float)h8[5], (float)h8[6], (float)h8[7]}; } }
            if (row >= ML && !first) {
                const f32x4* pr = (const f32x4*)(WSP(float, WS_PART) + (size_t)(row - ML) * D) + 2 * F.lane;
#pragma unroll
                for (int kp = 0; kp < 4; ++kp)
#pragma unroll
                    for (int j = 0; j < 4; ++j) { v[j][0] = v[j][0] + pr[(size_t)kp * MC * D / 4 + 128 * j]; v[j][1] = v[j][1] + pr[(size_t)kp * MC * D / 4 + 128 * j + 1]; }
                u32x4* xw = (u32x4*)(WSP(f16, WS_X) + (size_t)row * D) + F.lane;
#pragma unroll
                for (int j = 0; j < 4; ++j) { u32x4 w; w.x = pk_f16(v[j][0].x, v[j][0].y); w.y = pk_f16(v[j][0].z, v[j][0].w); w.z = pk_f16(v[j][1].x, v[j][1].y); w.w = pk_f16(v[j][1].z, v[j][1].w); xw[64 * j] = w; }
            }
#pragma unroll
            for (int j = 0; j < 4; ++j)
#pragma unroll
                for (int hh = 0; hh < 2; ++hh) ss += (v[j][hh].x * v[j][hh].x + v[j][hh].y * v[j][hh].y) + (v[j][hh].z * v[j][hh].z + v[j][hh].w * v[j][hh].w);
            const float rstd = rsqrtf(wave_sum(ss, F.lane) * (1.0f / D) + EPS);
            u32x4* o = (u32x4*)(H + (size_t)row * D) + F.lane;
#pragma unroll
            for (int j = 0; j < 4; ++j) { const f32x4 y0 = v[j][0] * rstd * gm[j][0] + sh[j][0], y1 = v[j][1] * rstd * gm[j][1] + sh[j][1];
                u32x4 w; w.x = pk_f16(y0.x, y0.y); w.y = pk_f16(y0.z, y0.w); w.z = pk_f16(y1.x, y1.y); w.w = pk_f16(y1.z, y1.w); o[64 * j] = w; }
        }
    }
}
__device__ __forceinline__ void phase_final() {
    Frame F = make_frame();
    const int gw = F.bid * 8 + F.wave, NGW = F.G * 8;
    const f16* X = WSP(f16, WS_X); const float* gain = inp(27);
    for (int row = gw; row < ML; row += NGW) {
        const f16x4* xr = (const f16x4*)(X + (size_t)row * D) + F.lane;
        f32x4 v[8]; float ss = 0.f;
#pragma unroll
        for (int j = 0; j < 8; ++j) { const f16x4 h4 = xr[64 * j]; v[j] = (f32x4){(float)h4[0], (float)h4[1], (float)h4[2], (float)h4[3]}; ss += (v[j].x * v[j].x + v[j].y * v[j].y) + (v[j].z * v[j].z + v[j].w * v[j].w); }
        const float rstd = rsqrtf(wave_sum(ss, F.lane) * (1.0f / D) + EPS);
        f32x4* o = (f32x4*)(F.out + (size_t)row * D) + F.lane;
#pragma unroll
        for (int j = 0; j < 8; ++j) { const int c = (64 * j + F.lane) * 4; f32x4 r_ = v[j] * rstd * *(const f32x4*)(gain + c);
#if TPROBE
            { const float* tp = (const float*)(F.ws + WS_CTL) + 2048; r_ = r_ * (1.0f + sqrtf(tp[0] * 1e-3f)); if (row == 0 && c == 0) r_.x += tp[1] * 1e3f; }
#endif
            o[64 * j] = r_; }
    }
}


template <int PASS> __device__ __forceinline__ void lru_block(Frame& F, int li, bool latent_only, int ufirst = 0, int ulimit = 1 << 30) {
    LAS f16* Xc = (LAS f16*)F.lds;
    LAS float* Hs = (LAS float*)(F.lds + 17408);
    const f16* P = WSP(f16, WS_P); float* SUM = WSP(float, WS_LSUM);
    const int lane0 = F.lane, wave = F.wave, tid0 = F.tid; int tid = tid0, c8 = (tid0 & 15) * 8;
    const int nunits = min(latent_only ? 4 * 32 * 8 : 4 * 36 * 8, ulimit);
#define LRU_UNIT(it) (latent_only ? ((it) / 256) * 288 + 32 + ((it) % 256) : (it))
#define LRU_ROW0(u) ((((u) >> 3) % 36) < 4 ? ML + ((u) / 288) * CTXL + (((u) >> 3) % 36) * 64 : ((u) / 288) * SEQ + ((((u) >> 3) % 36) - 4) * 64)
#define LRU_SBEG(u) ((((u) >> 3) % 36) < 4 ? ML + ((u) / 288) * CTXL : ((u) / 288) * SEQ)
#define LRU_SEND(u) (LRU_SBEG(u) + ((((u) >> 3) % 36) < 4 ? CTXL : SEQ))
    f16x8 raw[2][4];
#define LRU_PREFETCH(u) do { const int row0_ = LRU_ROW0(u), sb_ = LRU_SBEG(u), se_ = LRU_SEND(u), g_ = (u) & 7; \
        _Pragma("unroll") for (int it_ = 0; it_ < 2; ++it_) { const int row_ = row0_ + ((it_ * 512 + tid) >> 4); \
            _Pragma("unroll") for (int j_ = 0; j_ < 4; ++j_) { const int rr_ = row_ + j_ - 1; raw[it_][j_] = (f16x8){0, 0, 0, 0, 0, 0, 0, 0}; \
                if (rr_ >= sb_ && rr_ < se_) raw[it_][j_] = *(const f16x8*)(P + (size_t)rr_ * LDP + LX + g_ * 128 + c8); } } } while (0)
    int gprev = -1;
    f16x8 wa[2][4], wx[2][4]; float bav[2], bxv[2], sp[2];
    if (ufirst + F.bid < nunits) LRU_PREFETCH(LRU_UNIT(ufirst + F.bid));
#pragma unroll 1
    for (int itu = ufirst + F.bid; itu < nunits; itu += F.G) {
        const int unit = LRU_UNIT(itu);
        int lane = lane0; tid = tid0; asm volatile("" : "+v"(lane), "+v"(tid));
        const int fr = lane & 15, fq = lane >> 4; c8 = (tid & 15) * 8;
        const int g = unit & 7, seg = (unit >> 3) % 36, b = unit / 288;
        const bool isctx = seg < 4; const int row0 = LRU_ROW0(unit);
        if (g != gprev) {
            gprev = g;
#pragma unroll
            for (int q = 0; q < 2; ++q) { const int c = wave * 2 + q, n = c >> 3, jt = c & 7, ch = g * 128 + 16 * jt + fr;
                const f16* wt = WSP(f16, WS_WLRU) + ((((size_t)li * 2 + 0) * 2 + n) * 8 + g) * 128 * 128 + (size_t)(16 * jt + fr) * 128 + 8 * fq;
#pragma unroll
                for (int ks = 0; ks < 4; ++ks) { wa[q][ks] = *(const f16x8*)(wt + 32 * ks); wx[q][ks] = *(const f16x8*)(wt + (size_t)2 * 8 * 128 * 128 + 32 * ks); }
                bav[q] = inp(21)[(size_t)li * 2 * BW + n * BW + ch]; bxv[q] = inp(23)[(size_t)li * 2 * BW + n * BW + ch];
                sp[q] = log1pf(expf(-inp(24)[(size_t)li * 2 * BW + n * BW + ch])); }
        }
        const float* cw = inp(18) + (size_t)li * 4 * BW + g * 128 + c8; const float* cb = inp(19) + (size_t)li * BW + g * 128 + c8;
#pragma unroll
        for (int it = 0; it < 2; ++it) { const int t = (it * 512 + tid) >> 4;
            float y[8];
#pragma unroll
            for (int e = 0; e < 8; ++e) { y[e] = cb[e];
#pragma unroll
                for (int j = 0; j < 4; ++j) y[e] += cw[j * BW + e] * (float)raw[it][j][e]; }
            u32x4 w; w.x = pk_f16(y[0], y[1]); w.y = pk_f16(y[2], y[3]); w.z = pk_f16(y[4], y[5]); w.w = pk_f16(y[6], y[7]);
            *(LAS u32x4*)(Xc + t * 136 + c8) = w; }
        __syncthreads();
        if (itu + F.G < nunits) LRU_PREFETCH(LRU_UNIT(itu + F.G));
#pragma unroll
        for (int q = 0; q < 2; ++q) {
            const int c = wave * 2 + q, n = c >> 3, jt = c & 7, ch = g * 128 + 16 * jt + fr;
            float carry = 0.f, aprod = 1.f;
            if (PASS == 1) {
                const float* sb = SUM + ((size_t)b * 36 * 2 + n) * 2048 + ch * 2;
                const int cnt = n == 0 ? seg : (isctx ? 3 - seg : 39 - seg);
                f32x2 pv[9];
#pragma unroll
                for (int e = 0; e < 9; ++e) { const int p = fq * 9 + e; const int s2 = n == 0 ? p : (isctx ? 3 - p : (p < 4 ? 3 - p : 39 - p));
                    pv[e] = (f32x2){1.f, 0.f}; if (p < cnt) pv[e] = *(const f32x2*)(sb + (size_t)s2 * 4096); }
                float Al = 1.f, Ul = 0.f;
#pragma unroll
                for (int e = 0; e < 9; ++e) { Ul = Ul * pv[e].x + pv[e].y; Al *= pv[e].x; }
#pragma unroll
                for (int gg = 0; gg < 4; ++gg) { const float Ag = __shfl(Al, gg * 16 + fr), Ug = __shfl(Ul, gg * 16 + fr); carry = carry * Ag + Ug; }
                __builtin_amdgcn_sched_barrier(0);
            }
            float av_[4][4], uv_[4][4];
#pragma unroll
            for (int tt = 0; tt < 4; ++tt) {
                f32x4 racc = (f32x4){0.f, 0.f, 0.f, 0.f}, iacc = (f32x4){0.f, 0.f, 0.f, 0.f};
#pragma unroll
                for (int ks = 0; ks < 4; ++ks) { const f16x8 a = *(const LAS f16x8*)(Xc + (16 * tt + fr) * 136 + 32 * ks + 8 * fq); racc = mfma16(a, wa[q][ks], racc); iacc = mfma16(a, wx[q][ks], iacc); }
#pragma unroll
                for (int r = 0; r < 4; ++r) { const int t = 16 * tt + 4 * fq + r; const float rg = sigmoidf_(racc[r] + bav[q]), ig = sigmoidf_(iacc[r] + bxv[q]);
                    const float log_a = -8.0f * rg * sp[q]; av_[tt][r] = __expf(log_a);
                    const float y2 = 2.0f * log_a;
                    const float om = y2 > -0.125f ? -y2 * (1.0f + y2 * (0.5f + y2 * (0.16666667f + y2 * (0.041666668f + y2 * 0.0083333338f)))) : 1.0f - __expf(y2);
                    uv_[tt][r] = __builtin_amdgcn_sqrtf(om) * ig * (float)Xc[t * 136 + 16 * jt + fr]; }
                if (tt & 1) __builtin_amdgcn_sched_barrier(0);
            }
#pragma unroll
            for (int k = 0; k < 4; ++k) {
                const int tt = n ? 3 - k : k;
                float a4[4], u4[4];
#pragma unroll
                for (int r = 0; r < 4; ++r) { a4[r] = n ? av_[3 - k][r] : av_[k][r]; u4[r] = n ? uv_[3 - k][r] : uv_[k][r]; }
                float Al = 1.f, Ul = 0.f;
#pragma unroll
                for (int rr = 0; rr < 4; ++rr) { const float ar = n ? a4[3 - rr] : a4[rr], ur = n ? u4[3 - rr] : u4[rr]; Ul = Ul * ar + ur; Al *= ar; }
                float preA = 1.f, preU = 0.f, totA = 1.f, totU = 0.f;
#pragma unroll
                for (int gg = 0; gg < 4; ++gg) { const int gsrc = n ? 3 - gg : gg; const float Ag = __shfl(Al, gsrc * 16 + fr), Ug = __shfl(Ul, gsrc * 16 + fr);
                    const bool before = n ? (gsrc > fq) : (gsrc < fq);
                    if (before) { preU = preU * Ag + Ug; preA *= Ag; }
                    totU = totU * Ag + Ug; totA *= Ag; }
                float hrun = carry * preA + preU, arun = aprod * preA;
#pragma unroll
                for (int rr = 0; rr < 4; ++rr) { const float ar = n ? a4[3 - rr] : a4[rr], ur = n ? u4[3 - rr] : u4[rr]; hrun = ar * hrun + ur; arun *= ar;
                    const int e_ = (n * 64 + 16 * tt + 4 * fq + (n ? 3 - rr : rr)) * 128 + 16 * jt + fr;
                    if (PASS == 1) Hs[e_] = hrun;
                    else { ((LAS f16*)Hs)[e_] = (f16)hrun; ((LAS f16*)Hs)[16384 + e_] = (f16)arun; } }
                carry = carry * totA + totU; aprod *= totA;
            }
            if (PASS == 0 && fq == 0) { f32x2 v = {aprod, carry}; *(f32x2*)(SUM + (((size_t)b * 36 + seg) * 2 + n) * 2048 + ch * 2) = v; }
            __builtin_amdgcn_sched_barrier(0);
        }
        __syncthreads();
        if (PASS == 0) {
            f16* LH = WSP(f16, WS_LH); f16* LAC = WSP(f16, WS_LAC);
#pragma unroll
            for (int it = 0; it < 2; ++it) { const int t = (it * 512 + tid) >> 4; const size_t ro = ((size_t)(row0 + t) * 2) * BW + g * 128 + c8;
#pragma unroll
                for (int n = 0; n < 2; ++n) { *(u32x4*)(LH + ro + n * BW) = *(const LAS u32x4*)((LAS f16*)Hs + (n * 64 + t) * 128 + c8); *(u32x4*)(LAC + ro + n * BW) = *(const LAS u32x4*)((LAS f16*)Hs + 16384 + (n * 64 + t) * 128 + c8); } }
            __syncthreads();
        }
        if (PASS == 1) {
            f16* Y = WSP(f16, WS_Y) + (size_t)2 * MT * BW;
#pragma unroll
            for (int it = 0; it < 2; ++it) { const int t = (it * 512 + tid) >> 4; const int row = row0 + t;
                const f16x8 gg = *(const f16x8*)(P + (size_t)row * LDP + LG + g * 128 + c8);
                float y[8];
#pragma unroll
                for (int e = 0; e < 8; ++e) y[e] = (Hs[t * 128 + c8 + e] + Hs[(64 + t) * 128 + c8 + e]) * (float)gg[e];
                u32x4 w; w.x = pk_f16(y[0], y[1]); w.y = pk_f16(y[2], y[3]); w.z = pk_f16(y[4], y[5]); w.w = pk_f16(y[6], y[7]);
                *(u32x4*)(Y + (size_t)row * BW + g * 128 + c8) = w; }
            __syncthreads();
        }
    }
#undef LRU_UNIT
#undef LRU_ROW0
#undef LRU_SBEG
#undef LRU_SEND
#undef LRU_PREFETCH
}


__device__ __forceinline__ void lru_fix_block(Frame& F, int li, bool latent_only, int tfirst, int tlimit) {
    LAS float* cs = (LAS float*)F.lds;
    const f16* P = WSP(f16, WS_P); const float* SUM = WSP(float, WS_LSUM); const f16* LH = WSP(f16, WS_LH); const f16* LAC = WSP(f16, WS_LAC); f16* Y = WSP(f16, WS_Y) + (size_t)2 * MT * BW;
    const int tid = F.tid, c8 = (tid & 15) * 8;
    const int CH = latent_only ? 4 : 3, nch = latent_only ? 8 : 12;
#pragma unroll 1
    for (int t = tfirst + F.bid; t < tlimit; t += F.G) {
        const int g = t & 7, c = (t >> 3) % nch, b = t / (8 * nch), seg0 = latent_only ? 4 + 4 * c : 3 * c;
        if (tid < 256) { const int n = tid >> 7, ch = g * 128 + (tid & 127);
            const float* sb = SUM + ((size_t)b * 36 * 2 + n) * 2048 + ch * 2;
            float carry = 0.f;
#pragma unroll 12
            for (int q = 0; q < 36; ++q) { const int s2 = n == 0 ? q : (q < 4 ? 3 - q : 39 - q);
                if (s2 >= seg0 && s2 < seg0 + CH) cs[((s2 - seg0) * 2 + n) * 128 + (tid & 127)] = carry;
                const f32x2 v = *(const f32x2*)(sb + (size_t)s2 * 4096); carry = carry * v.x + v.y; }
        }
        __syncthreads();
#pragma unroll
        for (int k = 0; k < 4; ++k) if (k < CH) {
            const int seg = seg0 + k; const int row0 = seg < 4 ? ML + b * CTXL + seg * 64 : b * SEQ + (seg - 4) * 64;
            const LAS float* cf = cs + (k * 2) * 128 + c8; const LAS float* cb = cf + 128;
#pragma unroll
            for (int it = 0; it < 2; ++it) { const int tt = (it * 512 + tid) >> 4; const int row = row0 + tt; const size_t ro = ((size_t)row * 2) * BW + g * 128 + c8;
                const f16x8 hf = *(const f16x8*)(LH + ro), hb = *(const f16x8*)(LH + ro + BW), af = *(const f16x8*)(LAC + ro), ab = *(const f16x8*)(LAC + ro + BW);
                const f16x8 gg = *(const f16x8*)(P + (size_t)row * LDP + LG + g * 128 + c8);
                float y[8];
#pragma unroll
                for (int e = 0; e < 8; ++e) y[e] = ((float)hf[e] + (float)af[e] * cf[e] + (float)hb[e] + (float)ab[e] * cb[e]) * (float)gg[e];
                u32x4 w; w.x = pk_f16(y[0], y[1]); w.y = pk_f16(y[2], y[3]); w.z = pk_f16(y[4], y[5]); w.w = pk_f16(y[6], y[7]);
                *(u32x4*)(Y + (size_t)row * BW + g * 128 + c8) = w; }
        }
        __syncthreads();
    }
}

__device__ __forceinline__ void na_item(Frame& F, int li, bool lat, int b, int rr, int hpair, int& staged_hp) {
    constexpr int KB = 34816, VB = 36864, BUF = KB + VB;
    const int lane = F.lane, wave = F.wave, fr = lane & 15, fq = lane >> 4, tid = F.tid;
    const int i = wave & 3, hs = wave >> 2, h = hpair * 2 + hs;
    const f16* P = WSP(f16, WS_P); f16* Y = WSP(f16, WS_Y) + (size_t)1 * MT * BW;
    LAS float* rtab = (LAS float*)(F.lds + 2 * BUF);
    if (staged_hp != hpair) { staged_hp = hpair; for (int i_ = tid; i_ < 2 * 465; i_ += 512) rtab[i_] = inp(17)[((size_t)li * 8 + hpair * 2) * 465 + i_]; }
    const LAS float* rpb = rtab + hs * 465;
    const int q0row = lat ? b * SEQ + rr * 64 + 16 * i : ML + b * CTXL + rr * 64 + 16 * i;
    f16x8 qf[4];
#pragma unroll
    for (int ks = 0; ks < 4; ++ks) qf[ks] = *(const f16x8*)(P + (size_t)(q0row + fr) * LDP + NQ + h * 128 + 32 * ks + 8 * fq);
    f32x4 oacc[8];
#pragma unroll
    for (int dt = 0; dt < 8; ++dt) oacc[dt] = (f32x4){0.f, 0.f, 0.f, 0.f};
    float m_run = -INFINITY, l_run = 0.f;
    const int c0 = min(max(16 * i - 8, 0), 32), rs = min(max(rr - 4, 0), 24), qc = 16 * i + fr, cs = min(max(qc - 8, 0), 48);
    const int nstep = lat ? 12 : 4, nwin = lat ? 8 : 0;
#define NA_ROWBASE(st) ((st) < nwin ? b * SEQ + (rs + (st)) * 64 : ML + b * CTXL + ((st) - nwin) * 64)
    f16x8 preA[8], preB[8];
    const __amdgpu_buffer_rsrc_t rsP = __builtin_amdgcn_make_buffer_rsrc((void*)P, 0, 0x7ffff000, 0x00020000);
    const unsigned na_vo = (unsigned)(((tid >> 4) * LDP + (tid & 15) * 8) * 2);
#define NA_LOAD(pre, st) do { const unsigned so_ = (unsigned)__builtin_amdgcn_readfirstlane(NA_ROWBASE(st)) * (unsigned)(LDP * 2) + (unsigned)(hpair * 2 * 128 * 2); _Pragma("unroll") for (int it_ = 0; it_ < 8; ++it_) \
        pre[it_] = __builtin_bit_cast(f16x8, __builtin_amdgcn_raw_buffer_load_b128(rsP, na_vo, so_ + (unsigned)((32 * (it_ & 1) * LDP + ((it_ >> 2) ? NV : NK) + ((it_ >> 1) & 1) * 128) * 2), 0)); } while (0)
#define NA_STORE(pre, buf) do { _Pragma("unroll") for (int it_ = 0; it_ < 8; ++it_) { const int id_ = it_ * 512 + tid, rem_ = id_ & 2047, hs_ = rem_ >> 10, key_ = (rem_ >> 4) & 63, ch_ = rem_ & 15; \
        LAS f16* d_ = (LAS f16*)(F.lds + (buf) * BUF + ((id_ >> 11) ? KB + (hs_ * 64 + key_) * 288 : (hs_ * 64 + key_) * 272)) + ch_ * 8; *(LAS f16x8*)d_ = pre[it_]; } } while (0)
    NA_LOAD(preA, 0); NA_LOAD(preB, 1); NA_STORE(preA, 0);
    __syncthreads();
#pragma unroll 1
    for (int st2 = 0; st2 < nstep; st2 += 2) {
#pragma unroll
      for (int par = 0; par < 2; ++par) {
        const int st = st2 + par, cur = par;
        const bool win = st < nwin;
        float bv[8];
        { const LAS float* rrow = rpb + min(rs + st - rr + 7, 14) * 31;
#pragma unroll
            for (int nt = 0; nt < 2; ++nt)
#pragma unroll
                for (int r = 0; r < 4; ++r) { const int kc = c0 + 16 * nt + 4 * fq + r; bv[nt * 4 + r] = rrow[min(max(kc - qc + 15, 0), 30)]; } }
        __builtin_amdgcn_sched_barrier(0);
        { const int stn = min(st + 2, nstep - 1); if (par == 0) NA_LOAD(preA, stn); else NA_LOAD(preB, stn); }
        __builtin_amdgcn_sched_barrier(0);
        const LAS f16* Kb = (const LAS f16*)(F.lds + cur * BUF) + hs * 64 * 136;
        const LAS f16* Vb = (const LAS f16*)(F.lds + cur * BUF + KB) + hs * 64 * 144;
        const int nsub = win ? 1 : 2;
#pragma unroll 1
        for (int sub = 0; sub < nsub; ++sub) {
            const int koff = win ? c0 : 32 * sub;
            f16x8 kf[2][4];
#pragma unroll
            for (int nt = 0; nt < 2; ++nt)
#pragma unroll
                for (int ks = 0; ks < 4; ++ks) kf[nt][ks] = *(const LAS f16x8*)(Kb + (koff + 16 * nt + fr) * 136 + 32 * ks + 8 * fq);
            f32x4 sacc[2];
#pragma unroll
            for (int nt = 0; nt < 2; ++nt) { sacc[nt] = (f32x4){0.f, 0.f, 0.f, 0.f};
#pragma unroll
                for (int ks = 0; ks < 4; ++ks) sacc[nt] = mfma16(kf[nt][ks], qf[ks], sacc[nt]); }
            float sv[8]; float bm = -INFINITY;
#pragma unroll
            for (int nt = 0; nt < 2; ++nt)
#pragma unroll
                for (int r = 0; r < 4; ++r) { const int kc = c0 + 16 * nt + 4 * fq + r; const bool valid = !win || (kc >= cs && kc < cs + 16);
                    const float x = valid ? sacc[nt][r] + (win ? bv[nt * 4 + r] : 0.f) : -INFINITY;
                    sv[nt * 4 + r] = x; bm = fmaxf(bm, x); }
            bm = fmaxf(bm, bperm_f(lane ^ 16, bm)); bm = fmaxf(bm, bperm_f(lane ^ 32, bm));
            const float m_new = fmaxf(m_run, bm), alpha = __expf(m_run - m_new);
            float ps = 0.f;
#pragma unroll
            for (int e = 0; e < 8; ++e) { sv[e] = __expf(sv[e] - m_new); ps += sv[e]; }
            ps += bperm_f(lane ^ 16, ps); ps += bperm_f(lane ^ 32, ps);
            l_run = l_run * alpha + ps; m_run = m_new;
            f16x8 pf;
#pragma unroll
            for (int e = 0; e < 8; ++e) pf[e] = (f16)sv[e];
            const LAS f16* vb = Vb + (koff + 4 * fq + (fr >> 2)) * 144 + 4 * (fr & 3);
#pragma unroll
            for (int dt = 0; dt < 8; ++dt) { oacc[dt] = oacc[dt] * alpha;
                const f16x4 alo = lds_tr4(vb + 16 * dt), ahi = lds_tr4(vb + 16 * 144 + 16 * dt);
                const f16x8 a = __builtin_shufflevector(alo, ahi, 0, 1, 2, 3, 4, 5, 6, 7);
                oacc[dt] = mfma16(a, pf, oacc[dt]); }
        }
        if (st + 1 < nstep) { if (par == 0) NA_STORE(preB, 1); else NA_STORE(preA, 0); }
        __syncthreads();
      }
    }
#undef NA_ROWBASE
#undef NA_LOAD
#undef NA_STORE
    const float inv = 1.0f / l_run;
    LAS f16* Ot = (LAS f16*)(F.lds + wave * 4352);
#pragma unroll
    for (int dt = 0; dt < 8; ++dt) { u32x2 w; w.x = pk_f16(oacc[dt][0] * inv, oacc[dt][1] * inv); w.y = pk_f16(oacc[dt][2] * inv, oacc[dt][3] * inv);
        *(LAS u32x2*)(Ot + fr * 136 + 16 * dt + 4 * fq) = w; }
    { const int row = lane >> 2, seg = lane & 3;
#pragma unroll
      for (int c = 0; c < 4; ++c) { const u32x4 w = *(const LAS u32x4*)(Ot + row * 136 + seg * 32 + c * 8);
          *(u32x4*)(Y + (size_t)(q0row + row) * BW + h * 128 + seg * 32 + c * 8) = w; } }
    __syncthreads();
}


__device__ __forceinline__ void mlstm_gate_scan(Frame& F, int li, int seq) {
    const int dir = seq & 1, h = (seq >> 1) & 3, b = seq >> 3, lane = F.lane;
    const float* G = WSP(float, WS_G); float* GS = WSP(float, WS_GS) + (size_t)seq * 36 * 320; float* GD = WSP(float, WS_GS + 3 * 512 * 1024) + seq * 36;
    const float bi_ = inp(14)[(li * 2 + dir) * 4 + h], bf_ = inp(15)[(li * 2 + dir) * 4 + h];
    float m_prev = -INFINITY;
#pragma unroll 1
    for (int j = 0; j < 36; ++j) {
        const bool isctx = j < 4; const int base = isctx ? ML + b * CTXL : b * SEQ, len = isctx ? CTXL : SEQ, off = isctx ? j * 64 : (j - 4) * 64;
        const int row = base + (dir ? len - 1 - (off + lane) : off + lane);
        const float igv = G[(size_t)row * 16 + dir * 8 + h] + bi_; const float fp = G[(size_t)row * 16 + dir * 8 + 4 + h] + bf_;
        float cum = fminf(fp, 0.f) - log1pf(expf(-fabsf(fp)));
#pragma unroll
        for (int d = 1; d < 64; d <<= 1) { const float t = bperm_f((lane - d) & 63, cum); if (lane >= d) cum += t; }
        const float a = igv - cum; float R = a;
#pragma unroll
        for (int d = 1; d < 64; d <<= 1) { const float t = bperm_f((lane - d) & 63, R); if (lane >= d) R = fmaxf(R, t); }
        R = fmaxf(R, m_prev);
        const float mrow = cum + R, m_new = __shfl(mrow, 63), cl = __shfl(cum, 63);
        float* o = GS + j * 320 + lane;
        o[0] = a; o[64] = R; o[128] = expf(m_prev - R); o[192] = expf(-mrow); o[256] = expf(cl + a - m_new);
        if (lane == 0) GD[j] = expf(cl + m_prev - m_new);
        m_prev = m_new;
    }
}


__device__ __forceinline__ void mlstm_unit5(Frame& F, int li, int unit, bool ctx_out) {
    const int vs = unit & 3, dir = (unit >> 2) & 1, h = (unit >> 3) & 3, b = unit >> 5, seq = unit >> 2;
    constexpr int QS = 0, KS = 33792, VS = 67584, SC = 78848, C16 = 88064, VEC = 130304, NVT = 5, VP = 88;
    LAS f16* Qs = (LAS f16*)(F.lds + QS); LAS f16* Ks = (LAS f16*)(F.lds + KS); LAS f16* Vs = (LAS f16*)(F.lds + VS);
    LAS f16* Sc = (LAS f16*)(F.lds + SC); LAS f16* Cs = (LAS f16*)(F.lds + C16);
    LAS float* gv = (LAS float*)(F.lds + VEC);
    LAS float* av = gv; LAS float* Rv = gv + 64; LAS float* interv = gv + 128; LAS float* eneg = gv + 192; LAS f16* w16 = (LAS f16*)(gv + 320); LAS float* misc = gv + 352;
    const f16* P = WSP(f16, WS_P); f16* HMD = WSP(f16, WS_HMD) + (size_t)dir * MT * BW;
    const float* GS = WSP(float, WS_GS) + (size_t)seq * 36 * 320; const float* GD = WSP(float, WS_GS + 3 * 512 * 1024) + seq * 36;
    const int lane = F.lane, wave = F.wave, fr = lane & 15, fq = lane >> 4, tid = F.tid;
    for (int i = tid; i < 80 * 264; i += 512) Cs[i] = (f16)0.f;
    for (int i = tid; i < 64 * 16; i += 512) Vs[(i >> 4) * VP + 64 + (i & 15)] = ((i & 15) == 0) ? (f16)1.f : (f16)0.f;
    f32x4 Cacc[NVT][2];
#pragma unroll
    for (int vt = 0; vt < NVT; ++vt)
#pragma unroll
        for (int nt = 0; nt < 2; ++nt) Cacc[vt][nt] = (f32x4){0.f, 0.f, 0.f, 0.f};
#define MROWJ(j, s) (((j) < 4 ? ML + b * CTXL : b * SEQ) + (dir ? ((j) < 4 ? CTXL : SEQ) - 1 - (((j) < 4 ? (j) * 64 : ((j) - 4) * 64) + (s)) : ((j) < 4 ? (j) * 64 : ((j) - 4) * 64) + (s)))
    f16x8 qreg[4], kreg[4], vreg; float greg = 0.f, dreg = 0.f;
#define ML_PREFETCH(j) do { \
        _Pragma("unroll") for (int it = 0; it < 4; ++it) { const int i_ = it * 512 + tid, s_ = i_ >> 5, c8_ = i_ & 31; const size_t ro_ = (size_t)MROWJ(j, s_) * LDP + h * 256 + c8_ * 8; \
            qreg[it] = *(const f16x8*)(P + ro_ + PQ); kreg[it] = *(const f16x8*)(P + ro_ + PK); } \
        vreg = *(const f16x8*)(P + (size_t)MROWJ(j, tid >> 3) * LDP + PV + h * 256 + vs * 64 + (tid & 7) * 8); \
        if (tid < 320) greg = GS[(j) * 320 + tid]; \
        if (tid == 320) dreg = GD[j]; } while (0)
    ML_PREFETCH(0);
    __syncthreads();
#pragma unroll 1
    for (int j = 0; j < 36; ++j) {
        const bool isctx = j < 4;
#pragma unroll
        for (int it = 0; it < 4; ++it) { const int i = it * 512 + tid, s = i >> 5, c8 = i & 31;
            *(LAS f16x8*)(Qs + s * 264 + c8 * 8) = qreg[it]; *(LAS f16x8*)(Ks + s * 264 + c8 * 8) = kreg[it]; }
        *(LAS f16x8*)(Vs + (tid >> 3) * VP + (tid & 7) * 8) = vreg;
        if (tid < 320) { gv[tid] = greg; if (tid >= 256) w16[tid - 256] = (f16)greg; }
        if (tid == 320) misc[0] = dreg;
        __syncthreads();
        if (j + 1 < 36) ML_PREFETCH(j + 1);
        const bool need_out = !isctx || ctx_out;
        f32x4 nacc[NVT];
        if (need_out) {
            if (wave >= 4) {
                const int i = wave - 4; f32x4 sacc[4];
#pragma unroll
                for (int st = 0; st < 4; ++st) sacc[st] = (f32x4){0.f, 0.f, 0.f, 0.f};
#pragma unroll
                for (int ks = 0; ks < 8; ++ks) { const f16x8 a = *(const LAS f16x8*)(Qs + (16 * i + fr) * 264 + 32 * ks + 8 * fq);
#pragma unroll
                    for (int st = 0; st < 4; ++st) { const f16x8 bq = *(const LAS f16x8*)(Ks + (16 * st + fr) * 264 + 32 * ks + 8 * fq); sacc[st] = mfma16(a, bq, sacc[st]); } }
                const f32x4 Rt = *(const LAS f32x4*)(Rv + 16 * i + 4 * fq);
#pragma unroll
                for (int st = 0; st < 4; ++st) { const int sidx = 16 * st + fr; const float as = av[sidx];
#pragma unroll
                    for (int r = 0; r < 4; ++r) { const int t = 16 * i + 4 * fq + r; const float e = __expf(fminf(as - Rt[r], 0.f)); const float msk = sidx <= t ? 1.f : 0.f;
                        Sc[t * 72 + sidx] = (f16)(sacc[st][r] * msk * e); } }
            } else {
                const int i = wave;
#pragma unroll
                for (int vt = 0; vt < NVT; ++vt) nacc[vt] = (f32x4){0.f, 0.f, 0.f, 0.f};
#pragma unroll
                for (int ks = 0; ks < 8; ++ks) { const f16x8 a = *(const LAS f16x8*)(Qs + (16 * i + fr) * 264 + 32 * ks + 8 * fq);
#pragma unroll
                    for (int vt = 0; vt < NVT; ++vt) { const f16x8 bc = *(const LAS f16x8*)(Cs + (16 * vt + fr) * 264 + 32 * ks + 8 * fq); nacc[vt] = mfma16(a, bc, nacc[vt]); } }
#pragma unroll
                for (int r = 0; r < 4; ++r) { const float sc_ = interv[16 * i + 4 * fq + r];
#pragma unroll
                    for (int vt = 0; vt < NVT; ++vt) nacc[vt][r] *= sc_; }
            }
        }
        __syncthreads();
        f16x8 vf[2][NVT];
#pragma unroll
        for (int k2 = 0; k2 < 2; ++k2)
#pragma unroll
            for (int vt = 0; vt < NVT; ++vt) { const LAS f16* p = Vs + (32 * k2 + 8 * fq + (fr >> 2)) * VP + 16 * vt + 4 * (fr & 3);
                const f16x4 lo = lds_tr4(p), hi = lds_tr4(p + 4 * VP); vf[k2][vt] = __builtin_shufflevector(lo, hi, 0, 1, 2, 3, 4, 5, 6, 7); }
        if (need_out && wave < 4) {
            const int i = wave;
#pragma unroll
            for (int k2 = 0; k2 < 2; ++k2) { const f16x8 a = *(const LAS f16x8*)(Sc + (16 * i + fr) * 72 + 32 * k2 + 8 * fq);
#pragma unroll
                for (int vt = 0; vt < NVT; ++vt) nacc[vt] = mfma16(a, vf[k2][vt], nacc[vt]); }
#pragma unroll
            for (int r = 0; r < 4; ++r) { const int t = 16 * i + 4 * fq + r; const float dn = __shfl(nacc[4][r], lane & 48); const float inv = __builtin_amdgcn_rcpf(fmaxf(fabsf(dn), eneg[t]));
                f16* hp = HMD + (size_t)MROWJ(j, t) * BW + h * 256 + vs * 64 + fr;
                hp[0] = (f16)(nacc[0][r] * inv); hp[16] = (f16)(nacc[1][r] * inv); hp[32] = (f16)(nacc[2][r] * inv); hp[48] = (f16)(nacc[3][r] * inv); }
        }
        { const float decay = misc[0];
#pragma unroll
          for (int vt = 0; vt < NVT; ++vt)
#pragma unroll
              for (int nt = 0; nt < 2; ++nt) Cacc[vt][nt] = Cacc[vt][nt] * decay;
#pragma unroll
          for (int k2 = 0; k2 < 2; ++k2) { const f16x8 wf = *(const LAS f16x8*)(w16 + 32 * k2 + 8 * fq);
#pragma unroll
              for (int nt = 0; nt < 2; ++nt) { const LAS f16* p = Ks + (32 * k2 + 8 * fq + (fr >> 2)) * 264 + 32 * wave + 16 * nt + 4 * (fr & 3);
                  const f16x4 lo = lds_tr4(p), hi = lds_tr4(p + 4 * 264); const f16x8 bk = __builtin_shufflevector(lo, hi, 0, 1, 2, 3, 4, 5, 6, 7);
#pragma unroll
                  for (int vt = 0; vt < NVT; ++vt) Cacc[vt][nt] = mfma16(vf[k2][vt] * wf, bk, Cacc[vt][nt]); } }
#pragma unroll
          for (int vt = 0; vt < NVT; ++vt)
#pragma unroll
              for (int nt = 0; nt < 2; ++nt)
#pragma unroll
                  for (int r = 0; r < 4; ++r) Cs[(16 * vt + 4 * fq + r) * 264 + 32 * wave + 16 * nt + fr] = (f16)Cacc[vt][nt][r]; }
        __syncthreads();
    }
#undef MROWJ
#undef ML_PREFETCH
}

__device__ __forceinline__ void phase_finish(int li_v) {
    Frame F = make_frame(); const int li = UNI(li_v); const int M = li == DEPTH - 1 ? ML : MT;
    const int gw = F.bid * 8 + F.wave, NGW = F.G * 8;
    const f16* P = WSP(f16, WS_P); const f16* HMD = WSP(f16, WS_HMD); const float* HL = WSP(float, WS_PART); f16* Y = WSP(f16, WS_Y);
    const float* gn = inp(16) + (size_t)li * BW;
    for (int row = gw; row < M; row += NGW) {
#pragma unroll
        for (int hh = 0; hh < 4; ++hh) { const int c = hh * 256 + 4 * F.lane;
            const f16x4 a = *(const f16x4*)(HMD + (size_t)row * BW + c), bq = *(const f16x4*)(HMD + ((size_t)MT + row) * BW + c);
            const f32x4 s = (f32x4){(float)a[0] + (float)bq[0], (float)a[1] + (float)bq[1], (float)a[2] + (float)bq[2], (float)a[3] + (float)bq[3]}; const float ss = wave_sum((s.x * s.x + s.y * s.y) + (s.z * s.z + s.w * s.w), F.lane);
            const float rstd = rsqrtf(ss * (1.0f / 256.0f) + EPS);
            const f16x4 og = *(const f16x4*)(P + (size_t)row * LDP + PO + c); const f32x4 g = *(const f32x4*)(gn + c);
            u32x2 w; w.x = pk_f16((float)og[0] * s.x * rstd * g.x, (float)og[1] * s.y * rstd * g.y); w.y = pk_f16((float)og[2] * s.z * rstd * g.z, (float)og[3] * s.w * rstd * g.w);
            *(u32x2*)(Y + (size_t)row * BW + c) = w; }
    }
}

constexpr int REP_MIX = 1, REP_L1 = 1, REP_NA = 1, REP_ML = 1; constexpr int REP_GATE = 1, REP_RES = 1, REP_BAR = 0; constexpr int REP_PRO = 1, REP_G1 = 1, REP_G3 = 1, REP_ADALN = 1, REP_LRU0 = 1, REP_FIN = 1;
constexpr int NPL = 13, PH_FINAL = 1 + DEPTH * NPL, NPHASE = PH_FINAL + 1;
__device__ __forceinline__ void ph_gemm_swiglu(int li_v, int which_v) {
    Frame F = make_frame(); const int li = UNI(li_v), which = UNI(which_v);
    unsigned char* wl = F.ws + WS_W + (size_t)li * WL_SIZE; const int M = (which == 1 && li == DEPTH - 1) ? ML : MT;
    pg8::Gemm g{WSP(f16, WS_H), (const f16*)(wl + (which ? WL_W3 : WL_W1)), M, 2 * DFF, D, D}; pg8::StaticOrder S; S.init(M, 2 * DFF, F.G, F.bid);
    EpiSwiGLU E{WSP(f16, WS_P)}; pg8::gemm_phase<EpiSwiGLU, pg8::StaticOrder, true, true>(F.lds, g, S, E, F.tid);
}
__device__ __forceinline__ void ph_gemm_resid(int li_v, int which_v, float cmul = 1.0f) {
    Frame F = make_frame(); const int li = UNI(li_v), which = UNI(which_v);
    unsigned char* wl = F.ws + WS_W + (size_t)li * WL_SIZE;
    const float* modl = WSP(float, WS_MOD) + (size_t)li * 5 * NMODC + (2 + 3 * which) * D;
    const f16* A = which == 1 ? WSP(f16, WS_MH) : WSP(f16, WS_P); const f16* Bt = (const f16*)(wl + (which == 0 ? WL_W2 : which == 1 ? WL_WOUT : WL_W4));
    const int K = which == 1 ? D : DFF;
    pg8::Gemm g{A, Bt, ML, D, K, K}; pg8::StaticOrder S; S.init(ML, D, F.G, F.bid);
    const bool first = li == 0 && which == 0;
    EpiResid E{WSP(f16, WS_X), modl, which == 1 ? 0 : 1, first ? inp(0) : nullptr}; pg8::gemm_phase<EpiResid, pg8::StaticOrder, true, true>(F.lds, g, S, E, F.tid);
}
__device__ __forceinline__ void ph_gemm_resid_ctx(int li_v, int which_v) {
    Frame F = make_frame(); const int li = UNI(li_v), which = UNI(which_v);
    if (which >= 1 && li == DEPTH - 1) return;
    unsigned char* wl = F.ws + WS_W + (size_t)li * WL_SIZE;
    const float* modl = WSP(float, WS_MOD) + (size_t)li * 5 * NMODC + (2 + 3 * which) * D;
    const f16* A = which == 1 ? WSP(f16, WS_MH) : WSP(f16, WS_P); const f16* Bt = (const f16*)(wl + (which == 0 ? WL_W2 : which == 1 ? WL_WOUT : WL_W4));
    const int K = which == 1 ? D : DFF;
    pg8::Gemm g{A, Bt, MT, D, K / 4, K}; pg8::CtxSplitOrder S{F.bid, F.G};
    EpiResidPart E{WSP(float, WS_PART), modl, which == 1 ? 1.0f : 0.5f}; pg8::gemm_phase<EpiResidPart, pg8::CtxSplitOrder, false, true>(F.lds, g, S, E, F.tid);
}
__device__ __forceinline__ void ph_gemm_proj(int li_v) {
    Frame F = make_frame(); const int li = UNI(li_v);
    unsigned char* wl = F.ws + WS_W + (size_t)li * WL_SIZE;
    pg8::Gemm g{WSP(f16, WS_H), (const f16*)(wl + WL_WIN), MT, NPIN, D, D};
    EpiProj E{WSP(f16, WS_P), WSP(float, WS_G), WSP(float, WS_ROPE)};
    if (li == DEPTH - 1) { pg8::ProjLastOrder S{F.G, F.bid}; pg8::gemm_phase<EpiProj, pg8::ProjLastOrder, true, true>(F.lds, g, S, E, F.tid); }
    else { pg8::StaticOrder S; S.init(MT, NPIN, F.G, F.bid); pg8::gemm_phase<EpiProj, pg8::StaticOrder, true, true>(F.lds, g, S, E, F.tid); }
}
template <int MODE, int BR> __device__ __forceinline__ void ph_gemm_gate(int li_v) {
    Frame F = make_frame(); const int li = UNI(li_v);
    unsigned char* wl = F.ws + WS_W + (size_t)li * WL_SIZE; const int M = li == DEPTH - 1 ? ML : MT;
    const f16* Y = WSP(f16, WS_Y) + (size_t)BR * MT * BW; const f16* wbr = (const f16*)(wl + WL_WBR) + (size_t)BR * D * BW; const f16* gate = WSP(f16, WS_P) + GX + BR * D;
    pg8::Gemm g{Y, wbr, M, D, BW, BW}; pg8::StaticOrder S; S.init(M, D, F.G, F.bid);
    EpiGate<MODE> E{gate, WSP(f16, WS_MH)}; pg8::gemm_phase<EpiGate<MODE>, pg8::StaticOrder, true, true>(F.lds, g, S, E, F.tid);
}
__device__ __forceinline__ void phase_lru_p0(int li_v) {
    Frame F = make_frame(); const int li = UNI(li_v);
    if (F.G >= 64) {
        if (F.bid < 4) mlstm_gate_scan(F, li, F.bid * 8 + F.wave);
        else if (F.bid >= 8) { F.bid -= 8; F.G -= 8; lru_block<0>(F, li, false); }
    } else { if (F.bid * 8 + F.wave < 32) mlstm_gate_scan(F, li, F.bid * 8 + F.wave); __syncthreads(); lru_block<0>(F, li, false); }
}
#ifndef MIXSEL
#define MIXSEL 7
#endif
__device__ __forceinline__ void ph_mix_mlstm(int li_v) {
    Frame F = make_frame(); const int li = UNI(li_v); const bool last = li == DEPTH - 1; const int half = F.G >> 1;
    if (F.bid >= half) return;
    for (int rep = 0; rep < REP_ML; ++rep) for (int u = F.bid; u < 128; u += half) { mlstm_unit5(F, li, u, !last); __syncthreads(); }
}
__device__ __forceinline__ void ph_mix_na(int li_v) {
    Frame F = make_frame(); const int li = UNI(li_v); const bool last = li == DEPTH - 1; const int half = F.G >> 1;
    if (F.bid < half) return;
    F.bid -= half; F.G -= half;
    int staged_hp = -1;
    for (int rep = 0; rep < REP_NA; ++rep) { const int nna = last ? 512 : 576;
      for (int it = F.bid; it < nna; it += F.G) { const bool lat = it < 512; const int x = lat ? it : it - 512;
          const int hp = x & 3, rr = lat ? (x >> 2) & 31 : (x >> 2) & 3, b = lat ? x >> 7 : x >> 4;
          na_item(F, li, lat, b, rr, hp, staged_hp); }
      __syncthreads(); }
}
__device__ __forceinline__ void ph_mix_lru(int li_v) {
    Frame F = make_frame(); const int li = UNI(li_v); const bool last = li == DEPTH - 1; const int half = F.G >> 1;
    const int total = last ? 4 * 8 * 8 : 4 * 12 * 8, nu = total;
    if (F.bid < half) { F.G = half; for (int rep = 0; rep < REP_L1; ++rep) lru_fix_block(F, li, last, nu, total); }
    else { F.bid -= half; F.G -= half; for (int rep = 0; rep < REP_L1; ++rep) lru_fix_block(F, li, last, 0, nu); }
}
__device__ __forceinline__ void ph_mixers(int li_v) { ph_mix_mlstm(li_v); __syncthreads(); ph_mix_na(li_v); __syncthreads(); ph_mix_lru(li_v); }

__global__ void __launch_bounds__(512, 2) mega_fwd(Args args) {
    LAS unsigned char* lds = (LAS unsigned char*)lds_raw;
    const int tid = threadIdx.x;
    volatile LAS unsigned* MISC = (volatile LAS unsigned*)(lds + LDS_MISC);
    if (tid < 64) MISC[tid] = 0u;
    __syncthreads();
    unsigned* barw = (unsigned*)(args.ws + WS_CTL) + 4096;
    XcdBarrier bar; bar.bar = barw; bar.x = 0; bar.st = nullptr;
    const int lo = args.ph_lo, hi = args.ph_hi;
    if (hi - lo > 1) bar = xcd_barrier_post(barw, MISC + 8);
#define IN(k) (lo <= (k) && (k) < hi && ((PHSEL >> ((k) == 0 ? 16 : (k) == PH_FINAL ? 17 : ((k) - 1) % NPL)) & 1))
#if TPROBE
    volatile LAS unsigned long long* TACC = (volatile LAS unsigned long long*)(lds + LDS_MISC + 128);
    const bool tprobe = blockIdx.x == 0 && tid == 0;
    if (tprobe) { TACC[0] = 0ull; TACC[1] = 0ull; }
#define TBEG() do { if (tprobe) TACC[2] = __builtin_amdgcn_s_memrealtime(); } while (0)
#define TEND(g) do { if (tprobe) TACC[g] = TACC[g] + (__builtin_amdgcn_s_memrealtime() - TACC[2]); } while (0)
#else
#define TBEG() do {} while (0)
#define TEND(g) do {} while (0)
#endif
#define SEAM(k) do { if (lo <= (k) && (k) + 1 < hi) { TBEG(); xcd_barrier(bar); TEND(1); } } while (0)
    if (IN(0)) for (int rep = 0; rep < REP_PRO; ++rep) { phase_prologue(); __syncthreads(); }
    SEAM(0);
#pragma unroll 1
    for (int li = 0; li < DEPTH; ++li) {
        const int p0 = 1 + li * NPL;
        if (IN(p0 + 0)) phase_adaln(li, 0);
        SEAM(p0 + 0); for (int rep = 0; rep < REP_BAR; ++rep) SEAM(p0 + 0);
        TBEG();
        if (IN(p0 + 1)) { ph_gemm_swiglu(li, 0); __syncthreads(); ph_convert_idle(36 * 44, 6, li == 0 ? CS1 : CT1); }
        if (IN(p0 + 1)) TEND(0);
        SEAM(p0 + 1);
        TBEG();
        if (IN(p0 + 2)) { ph_gemm_resid(li, 0); ph_gemm_resid_ctx(li, 0); __syncthreads(); ph_convert_idle(128, 3, li == 0 ? CS2 : CT2); }
        if (IN(p0 + 2)) TEND(0);
        SEAM(p0 + 2);
        if (IN(p0 + 3)) phase_adaln(li, 1);
        SEAM(p0 + 3);
        TBEG();
        if (IN(p0 + 4)) { ph_gemm_proj(li); __syncthreads(); if (li == 0) ph_convert_idle(36 * 61, 6, CS3); }
        if (IN(p0 + 4)) TEND(0);
        SEAM(p0 + 4);
        if (IN(p0 + 5)) for (int rep = 0; rep < REP_LRU0; ++rep) { phase_lru_p0(li); __syncthreads(); }
        SEAM(p0 + 5);
        if (IN(p0 + 6)) for (int rep = 0; rep < REP_MIX; ++rep) { ph_mixers(li); __syncthreads(); }
        SEAM(p0 + 6);
        TBEG();
        if (IN(p0 + 7)) { phase_finish(li); __syncthreads(); ph_gemm_gate<0, 1>(li); ph_gemm_gate<1, 2>(li); __syncthreads(); if (li == 0) ph_convert_idle(288, 6, CS4); }
        if (IN(p0 + 7)) TEND(0);
        SEAM(p0 + 7);
        TBEG();
        if (IN(p0 + 8)) { ph_gemm_gate<2, 0>(li); __syncthreads(); if (li == 0) ph_convert_idle(288, 3, CS5); }
        if (IN(p0 + 8)) TEND(0);
        SEAM(p0 + 8);
        TBEG();
        if (IN(p0 + 9)) { ph_gemm_resid(li, 1); ph_gemm_resid_ctx(li, 1); __syncthreads(); if (li == 0) ph_convert_idle(128, 3, CS6); }
        if (IN(p0 + 9)) TEND(0);
        SEAM(p0 + 9);
        if (IN(p0 + 10)) { phase_adaln(li, 2); if (li == DEPTH - 1) { __syncthreads(); ph_convert_all(CT3, CO_W3END); } }
        SEAM(p0 + 10);
        TBEG();
        if (IN(p0 + 11)) { ph_gemm_swiglu(li, 1); __syncthreads(); if (li == 0) ph_convert_idle(36 * 44, 6, CS7); else ph_convert_idle(32 * 44, 6, CO_W3END); }
        if (IN(p0 + 11)) TEND(0);
        SEAM(p0 + 11);
        TBEG();
        if (IN(p0 + 12)) { ph_gemm_resid(li, 2); ph_gemm_resid_ctx(li, 2); __syncthreads(); if (li == 0) ph_convert_idle(128, 3, CS8); }
        if (IN(p0 + 12)) TEND(0);
        SEAM(p0 + 12);
    }
#if TPROBE
    if (tprobe) { float* tp = (float*)(args.ws + WS_CTL) + 2048; tp[0] = (float)TACC[0] * 1e-8f; tp[1] = (float)TACC[1] * 1e-8f; __builtin_amdgcn_fence(__ATOMIC_RELEASE, "agent"); }
    __syncthreads(); xcd_barrier(bar);
#endif
    if (IN(PH_FINAL)) phase_final();
#undef IN
#undef SEAM
}

extern "C" void kernel_launch(void* const* d_in, const int* in_sizes, int n_in, void* d_out, int out_size, void* d_ws, size_t ws_size, hipStream_t stream) {
    static int grid = 0;
    if (grid == 0) {
        if (n_in != 28 || ws_size < WS_END) { fprintf(stderr, "kernel_launch: unexpected n_in %d or ws_size %zu (< %zu)\n", n_in, ws_size, (size_t)WS_END); grid = -1; return; }
        int dev = 0, cus = 0, per_cu = 0;
        if (hipGetDevice(&dev) != hipSuccess || hipDeviceGetAttribute(&cus, hipDeviceAttributeMultiprocessorCount, dev) != hipSuccess) { grid = -1; return; }
        if (hipFuncSetAttribute((const void*)mega_fwd, hipFuncAttributeMaxDynamicSharedMemorySize, LDS_BYTES) != hipSuccess) { fprintf(stderr, "kernel_launch: hipFuncSetAttribute failed\n"); grid = -1; return; }
        if (hipOccupancyMaxActiveBlocksPerMultiprocessor(&per_cu, (const void*)mega_fwd, 512, LDS_BYTES) != hipSuccess || per_cu < 1) fprintf(stderr, "kernel_launch: occupancy query says %d\n", per_cu);
        (void)hipGetLastError();
        grid = cus;
    }
    if (grid < 0) return;
    (void)hipMemsetAsync((char*)d_ws + WS_CTL + 16384, 0, 16384, stream);
    Args a{};
    for (int i = 0; i < 28; ++i) a.in[i] = (const float*)d_in[i];
    a.out = (float*)d_out; a.ws = (unsigned char*)d_ws;
#if MK_ONE_LAUNCH
    a.ph_lo = 0; a.ph_hi = NPHASE;
    hipLaunchKernelGGL(mega_fwd, dim3(grid), dim3(512), LDS_BYTES, stream, a);
#else
    for (int p = 0; p < NPHASE; ++p) { a.ph_lo = p; a.ph_hi = p + 1; hipLaunchKernelGGL(mega_fwd, dim3(grid), dim3(512), LDS_BYTES, stream, a); }
#endif
}
```

```cpp
#include <hip/hip_runtime.h>
#include <cstdio>
#include <cstdint>

#define LAS __attribute__((address_space(3)))
typedef _Float16 f16;
typedef _Float16 f16x8 __attribute__((ext_vector_type(8)));
typedef _Float16 f16x4 __attribute__((ext_vector_type(4)));
typedef _Float16 f16x2 __attribute__((ext_vector_type(2)));
typedef float f32x4 __attribute__((ext_vector_type(4)));
typedef float f32x2 __attribute__((ext_vector_type(2)));
typedef unsigned u32x4 __attribute__((ext_vector_type(4)));
typedef unsigned u32x2 __attribute__((ext_vector_type(2)));

#ifndef PHSEL
#define PHSEL 0xFFFFF
#endif
#ifndef TPROBE
#define TPROBE 0
#endif
#ifndef MK_ONE_LAUNCH
#define MK_ONE_LAUNCH 1
#endif

constexpr int D = 2048, NB = 4, SEQ = 2048, CTXL = 256, DEPTH = 2, DFF = 5632, BW = 1024;
constexpr int ML = NB * SEQ, MC = NB * CTXL, MT = ML + MC;
constexpr int NMODC = 9 * D;
constexpr int PIN_SRC = 15376;
constexpr int NPIN = 15616;
constexpr int LDP = 15360;
constexpr int PQ = 0, PK = 1024, PV = 2048, PO = 3072, NQ = 4096, NK = 5120, NV = 6144, LX = 7168, LG = 8192, GX = 9216;
constexpr float EPS = 1e-6f;

constexpr size_t MiB = 1u << 20;
constexpr size_t WS_CTL = 0;
constexpr size_t WS_MOD = 1 * MiB;
constexpr size_t WS_ROPE = 2 * MiB;
constexpr size_t WS_G = 3 * MiB;
constexpr size_t WS_W = 4 * MiB;
constexpr size_t WL_W1 = 0, WL_W2 = 44 * MiB, WL_W3 = 66 * MiB, WL_W4 = 110 * MiB, WL_WIN = 132 * MiB, WL_WBR = 193 * MiB, WL_WOUT = 205 * MiB, WL_SIZE = 213 * MiB;
constexpr size_t WS_X = WS_W + 2 * WL_SIZE;
constexpr size_t WS_H = WS_X + 72 * MiB;
constexpr size_t WS_P = WS_H + 36 * MiB;
constexpr size_t WS_Y = WS_P + 270 * MiB;
constexpr size_t WS_HMD = WS_Y + 54 * MiB;
constexpr size_t WS_MH = WS_HMD + 72 * MiB;
constexpr size_t WS_PART = WS_MH + 36 * MiB;
constexpr size_t WS_WLRU = WS_PART + 32 * MiB;
constexpr size_t WS_LSUM = WS_WLRU + 2 * MiB;
constexpr size_t WS_GS = WS_LSUM + 3 * MiB;
constexpr size_t WS_LH = WS_GS + 2 * MiB;
constexpr size_t WS_LAC = WS_LH + 36 * MiB;
constexpr size_t WS_END = WS_LAC + 36 * MiB;

constexpr int LDS_BYTES = 147456;
constexpr int LDS_MISC = 147200;

__device__ __forceinline__ unsigned pk_f16(float lo, float hi) { f32x2 v = {lo, hi}; f16x2 h = __builtin_convertvector(v, f16x2); return __builtin_bit_cast(unsigned, h); }
__device__ __forceinline__ float bperm_f(int srclane, float v) { return __builtin_bit_cast(float, __builtin_amdgcn_ds_bpermute(srclane << 2, __builtin_bit_cast(int, v))); }
template <int CTRL> __device__ __forceinline__ float dpp_f(float v) { return __builtin_bit_cast(float, __builtin_amdgcn_update_dpp(0, __builtin_bit_cast(int, v), CTRL, 0xF, 0xF, true)); }
__device__ __forceinline__ float wave_sum(float v, int lane) {
    v += dpp_f<0xB1>(v); v += dpp_f<0x4E>(v); v += dpp_f<0x141>(v); v += dpp_f<0x140>(v);
    v += bperm_f(lane ^ 16, v); v += bperm_f(lane ^ 32, v);
    return v;
}
__device__ __forceinline__ float sigmoidf_(float x) { return __builtin_amdgcn_rcpf(1.0f + __expf(-x)); }
__device__ __forceinline__ float siluf_(float x) { return x * __builtin_amdgcn_rcpf(1.0f + __expf(-x)); }
__device__ __forceinline__ float gelu_tanh_(float x) { const float z = 0.7978845608028654f * (x + 0.044715f * x * x * x); const float e = __expf(2.0f * z); return 0.5f * x * (1.0f + (1.0f - 2.0f * __builtin_amdgcn_rcpf(e + 1.0f))); }
#define LDS_WAIT() asm volatile("s_waitcnt lgkmcnt(0)" ::: "memory")
__device__ __forceinline__ f32x4 mfma16(f16x8 a, f16x8 b, f32x4 c) { return __builtin_amdgcn_mfma_f32_16x16x32_f16(a, b, c, 0, 0, 0); }

typedef __fp16 fp16x4v __attribute__((__vector_size__(8)));
__device__ __forceinline__ f16x4 lds_tr4(const LAS f16* p) { return __builtin_bit_cast(f16x4, __builtin_amdgcn_ds_read_tr16_b64_v4f16((LAS fp16x4v*)p)); }

#define XB_TMO      128
#define XB_XCNT(j)  (256  + 64 * (j))
#define XB_XSUB(j)  (1280 + 64 * (j))
#define XB_XGEN(j)  (2304 + 64 * (j))
#define XB_TOP      3328
#define XB_TOPGEN   3392
#define XCD_BAR_WORDS 3456
#define XB_SPIN_CAP (1u << 25)
__device__ __forceinline__ unsigned xb_ld(unsigned* p)              { return __hip_atomic_load(p, __ATOMIC_RELAXED, __HIP_MEMORY_SCOPE_AGENT); }
__device__ __forceinline__ unsigned xb_add(unsigned* p, unsigned v) { return __hip_atomic_fetch_add(p, v, __ATOMIC_RELAXED, __HIP_MEMORY_SCOPE_AGENT); }
__device__ __forceinline__ unsigned xb_xcc_id() { return (unsigned)__builtin_amdgcn_s_getreg((3 << 11) | 20) & 0xFu; }
#define XB_SPIN(cond, bar) do { unsigned _sp = 0; while (cond) { __builtin_amdgcn_s_sleep(1); \
    if ((++_sp & 255u) == 0u) { if (xb_ld(&(bar)[XB_TMO])) break; if (_sp > XB_SPIN_CAP) { atomicAdd(&(bar)[XB_TMO], 1u); break; } } } } while (0)
struct XcdBarrier { unsigned* bar; unsigned x; volatile LAS unsigned* st; };
__device__ __forceinline__ XcdBarrier xcd_barrier_post(unsigned* bar, volatile LAS unsigned* st) {
    XcdBarrier b; b.bar = bar; b.x = xb_xcc_id(); b.st = st;
    if (threadIdx.x == 0) (void)xb_add(&bar[XB_XCNT(b.x)], 1u);
    return b;
}
__device__ __forceinline__ void xcd_barrier_complete(unsigned* bar, unsigned x, unsigned& nloc, unsigned& nx) {
    const unsigned G = gridDim.x * gridDim.y * gridDim.z;
    unsigned sum, cnt, mine, sp = 0u;
    for (;;) {
        sum = 0u; cnt = 0u; mine = 0u;
#pragma unroll
        for (unsigned j = 0; j < 16; ++j) { const unsigned c = xb_ld(&bar[XB_XCNT(j)]); sum += c; cnt += (c > 0u) ? 1u : 0u; mine = (j == x) ? c : mine; }
        if (sum == G) break;
        __builtin_amdgcn_s_sleep(1);
        if ((++sp & 255u) == 0u) { if (xb_ld(&bar[XB_TMO])) break; if (sp > XB_SPIN_CAP) { atomicAdd(&bar[XB_TMO], 1u); break; } }
    }
    nloc = mine > 0u ? mine : 1u; nx = cnt > 0u ? cnt : 1u;
}
__device__ __forceinline__ void xcd_barrier(const XcdBarrier& b) {
    asm volatile("s_waitcnt vmcnt(0)" ::: "memory");
    __syncthreads();
    if (threadIdx.x == 0) {
        unsigned* bar = b.bar;
        __builtin_amdgcn_s_waitcnt(0);
        unsigned nloc = b.st[0], nx = b.st[1];
        if (nloc == 0u) { xcd_barrier_complete(bar, b.x, nloc, nx); b.st[0] = nloc; b.st[1] = nx; }
        const unsigned old = xb_add(&bar[XB_XSUB(b.x)], 1u);
        const unsigned gen = old / nloc;
        if (old + 1u == (gen + 1u) * nloc) {
            __builtin_amdgcn_fence(__ATOMIC_RELEASE, "agent");
            asm volatile("s_waitcnt vmcnt(0)" ::: "memory");
            const unsigned og = xb_add(&bar[XB_TOP], 1u);
            const unsigned tg = og / nx;
            if (og + 1u == (tg + 1u) * nx) xb_add(&bar[XB_TOPGEN], 1u);
            else XB_SPIN(xb_ld(&bar[XB_TOPGEN]) == tg, bar);
            __builtin_amdgcn_fence(__ATOMIC_ACQUIRE, "agent");
            xb_add(&bar[XB_XGEN(b.x)], 1u);
            asm volatile("s_waitcnt vmcnt(0)" ::: "memory");
        } else {
            XB_SPIN(xb_ld(&bar[XB_XGEN(b.x)]) == gen, bar);
            __builtin_amdgcn_fence(__ATOMIC_ACQUIRE, "agent");
            asm volatile("s_waitcnt vmcnt(0)" ::: "memory");
        }
    }
    __syncthreads();
}

namespace pg8 {
constexpr int BM = 256, BK = 64, HALF = 128, HTB = HALF * BK * 2, STAGE_BYTES = 8 * HTB, NXCD = 8, WGM = 4;
__host__ __device__ __forceinline__ int lds_byte(int r, int c) { const int st = (r >> 4) * 2 + (c >> 5), rr = r & 15, cc = c & 31, ob = rr * 64 + cc * 2; return st * 1024 + (ob ^ (((ob >> 9) & 1) << 5)); }
__host__ __device__ __forceinline__ void stage_rc(int b, int& R, int& C) { const int st = b / 1024, sb = b % 1024, swz = sb ^ (((sb >> 9) & 1) << 5); R = (st >> 1) * 16 + swz / 64; C = (st & 1) * 32 + (swz % 64) / 2; }
__host__ __device__ __forceinline__ int perm32(int rho) { const int n = rho >> 4, i = rho & 15; return 8 * (i >> 2) + 4 * n + (i & 3); }
struct Unit { int pm, pn, kp; };
struct Gemm { const f16* A; const f16* Bt; int M, N, K, ld; };
struct StaticOrder {
    int nM, nN, nwg, G, c;
    __host__ __device__ void init(int M, int N, int G_, int c_) { nM = M / BM; nN = N / BM; nwg = nM * nN; G = G_; c = c_; }
    __host__ __device__ bool next(int i, Unit& u) const {
        const long L = (long)i * G + c; if (L >= nwg) return false;
        int wgid = (int)L; { const int q = nwg / NXCD, r = nwg % NXCD, xcd = wgid % NXCD, off = wgid / NXCD; wgid = (xcd < r ? xcd * (q + 1) : r * (q + 1) + (xcd - r) * q) + off; }
        const int nig = WGM * nN, gid = wgid / nig, fm = gid * WGM, gsz = (nM - fm) < WGM ? (nM - fm) : WGM;
        u.pm = fm + ((wgid % nig) % gsz); u.pn = (wgid % nig) / gsz; u.kp = 0; return true;
    }
    __device__ __forceinline__ void a_ready(const Unit&) const {}
    __device__ __forceinline__ void done(const Unit&) const {}
};
struct ProjLastOrder {
    int G, c;
    __device__ bool next(int i, Unit& u) const {
        const int L = i * G + c; u.kp = 0;
        if (L < 32 * 61) { const int w = (L % NXCD) * (32 * 61 / NXCD) + L / NXCD;
            const int grp = w / (WGM * 61), rem = w % (WGM * 61); u.pm = grp * WGM + rem % WGM; u.pn = rem / WGM; return true; }
        const int x = L - 32 * 61; if (x >= 4 * 21) return false;
        u.pm = 32 + (x & 3); const int t = x >> 2; u.pn = t < 8 ? 4 + t : (t < 20 ? 20 + (t - 8) : 60); return true;
    }
    __device__ __forceinline__ void a_ready(const Unit&) const {}
    __device__ __forceinline__ void done(const Unit&) const {}
};
struct CtxSplitOrder {
    int c, G;
    __device__ bool next(int i, Unit& u) const { const int L = i * G + c; if (L >= 128) return false; u.kp = L & 3; const int t = L >> 2; u.pm = 32 + (t >> 3); u.pn = t & 7; return true; }
    __device__ __forceinline__ void a_ready(const Unit&) const {}
    __device__ __forceinline__ void done(const Unit&) const {}
};
template <class Epi, class Sched, bool ALIGN_EPI = false, bool SP2 = false>
__device__ __forceinline__ void gemm_phase(LAS unsigned char* lds, const Gemm g, const Sched& S, const Epi& E, const int tid) {
    const int wid = __builtin_amdgcn_readfirstlane(tid >> 6), lane = tid & 63, wr = wid >> 2, wc = wid & 3, fr = lane & 15, fq = lane >> 4;
    const int K = g.K, nt = K / BK;
    unsigned voffA[2], voffB[2];
#pragma unroll
    for (int i = 0; i < 2; ++i) { int R, C; stage_rc(tid * 16 + i * 8192, R, C); const int Rb = Epi::PERM ? ((R & ~31) + perm32(R & 31)) : R;
        voffA[i] = (unsigned)(R * g.ld + C) * 2u; voffB[i] = (unsigned)(Rb * g.ld + C) * 2u; }
    const __amdgpu_buffer_rsrc_t rsA = __builtin_amdgcn_make_buffer_rsrc((void*)g.A, 0, 0x7ffff000, 0x00020000), rsB = __builtin_amdgcn_make_buffer_rsrc((void*)g.Bt, 0, 0x7ffff000, 0x00020000);
    const size_t kstep = (size_t)(BK * 2);
    const size_t hstep = (size_t)HALF * g.ld * 2;
    const size_t tstep = 2 * hstep;
    const unsigned ldsw = (unsigned)wid * 1024u;
    const int aoff = lds_byte(wr * 64 + fr, fq * 8), boff = lds_byte(wc * 32 + fr, fq * 8);
#define PG8_SA(b, h) (((b) * 2 + (h)) * HTB)
#define PG8_SB(b, h) ((4 + (b) * 2 + (h)) * HTB)
#define PG8_STAGE(bufoff, gbase, voff, rs, base0) do { const unsigned so_ = (unsigned)((const char*)(gbase) - (const char*)(base0)); _Pragma("unroll") for (int _i = 0; _i < 2; ++_i) \
        __builtin_amdgcn_raw_ptr_buffer_load_lds(rs, (LAS void*)(lds + (bufoff) + ldsw + _i * 8192), 16, (voff)[_i], so_, 0, 0); } while (0)
#define PG8_LDA(dst, b, h) do { _Pragma("unroll") for (int m = 0; m < 4; ++m) _Pragma("unroll") for (int k = 0; k < 2; ++k) dst[m][k] = *(const LAS f16x8*)(lds + PG8_SA(b, h) + aoff + m * 2048 + k * 1024); } while (0)
#define PG8_LDB(dst, b, h) do { _Pragma("unroll") for (int n = 0; n < 2; ++n) _Pragma("unroll") for (int k = 0; k < 2; ++k) dst[n][k] = *(const LAS f16x8*)(lds + PG8_SB(b, h) + boff + n * 2048 + k * 1024); } while (0)
#define PG8_MMA(ai, bj, At, Bt) do { __builtin_amdgcn_s_setprio(1); _Pragma("unroll") for (int m = 0; m < 4; ++m) _Pragma("unroll") for (int n = 0; n < 2; ++n) _Pragma("unroll") for (int k = 0; k < 2; ++k) \
        acc[ai][bj][m][n] = __builtin_amdgcn_mfma_f32_16x16x32_f16(Bt[n][k], At[m][k], acc[ai][bj][m][n], 0, 0, 0); __builtin_amdgcn_s_setprio(0); } while (0)
#define PG8_WAIT_V(n) asm volatile("s_waitcnt vmcnt(" #n ")" ::: "memory")
#define PG8_WAIT_L(n) asm volatile("s_waitcnt lgkmcnt(" #n ")" ::: "memory")
#define PG8_BAR __builtin_amdgcn_s_barrier()
#define PG8_SCHED __builtin_amdgcn_sched_barrier(0)
    Unit cur, nxt; int ui = 0;
    if (!S.next(0, cur)) return;
    f32x4 acc[2][2][4][2];
#pragma unroll
    for (int a = 0; a < 2; ++a)
#pragma unroll
        for (int b = 0; b < 2; ++b)
#pragma unroll
            for (int m = 0; m < 4; ++m)
#pragma unroll
                for (int n = 0; n < 2; ++n) acc[a][b][m][n] = (f32x4){0.f, 0.f, 0.f, 0.f};
    f16x8 At[4][2], B0[2][2], B1[2][2];
    const char* cA = (const char*)g.A + (size_t)cur.pm * tstep + (size_t)cur.kp * K * 2; const char* cB = (const char*)g.Bt + (size_t)cur.pn * tstep + (size_t)cur.kp * K * 2;
    S.a_ready(cur);
    if constexpr (SP2) {
        PG8_STAGE(PG8_SB(0, 0), cB, voffB, rsB, g.Bt); PG8_STAGE(PG8_SB(0, 1), cB + hstep, voffB, rsB, g.Bt); PG8_STAGE(PG8_SA(0, 0), cA, voffA, rsA, g.A); PG8_STAGE(PG8_SA(0, 1), cA + hstep, voffA, rsA, g.A);
        if (wr == 1) PG8_BAR;
        PG8_WAIT_V(2); PG8_BAR;
        PG8_STAGE(PG8_SB(1, 0), cB + kstep, voffB, rsB, g.Bt); PG8_STAGE(PG8_SA(1, 0), cA + kstep, voffA, rsA, g.A); PG8_STAGE(PG8_SB(1, 1), cB + hstep + kstep, voffB, rsB, g.Bt);
        PG8_WAIT_V(6); PG8_BAR;
    } else {
        PG8_STAGE(PG8_SB(0, 0), cB, voffB, rsB, g.Bt); PG8_STAGE(PG8_SA(0, 0), cA, voffA, rsA, g.A); PG8_STAGE(PG8_SB(0, 1), cB + hstep, voffB, rsB, g.Bt); PG8_STAGE(PG8_SA(0, 1), cA + hstep, voffA, rsA, g.A);
        if (wr == 1) PG8_BAR;
        PG8_WAIT_V(4); PG8_BAR;
        PG8_STAGE(PG8_SB(1, 0), cB + kstep, voffB, rsB, g.Bt); PG8_STAGE(PG8_SA(1, 0), cA + kstep, voffA, rsA, g.A); PG8_STAGE(PG8_SB(1, 1), cB + hstep + kstep, voffB, rsB, g.Bt);
        PG8_WAIT_V(6); PG8_BAR;
    }
    for (;;) {
        const bool has_next = S.next(ui + 1, nxt);
        const char* nA = has_next ? (const char*)g.A + (size_t)nxt.pm * tstep + (size_t)nxt.kp * K * 2 : cA; const char* nB = has_next ? (const char*)g.Bt + (size_t)nxt.pn * tstep + (size_t)nxt.kp * K * 2 : cB;
        for (int t = 0; t < nt; t += 2) {
            const bool last = (t == nt - 2);
            const char* a1 = cA + (size_t)(t + 1) * kstep;
            const char* a2 = last ? nA : cA + (size_t)(t + 2) * kstep; const char* b2 = last ? nB : cB + (size_t)(t + 2) * kstep;
            const char* a3 = a2 + kstep; const char* b3 = b2 + kstep;
            if (last && has_next) S.a_ready(nxt);
            if constexpr (SP2) {
            PG8_LDB(B0, 0, 0); PG8_LDB(B1, 0, 1); PG8_SCHED; PG8_LDA(At, 0, 0); PG8_STAGE(PG8_SA(1, 1), a1 + hstep, voffA, rsA, g.A);
            PG8_WAIT_V(8); PG8_WAIT_L(0); PG8_BAR; PG8_MMA(0, 0, At, B0); PG8_MMA(0, 1, At, B1); PG8_BAR; PG8_SCHED;
            PG8_LDA(At, 0, 1); PG8_STAGE(PG8_SB(0, 0), b2, voffB, rsB, g.Bt); PG8_STAGE(PG8_SB(0, 1), b2 + hstep, voffB, rsB, g.Bt); PG8_STAGE(PG8_SA(0, 0), a2, voffA, rsA, g.A);
            PG8_WAIT_V(8); PG8_WAIT_L(0); PG8_BAR; PG8_MMA(1, 0, At, B0); PG8_MMA(1, 1, At, B1); PG8_BAR; PG8_SCHED;
            PG8_LDB(B0, 1, 0); PG8_LDB(B1, 1, 1); PG8_SCHED; PG8_LDA(At, 1, 0); PG8_STAGE(PG8_SA(0, 1), a2 + hstep, voffA, rsA, g.A);
            PG8_WAIT_V(8); PG8_WAIT_L(0); PG8_BAR; PG8_MMA(0, 0, At, B0); PG8_MMA(0, 1, At, B1); PG8_BAR; PG8_SCHED;
            PG8_LDA(At, 1, 1); PG8_STAGE(PG8_SB(1, 0), b3, voffB, rsB, g.Bt); PG8_STAGE(PG8_SB(1, 1), b3 + hstep, voffB, rsB, g.Bt); PG8_STAGE(PG8_SA(1, 0), a3, voffA, rsA, g.A);
            PG8_WAIT_V(8); PG8_WAIT_L(0); PG8_BAR; PG8_MMA(1, 0, At, B0); PG8_MMA(1, 1, At, B1); PG8_BAR; PG8_SCHED;
            } else {
            PG8_LDB(B0, 0, 0); PG8_SCHED; PG8_LDA(At, 0, 0); PG8_STAGE(PG8_SA(1, 1), a1 + hstep, voffA, rsA, g.A);
            PG8_WAIT_L(8); PG8_BAR; PG8_WAIT_L(0); PG8_MMA(0, 0, At, B0); PG8_BAR; PG8_SCHED;
            PG8_LDB(B1, 0, 1); PG8_STAGE(PG8_SB(0, 0), b2, voffB, rsB, g.Bt);
            PG8_BAR; PG8_WAIT_L(0); PG8_MMA(0, 1, At, B1); PG8_BAR;
            PG8_LDA(At, 0, 1); PG8_STAGE(PG8_SA(0, 0), a2, voffA, rsA, g.A);
            PG8_BAR; PG8_WAIT_L(0); PG8_MMA(1, 0, At, B0); PG8_BAR; PG8_SCHED;
            PG8_STAGE(PG8_SB(0, 1), b2 + hstep, voffB, rsB, g.Bt);
            PG8_WAIT_V(6); PG8_BAR; PG8_MMA(1, 1, At, B1); PG8_BAR;
            PG8_LDB(B0, 1, 0); PG8_SCHED; PG8_LDA(At, 1, 0); PG8_STAGE(PG8_SA(0, 1), a2 + hstep, voffA, rsA, g.A);
            PG8_WAIT_L(8); PG8_BAR; PG8_WAIT_L(0); PG8_MMA(0, 0, At, B0); PG8_BAR; PG8_SCHED;
            PG8_LDB(B1, 1, 1); PG8_STAGE(PG8_SB(1, 0), b3, voffB, rsB, g.Bt);
            PG8_BAR; PG8_WAIT_L(0); PG8_MMA(0, 1, At, B1); PG8_BAR;
            PG8_LDA(At, 1, 1); PG8_STAGE(PG8_SA(1, 0), a3, voffA, rsA, g.A);
            PG8_BAR; PG8_WAIT_L(0); PG8_MMA(1, 0, At, B0); PG8_BAR; PG8_SCHED;
            PG8_STAGE(PG8_SB(1, 1), b3 + hstep, voffB, rsB, g.Bt);
            PG8_WAIT_V(6); PG8_BAR; PG8_MMA(1, 1, At, B1); PG8_BAR;
            }
        }
        if constexpr (ALIGN_EPI) { if (wr == 0) PG8_BAR; }
        E(acc, cur, wr, wc, fr, fq); S.done(cur);
        if (!has_next) break;
#pragma unroll
        for (int a = 0; a < 2; ++a)
#pragma unroll
            for (int b = 0; b < 2; ++b)
#pragma unroll
                for (int m = 0; m < 4; ++m)
#pragma unroll
                    for (int n = 0; n < 2; ++n) acc[a][b][m][n] = (f32x4){0.f, 0.f, 0.f, 0.f};
        cur = nxt; cA = nA; cB = nB; ++ui;
        if constexpr (ALIGN_EPI) { if (wr == 1) PG8_BAR; }
    }
    PG8_WAIT_V(0);
    if constexpr (!ALIGN_EPI) { if (wr == 0) PG8_BAR; }
    PG8_BAR;
#undef PG8_SA
#undef PG8_SB
#undef PG8_STAGE
#undef PG8_LDA
#undef PG8_LDB
#undef PG8_MMA
#undef PG8_WAIT_V
#undef PG8_WAIT_L
#undef PG8_BAR
#undef PG8_SCHED
}
}
using pg8::Unit;
constexpr int HALF = pg8::HALF, BM = pg8::BM;

struct EpiSwiGLU {
    static constexpr bool PERM = true;
    f16* O;
    __device__ __forceinline__ void operator()(const f32x4 (&acc)[2][2][4][2], const Unit& u, int wr, int wc, int fr, int fq) const {
        asm volatile("" : "+v"(fr), "+v"(fq));
        const int row0 = u.pm * BM + wr * 64 + fr, col0 = u.pn * HALF + wc * 32 + 8 * fq;
#pragma unroll
        for (int ai = 0; ai < 2; ++ai)
#pragma unroll
            for (int m = 0; m < 4; ++m) {
                f16* rowp = O + (size_t)(row0 + ai * HALF + m * 16) * DFF + col0;
                const f32x4 g0 = acc[ai][0][m][0], g1 = acc[ai][0][m][1], u0 = acc[ai][1][m][0], u1 = acc[ai][1][m][1];
                u32x4 w;
                w.x = pk_f16(siluf_(g0[0]) * u0[0], siluf_(g0[1]) * u0[1]); w.y = pk_f16(siluf_(g0[2]) * u0[2], siluf_(g0[3]) * u0[3]);
                w.z = pk_f16(siluf_(g1[0]) * u1[0], siluf_(g1[1]) * u1[1]); w.w = pk_f16(siluf_(g1[2]) * u1[2], siluf_(g1[3]) * u1[3]);
                *(u32x4*)rowp = w;
            }
    }
};
struct EpiResid {
    static constexpr bool PERM = true;
    f16* X; const float* modg;
    int halfc; const float* Xin32;
    __device__ __forceinline__ void operator()(const f32x4 (&acc)[2][2][4][2], const Unit& u, int wr, int wc, int fr, int fq) const {
        asm volatile("" : "+v"(fr), "+v"(fq));
        const int row0 = u.pm * BM + wr * 64 + fr, col0 = u.pn * BM + wc * 32 + 8 * fq;
        const int bidx = u.pm < 32 ? (u.pm >> 3) : 4;
        const float* gp = modg + (size_t)bidx * NMODC + col0; const float coef = halfc ? 0.5f : 1.0f;
        f32x4 gv[2][2];
#pragma unroll
        for (int bj = 0; bj < 2; ++bj)
#pragma unroll
            for (int n = 0; n < 2; ++n) gv[bj][n] = *(const f32x4*)(gp + bj * HALF + n * 4) * coef;
#pragma unroll
        for (int ai = 0; ai < 2; ++ai)
#pragma unroll
            for (int m = 0; m < 4; ++m) { const size_t ro = (size_t)(row0 + ai * HALF + m * 16) * D + col0;
#pragma unroll
                for (int bj = 0; bj < 2; ++bj) { f32x4 x0, x1;
                    if (Xin32) { x0 = *(const f32x4*)(Xin32 + ro + bj * HALF); x1 = *(const f32x4*)(Xin32 + ro + bj * HALF + 4); }
                    else { const f16x8 h8 = *(const f16x8*)(X + ro + bj * HALF); x0 = (f32x4){(float)h8[0], (float)h8[1], (float)h8[2], (float)h8[3]}; x1 = (f32x4){(float)h8[4], (float)h8[5], (float)h8[6], (float)h8[7]}; }
                    x0 = x0 + gv[bj][0] * acc[ai][bj][m][0]; x1 = x1 + gv[bj][1] * acc[ai][bj][m][1];
                    u32x4 w; w.x = pk_f16(x0[0], x0[1]); w.y = pk_f16(x0[2], x0[3]); w.z = pk_f16(x1[0], x1[1]); w.w = pk_f16(x1[2], x1[3]);
                    *(u32x4*)(X + ro + bj * HALF) = w; } }
    }
};
struct EpiResidPart {
    static constexpr bool PERM = false;
    float* PART; const float* modg; float coef;
    __device__ __forceinline__ void operator()(const f32x4 (&acc)[2][2][4][2], const Unit& u, int wr, int wc, int fr, int fq) const {
        asm volatile("" : "+v"(fr), "+v"(fq));
        const int row0 = (u.pm - 32) * BM + wr * 64 + fr, col0 = u.pn * BM + wc * 32 + 4 * fq;
        const float* gp = modg + (size_t)4 * NMODC + col0;
        f32x4 gv[2][2];
#pragma unroll
        for (int bj = 0; bj < 2; ++bj)
#pragma unroll
            for (int n = 0; n < 2; ++n) gv[bj][n] = *(const f32x4*)(gp + bj * HALF + n * 16) * coef;
#pragma unroll
        for (int ai = 0; ai < 2; ++ai)
#pragma unroll
            for (int m = 0; m < 4; ++m) { float* rowp = PART + ((size_t)u.kp * MC + row0 + ai * HALF + m * 16) * D + col0;
#pragma unroll
                for (int bj = 0; bj < 2; ++bj)
#pragma unroll
                    for (int n = 0; n < 2; ++n) *(f32x4*)(rowp + bj * HALF + n * 16) = gv[bj][n] * acc[ai][bj][m][n]; }
    }
};
struct EpiProj {
    static constexpr bool PERM = true;
    f16* P; float* G; const float* rope;
    __device__ __forceinline__ void operator()(const f32x4 (&acc)[2][2][4][2], const Unit& u, int wr, int wc, int fr, int fq) const {
        asm volatile("" : "+v"(fr), "+v"(fq));
        const int row0 = u.pm * BM + wr * 64 + fr; const int pn = u.pn;
        if (pn == 60) {
            if (wc == 0 && fq < 2) {
#pragma unroll
                for (int ai = 0; ai < 2; ++ai)
#pragma unroll
                    for (int m = 0; m < 4; ++m) { float* gp = G + (size_t)(row0 + ai * HALF + m * 16) * 16 + 8 * fq;
                        *(f32x4*)gp = acc[ai][0][m][0]; *(f32x4*)(gp + 4) = acc[ai][0][m][1]; }
            }
            return;
        }
        const int col0 = pn * BM + wc * 32 + 8 * fq;
        int mode = 0; float scl = 1.0f;
        if (pn < 8) { mode = (u.pm < 32) ? 1 : 2; scl = (pn >= 4) ? 0.0625f : 1.0f; }
        else if (pn >= 12 && pn < 16) mode = 3;
        else if (pn >= 16 && pn < 20) { mode = 2; scl = 0.08838834764831845f; }
        else if (pn >= 32 && pn < 36) mode = 4;
        else if (pn >= 36) mode = 3;
#pragma unroll
        for (int ai = 0; ai < 2; ++ai)
#pragma unroll
            for (int m = 0; m < 4; ++m) {
                const int row = row0 + ai * HALF + m * 16;
                f16* rowp = P + (size_t)row * LDP + col0;
#pragma unroll
                for (int bj = 0; bj < 2; ++bj) {
                    f32x4 v0 = acc[ai][bj][m][0], v1 = acc[ai][bj][m][1];
                    if (mode == 1) {
                        const int t = row & (SEQ - 1); const int pos = bj == 0 ? (t >> 6) : (t & 63);
                        const float* cp = rope + pos * 64 + 16 * wc + 4 * fq;
                        const f32x4 c = *(const f32x4*)cp, s = *(const f32x4*)(cp + 4096);
                        f32x4 o0, o1;
                        o0[0] = v0[0] * c[0] - v0[1] * s[0]; o0[1] = v0[0] * s[0] + v0[1] * c[0];
                        o0[2] = v0[2] * c[1] - v0[3] * s[1]; o0[3] = v0[2] * s[1] + v0[3] * c[1];
                        o1[0] = v1[0] * c[2] - v1[1] * s[2]; o1[1] = v1[0] * s[2] + v1[1] * c[2];
                        o1[2] = v1[2] * c[3] - v1[3] * s[3]; o1[3] = v1[2] * s[3] + v1[3] * c[3];
                        v0 = o0 * scl; v1 = o1 * scl;
                    } else if (mode == 2) { v0 = v0 * scl; v1 = v1 * scl; }
                    else if (mode == 3) {
#pragma unroll
                        for (int e = 0; e < 4; ++e) { v0[e] = sigmoidf_(v0[e]); v1[e] = sigmoidf_(v1[e]); }
                    } else if (mode == 4) {
#pragma unroll
                        for (int e = 0; e < 4; ++e) { v0[e] = gelu_tanh_(v0[e]); v1[e] = gelu_tanh_(v1[e]); }
                    }
                    u32x4 w; w.x = pk_f16(v0[0], v0[1]); w.y = pk_f16(v0[2], v0[3]); w.z = pk_f16(v1[0], v1[1]); w.w = pk_f16(v1[2], v1[3]);
                    *(u32x4*)(rowp + bj * HALF) = w;
                }
            }
    }
};
template <int MODE> struct EpiGate {
    static constexpr bool PERM = true;
    const f16* gate;
    f16* MH;
    __device__ __forceinline__ void operator()(const f32x4 (&acc)[2][2][4][2], const Unit& u, int wr, int wc, int fr, int fq) const {
        asm volatile("" : "+v"(fr), "+v"(fq));
        const int row0 = u.pm * BM + wr * 64 + fr, col0 = u.pn * BM + wc * 32 + 8 * fq;
#pragma unroll
        for (int ai = 0; ai < 2; ++ai)
#pragma unroll
            for (int m = 0; m < 4; ++m) {
                const int row = row0 + ai * HALF + m * 16;
#pragma unroll
                for (int bj = 0; bj < 2; ++bj) {
                    const f16x8 gh = *(const f16x8*)(gate + (size_t)row * LDP + col0 + bj * HALF);
                    f16* mp = MH + (size_t)row * D + col0 + bj * HALF;
                    f32x4 v0 = acc[ai][bj][m][0], v1 = acc[ai][bj][m][1];
#pragma unroll
                    for (int e = 0; e < 4; ++e) { v0[e] *= (float)gh[e]; v1[e] *= (float)gh[4 + e]; }
                    if (MODE >= 1) { const f16x8 pm_ = *(const f16x8*)mp;
#pragma unroll
                        for (int e = 0; e < 4; ++e) { v0[e] += (float)pm_[e]; v1[e] += (float)pm_[4 + e]; } }
                    { u32x4 w; w.x = pk_f16(v0[0], v0[1]); w.y = pk_f16(v0[2], v0[3]); w.z = pk_f16(v1[0], v1[1]); w.w = pk_f16(v1[2], v1[3]); *(u32x4*)mp = w; }
                }
            }
    }
};

struct Args { const float* in[28]; float* out; unsigned char* ws; int ph_lo, ph_hi; };
struct Frame {
    LAS unsigned char* lds; int tid, lane, wave, G, bid;
    float* out; unsigned char* ws;
};
typedef const Args __attribute__((address_space(4)))* KArgs;
__device__ __forceinline__ KArgs kargs() { return (KArgs)__builtin_amdgcn_kernarg_segment_ptr(); }
__device__ __forceinline__ const float* inp(int k) { return kargs()->in[k]; }
extern __shared__ __attribute__((aligned(16))) unsigned char lds_raw[];
__device__ __forceinline__ Frame make_frame() {
    Frame F; F.lds = (LAS unsigned char*)lds_raw; int t = threadIdx.x; asm volatile("" : "+v"(t));
    F.tid = t; F.lane = F.tid & 63; F.wave = __builtin_amdgcn_readfirstlane(F.tid >> 6);
    int g = gridDim.x, b = blockIdx.x; asm volatile("" : "+s"(g), "+s"(b)); F.G = g; F.bid = b;
    KArgs ka = kargs(); asm volatile("" : "+s"(ka)); F.out = ka->out; F.ws = ka->ws; return F;
}
#define UNI(x) __builtin_amdgcn_readfirstlane(x)
#define WSP(T, off) ((T*)(F.ws + (off)))

template <int MAP> __device__ __forceinline__ int dest_row(int c) {
    if (MAP == 0) return c;
    if (MAP == 1) { const int bj = c >= DFF ? 1 : 0, j = c - bj * DFF; return (j >> 7) * 256 + bj * 128 + (j & 127); }
    if (c < 2048) { const int base = c & 1024, x = c & 255, hh = (c >> 8) & 3, bj = x >> 7, within = x & 127, e = within >> 6, i = within & 63; return base + hh * 256 + bj * 128 + 2 * i + e; }
    if (c < 4096) return c;
    if (c < 4112) return 15360 + (c - 4096);
    return c - 16;
}
template <int MAP> __device__ __forceinline__ void transpose_item2(const float* W, int ldw, int k0, int c0, f16* WT, int Kdim, LAS float* scr, int lane) {
    const int col4 = (lane & 7) * 4; const bool cv = c0 + col4 < ldw;
    f32x4 v[8];
#pragma unroll
    for (int it = 0; it < 8; ++it) { const int r = it * 8 + (lane >> 3); v[it] = cv ? __builtin_nontemporal_load((const f32x4*)(W + (size_t)(k0 + r) * ldw + c0 + col4)) : (f32x4){0.f, 0.f, 0.f, 0.f}; }
#pragma unroll
    for (int it = 0; it < 8; ++it) { const int r = it * 8 + (lane >> 3); LAS float* d = scr + r * 33 + col4; d[0] = v[it].x; d[1] = v[it].y; d[2] = v[it].z; d[3] = v[it].w; }
    LDS_WAIT();
    const int c = lane & 7;
#pragma unroll
    for (int j = 0; j < 4; ++j) { const int n = (lane >> 3) + 8 * j; const LAS float* sp = scr + (8 * c) * 33 + n;
        u32x4 o; o.x = pk_f16(sp[0 * 33], sp[1 * 33]); o.y = pk_f16(sp[2 * 33], sp[3 * 33]); o.z = pk_f16(sp[4 * 33], sp[5 * 33]); o.w = pk_f16(sp[6 * 33], sp[7 * 33]);
        if (c0 + n < ldw) __builtin_nontemporal_store(o, (u32x4*)(WT + (size_t)dest_row<MAP>(c0 + n) * Kdim + k0 + 8 * c)); }
    LDS_WAIT();
}
constexpr int CV_W1 = 32 * 352, CV_W2 = 88 * 64, CV_WIN = 32 * 481, CV_WBR = 3 * 16 * 64, CV_WOUT = 32 * 64, CV_LRU = 256;
constexpr int CV_PER_L = 2 * CV_W1 + 2 * CV_W2 + CV_WIN + CV_WBR + CV_WOUT + CV_LRU;
__device__ __forceinline__ void convert_item(Frame& F, int l, int r, LAS float* scr) {
    unsigned char* wl = F.ws + WS_W + (size_t)l * WL_SIZE;
    if (r < 2 * CV_W1) { const int which = r / CV_W1; r %= CV_W1;
        transpose_item2<1>(inp(which ? 11 : 9) + (size_t)l * D * 2 * DFF, 2 * DFF, (r / 352) * 64, (r % 352) * 32, (f16*)(wl + (which ? WL_W3 : WL_W1)), D, scr, F.lane); return; }
    r -= 2 * CV_W1;
    if (r < 2 * CV_W2) { const int which = r / CV_W2; r %= CV_W2;
        transpose_item2<0>(inp(which ? 12 : 10) + (size_t)l * DFF * D, D, (r / 64) * 64, (r % 64) * 32, (f16*)(wl + (which ? WL_W4 : WL_W2)), DFF, scr, F.lane); return; }
    r -= 2 * CV_W2;
    if (r < CV_WIN) { transpose_item2<2>(inp(13) + (size_t)l * D * PIN_SRC, PIN_SRC, (r / 481) * 64, (r % 481) * 32, (f16*)(wl + WL_WIN), D, scr, F.lane); return; }
    r -= CV_WIN;
    if (r < CV_WBR) { const int n = r / 1024; r %= 1024;
        transpose_item2<0>(inp(25) + ((size_t)l * 3 + n) * BW * D, D, (r / 64) * 64, (r % 64) * 32, (f16*)(wl + WL_WBR) + (size_t)n * D * BW, BW, scr, F.lane); return; }
    r -= CV_WBR;
    if (r < CV_WOUT) { transpose_item2<0>(inp(26) + (size_t)l * D * D, D, (r / 64) * 64, (r % 64) * 32, (f16*)(wl + WL_WOUT), D, scr, F.lane); return; }
    r -= CV_WOUT;
    { const int mat = r >> 7, ng = (r >> 3) & 15, kb = (r >> 2) & 1, nb = r & 3;
      transpose_item2<0>(inp(mat ? 22 : 20) + ((size_t)l * 16 + ng) * 128 * 128, 128, kb * 64, nb * 32, WSP(f16, WS_WLRU) + (((size_t)l * 2 + mat) * 16 + ng) * 128 * 128, 128, scr, F.lane); }
}
constexpr int CO_A = CV_W1 + CV_W2 + CV_WIN + CV_LRU;
constexpr int CO_L0 = CV_PER_L, CO_TOT = 2 * CV_PER_L;
__device__ __forceinline__ void ord_item(Frame& F, int o, LAS float* scr) {
    const int l = o >= CO_L0 ? 1 : 0; int x = o - l * CO_L0;
    constexpr int N_W3 = CV_W1, N_W2 = 2 * CV_W1, N_W4 = 2 * CV_W1 + CV_W2, N_WIN = 2 * CV_W1 + 2 * CV_W2, N_WBR = N_WIN + CV_WIN, N_WOUT = N_WBR + CV_WBR, N_LRU = N_WOUT + CV_WOUT;
    int r;
    if (x < CV_W1) r = x;
    else if ((x -= CV_W1) < CV_W2) r = N_W2 + x;
    else if ((x -= CV_W2) < CV_WIN) r = N_WIN + x;
    else if ((x -= CV_WIN) < CV_LRU) r = N_LRU + x;
    else if ((x -= CV_LRU) < CV_WBR) r = N_WBR + x;
    else if ((x -= CV_WBR) < CV_WOUT) r = N_WOUT + x;
    else if ((x -= CV_WOUT) < CV_W1) r = N_W3 + x;
    else { x -= CV_W1; r = N_W4 + x; }
    convert_item(F, l, r, scr);
}
__device__ __forceinline__ void ph_convert_idle(int nunits, int q, int start) {
    Frame F = make_frame();
    if (F.G != 256) return;
    LAS float* scr = (LAS float*)(F.lds + F.wave * 16384);
    const int first_idle = nunits - ((nunits + F.G - 1) / F.G - 1) * F.G; if (F.bid < first_idle) return;
    const int nidle = F.G - first_idle, j = F.bid - first_idle, lim = min(start + nidle * 8 * q, CO_TOT);
#pragma unroll 1
    for (int t = 0; t < q; ++t) { const int o = start + (t * nidle + j) * 8 + F.wave; if (o < lim) ord_item(F, o, scr); }
}
__device__ __forceinline__ void ph_convert_all(int start, int end) {
    Frame F = make_frame();
    if (F.G != 256) return;
    LAS float* scr = (LAS float*)(F.lds + F.wave * 16384);
    for (int o = start + F.bid * 8 + F.wave; o < end; o += F.G * 8) ord_item(F, o, scr);
}
constexpr int CSM_Q = 8;
constexpr int CS1 = CO_A, CS2 = CS1 + 208 * 48, CS3 = CS2 + 128 * 24, CSM = CS3 + 108 * 48, CS4 = CSM + 128 * 8 * CSM_Q, CS5 = CS4 + 224 * 48, CS6 = CS5 + 224 * 24, CS7 = CS6 + 128 * 24, CS8 = CS7 + 208 * 48,
              CT1 = CS8 + 128 * 24, CT2 = CT1 + 208 * 48, CT3 = CT2 + 128 * 24, CO_W3END = CO_TOT - CV_W2;
static_assert(CS4 >= CO_A + CV_WBR && CS6 >= CO_A + CV_WBR + CV_WOUT && CS7 >= CO_L0 - CV_W2 && CS8 >= CO_L0, "layer-0 deadlines");
static_assert(CT1 >= CO_L0 + CV_W1 && CT2 >= CO_L0 + CV_W1 + CV_W2 && CT3 >= CO_W3END && CO_W3END + 128 * 48 >= CO_TOT, "layer-1 deadlines");
__device__ __forceinline__ void phase_prologue() {
    Frame F = make_frame();
    const int gw = F.bid * 8 + F.wave, NGW = F.G * 8;
    const int gt = F.bid * 512 + F.tid, NGT = F.G * 512;
    { const f32x4* cs = (const f32x4*)inp(2); u32x2* X = WSP(u32x2, WS_X) + (size_t)ML * D / 4; for (int i = gt; i < MC * D / 4; i += NGT) { const f32x4 v = cs[i]; u32x2 w; w.x = pk_f16(v.x, v.y); w.y = pk_f16(v.z, v.w); X[i] = w; } }
    { float* rope = WSP(float, WS_ROPE);
      for (int i = gt; i < 4096; i += NGT) { const int pos = i >> 6, j = i & 63; const float inv = powf(10000.0f, -(float)j / 64.0f); const float a = (float)pos * inv; rope[i] = cosf(a); rope[4096 + i] = sinf(a); }
      for (int l = 0; l < DEPTH; ++l) { u32x4* z = (u32x4*)(F.ws + WS_W + (size_t)l * WL_SIZE + WL_WIN + (size_t)15376 * D * 2);
          for (int i = gt; i < 240 * D * 2 / 16; i += NGT) z[i] = (u32x4){0u, 0u, 0u, 0u}; } }
    LAS float* scr = (LAS float*)(F.lds + F.wave * 16384);
    LAS float* sa = (LAS float*)(F.lds + F.wave * 16384 + 8448);
    for (int it = F.bid; it < DEPTH * 72; it += F.G) {
        const int l = it / 72, cg = it % 72, n0 = cg * 256 + 4 * F.lane, k0 = F.wave * 256;
        for (int i = F.lane; i < 5 * 256; i += 64) { const int bi = i >> 8, k = i & 255; const float c = bi < 4 ? inp(1)[bi * D + k0 + k] : inp(3)[k0 + k]; sa[i] = siluf_(c); }
        LDS_WAIT();
        const float* Wm = inp(4) + (size_t)l * D * NMODC + (size_t)k0 * NMODC + n0;
        f32x4 acc[5];
#pragma unroll
        for (int bi = 0; bi < 5; ++bi) acc[bi] = (f32x4){0.f, 0.f, 0.f, 0.f};
#pragma unroll 8
        for (int kk = 0; kk < 256; ++kk) { const f32x4 w = __builtin_nontemporal_load((const f32x4*)(Wm + (size_t)kk * NMODC));
#pragma unroll
            for (int bi = 0; bi < 5; ++bi) acc[bi] = acc[bi] + w * sa[bi * 256 + kk]; }
#pragma unroll
        for (int bi = 0; bi < 5; ++bi) *(LAS f32x4*)(scr + bi * 256 + 4 * F.lane) = acc[bi];
        __syncthreads();
        for (int i = F.tid; i < 5 * 256; i += 512) { const int bi = i >> 8, col = i & 255; float sum = inp(5)[(size_t)l * NMODC + cg * 256 + col];
#pragma unroll
            for (int w = 0; w < 8; ++w) sum += ((LAS float*)(F.lds + w * 16384))[bi * 256 + col];
            WSP(float, WS_MOD)[((size_t)l * 5 + bi) * NMODC + cg * 256 + col] = sum; }
        __syncthreads();
    }
    if (F.G == 256) {
        constexpr int NHI = 30352;
        if (F.bid >= 144) { for (int o = (F.bid - 144) * 8 + F.wave; o < NHI; o += 112 * 8) ord_item(F, o, scr); }
        else { for (int o = NHI + F.bid * 8 + F.wave; o < CO_A; o += 144 * 8) ord_item(F, o, scr); }
    } else { for (int o = gw; o < CO_TOT; o += NGW) ord_item(F, o, scr); }
}

__device__ __forceinline__ void phase_adaln(int li_v, int which_v) {
    Frame F = make_frame(); const int li = UNI(li_v), which = UNI(which_v);
    const float* gain = inp(6 + which) + (size_t)li * D; const int chunk_shift = 3 * which; const int M = (which == 2 && li == DEPTH - 1) ? ML : MT;
    const int gw = F.bid * 8 + F.wave, NGW = F.G * 8;
    const bool first = li == 0 && which == 0;
    const f16* XH = WSP(f16, WS_X); f16* H = WSP(f16, WS_H);
#pragma unroll 1
    for (int pass = 0; pass < 2; ++pass) {
        int bidx, rbeg, rend, rstep;
        if (pass == 0) { const int wpb = NGW / NB; if (wpb == 0) { bidx = -1; rbeg = rend = rstep = 0; } else { bidx = gw / wpb; rbeg = bidx * SEQ + gw % wpb; rend = (bidx + 1) * SEQ; rstep = wpb; if (bidx >= NB) { bidx = -1; } } }
        else { bidx = 4; rbeg = ML + gw; rend = M; rstep = NGW; }
        if (bidx < 0 || rbeg >= rend) continue;
        const float* modb = WSP(float, WS_MOD) + ((size_t)li * 5 + bidx) * NMODC + chunk_shift * D;
        f32x4 gm[4][2], sh[4][2];
#pragma unroll
        for (int j = 0; j < 4; ++j)
#pragma unroll
            for (int hh = 0; hh < 2; ++hh) { const int c = (64 * j + F.lane) * 8 + 4 * hh; gm[j][hh] = *(const f32x4*)(gain + c) * (*(const f32x4*)(modb + D + c) + 1.0f); sh[j][hh] = *(const f32x4*)(modb + c); }
#pragma unroll 1
        for (int row = rbeg; row < rend; row += rstep) {
            f32x4 v[4][2]; float ss = 0.f;
            if (first && row < ML) { const f32x4* xr = (const f32x4*)(inp(0) + (size_t)row * D) + 2 * F.lane;
#pragma unroll
                for (int j = 0; j < 4; ++j) { v[j][0] = xr[128 * j]; v[j][1] = xr[128 * j + 1]; } }
            else { const f16x8* xr = (const f16x8*)(XH + (size_t)row * D) + F.lane;
#pragma unroll
                for (int j = 0; j < 4; ++j) { const f16x8 h8 = __builtin_nontemporal_load(xr + 64 * j);
                    v[j][0] = (f32x4){(float)h8[0], (float)h8[1], (float)h8[2], (float)h8[3]}; v[j][1] = (f32x4){(float)h8[4], (float)h8[5], (float)h8[6], (float)h8[7]}; } }
            if (row >= ML && !first) {
                const f32x4* pr = (const f32x4*)(WSP(float, WS_PART) + (size_t)(row - ML) * D) + 2 * F.lane;
#pragma unroll
                for (int kp = 0; kp < 4; ++kp)
#pragma unroll
                    for (int j = 0; j < 4; ++j) { v[j][0] = v[j][0] + pr[(size_t)kp * MC * D / 4 + 128 * j]; v[j][1] = v[j][1] + pr[(size_t)kp * MC * D / 4 + 128 * j + 1]; }
                u32x4* xw = (u32x4*)(WSP(f16, WS_X) + (size_t)row * D) + F.lane;
#pragma unroll
                for (int j = 0; j < 4; ++j) { u32x4 w; w.x = pk_f16(v[j][0].x, v[j][0].y); w.y = pk_f16(v[j][0].z, v[j][0].w); w.z = pk_f16(v[j][1].x, v[j][1].y); w.w = pk_f16(v[j][1].z, v[j][1].w); xw[64 * j] = w; }
            }
#pragma unroll
            for (int j = 0; j < 4; ++j)
#pragma unroll
                for (int hh = 0; hh < 2; ++hh) ss += (v[j][hh].x * v[j][hh].x + v[j][hh].y * v[j][hh].y) + (v[j][hh].z * v[j][hh].z + v[j][hh].w * v[j][hh].w);
            const float rstd = rsqrtf(wave_sum(ss, F.lane) * (1.0f / D) + EPS);
            u32x4* o = (u32x4*)(H + (size_t)row * D) + F.lane;
#pragma unroll
            for (int j = 0; j < 4; ++j) { const f32x4 y0 = v[j][0] * rstd * gm[j][0] + sh[j][0], y1 = v[j][1] * rstd * gm[j][1] + sh[j][1];
                u32x4 w; w.x = pk_f16(y0.x, y0.y); w.y = pk_f16(y0.z, y0.w); w.z = pk_f16(y1.x, y1.y); w.w = pk_f16(y1.z, y1.w); o[64 * j] = w; }
        }
    }
}
__device__ __forceinline__ void phase_final() {
    Frame F = make_frame();
    const int gw = F.bid * 8 + F.wave, NGW = F.G * 8;
    const f16* X = WSP(f16, WS_X); const float* gain = inp(27);
    for (int row = gw; row < ML; row += NGW) {
        const f16x4* xr = (const f16x4*)(X + (size_t)row * D) + F.lane;
        f32x4 v[8]; float ss = 0.f;
#pragma unroll
        for (int j = 0; j < 8; ++j) { const f16x4 h4 = xr[64 * j]; v[j] = (f32x4){(float)h4[0], (float)h4[1], (float)h4[2], (float)h4[3]}; ss += (v[j].x * v[j].x + v[j].y * v[j].y) + (v[j].z * v[j].z + v[j].w * v[j].w); }
        const float rstd = rsqrtf(wave_sum(ss, F.lane) * (1.0f / D) + EPS);
        f32x4* o = (f32x4*)(F.out + (size_t)row * D) + F.lane;
#pragma unroll
        for (int j = 0; j < 8; ++j) { const int c = (64 * j + F.lane) * 4; f32x4 r_ = v[j] * rstd * *(const f32x4*)(gain + c);
#if TPROBE
            { const float* tp = (const float*)(F.ws + WS_CTL) + 2048; r_ = r_ * (1.0f + sqrtf(tp[0] * 1e-3f)); if (row == 0 && c == 0) r_.x += tp[1] * 1e3f; }
#endif
            o[64 * j] = r_; }
    }
}


template <int PASS> __device__ __forceinline__ void lru_block(Frame& F, int li, bool latent_only, int ufirst = 0, int ulimit = 1 << 30) {
    LAS f16* Xc = (LAS f16*)F.lds;
    LAS float* Hs = (LAS float*)(F.lds + 17408);
    const f16* P = WSP(f16, WS_P); float* SUM = WSP(float, WS_LSUM);
    const int lane0 = F.lane, wave = F.wave, tid0 = F.tid; int tid = tid0, c8 = (tid0 & 15) * 8;
    const int nunits = min(latent_only ? 4 * 32 * 8 : 4 * 36 * 8, ulimit);
#define LRU_UNIT(it) (latent_only ? ((it) / 256) * 288 + 32 + ((it) % 256) : (it))
#define LRU_ROW0(u) ((((u) >> 3) % 36) < 4 ? ML + ((u) / 288) * CTXL + (((u) >> 3) % 36) * 64 : ((u) / 288) * SEQ + ((((u) >> 3) % 36) - 4) * 64)
#define LRU_SBEG(u) ((((u) >> 3) % 36) < 4 ? ML + ((u) / 288) * CTXL : ((u) / 288) * SEQ)
#define LRU_SEND(u) (LRU_SBEG(u) + ((((u) >> 3) % 36) < 4 ? CTXL : SEQ))
    f16x8 raw[2][4];
#define LRU_PREFETCH(u) do { const int row0_ = LRU_ROW0(u), sb_ = LRU_SBEG(u), se_ = LRU_SEND(u), g_ = (u) & 7; \
        _Pragma("unroll") for (int it_ = 0; it_ < 2; ++it_) { const int row_ = row0_ + ((it_ * 512 + tid) >> 4); \
            _Pragma("unroll") for (int j_ = 0; j_ < 4; ++j_) { const int rr_ = row_ + j_ - 1; raw[it_][j_] = (f16x8){0, 0, 0, 0, 0, 0, 0, 0}; \
                if (rr_ >= sb_ && rr_ < se_) raw[it_][j_] = *(const f16x8*)(P + (size_t)rr_ * LDP + LX + g_ * 128 + c8); } } } while (0)
    int gprev = -1;
    f16x8 wa[2][4], wx[2][4]; float bav[2], bxv[2], sp[2];
    if (ufirst + F.bid < nunits) LRU_PREFETCH(LRU_UNIT(ufirst + F.bid));
#pragma unroll 1
    for (int itu = ufirst + F.bid; itu < nunits; itu += F.G) {
        const int unit = LRU_UNIT(itu);
        int lane = lane0; tid = tid0; asm volatile("" : "+v"(lane), "+v"(tid));
        const int fr = lane & 15, fq = lane >> 4; c8 = (tid & 15) * 8;
        const int g = unit & 7, seg = (unit >> 3) % 36, b = unit / 288;
        const bool isctx = seg < 4; const int row0 = LRU_ROW0(unit);
        if (g != gprev) {
            gprev = g;
#pragma unroll
            for (int q = 0; q < 2; ++q) { const int c = wave * 2 + q, n = c >> 3, jt = c & 7, ch = g * 128 + 16 * jt + fr;
                const f16* wt = WSP(f16, WS_WLRU) + ((((size_t)li * 2 + 0) * 2 + n) * 8 + g) * 128 * 128 + (size_t)(16 * jt + fr) * 128 + 8 * fq;
#pragma unroll
                for (int ks = 0; ks < 4; ++ks) { wa[q][ks] = *(const f16x8*)(wt + 32 * ks); wx[q][ks] = *(const f16x8*)(wt + (size_t)2 * 8 * 128 * 128 + 32 * ks); }
                bav[q] = inp(21)[(size_t)li * 2 * BW + n * BW + ch]; bxv[q] = inp(23)[(size_t)li * 2 * BW + n * BW + ch];
                sp[q] = log1pf(expf(-inp(24)[(size_t)li * 2 * BW + n * BW + ch])); }
        }
        const float* cw = inp(18) + (size_t)li * 4 * BW + g * 128 + c8; const float* cb = inp(19) + (size_t)li * BW + g * 128 + c8;
#pragma unroll
        for (int it = 0; it < 2; ++it) { const int t = (it * 512 + tid) >> 4;
            float y[8];
#pragma unroll
            for (int e = 0; e < 8; ++e) { y[e] = cb[e];
#pragma unroll
                for (int j = 0; j < 4; ++j) y[e] += cw[j * BW + e] * (float)raw[it][j][e]; }
            u32x4 w; w.x = pk_f16(y[0], y[1]); w.y = pk_f16(y[2], y[3]); w.z = pk_f16(y[4], y[5]); w.w = pk_f16(y[6], y[7]);
            *(LAS u32x4*)(Xc + t * 136 + c8) = w; }
        __syncthreads();
        if (itu + F.G < nunits) LRU_PREFETCH(LRU_UNIT(itu + F.G));
#pragma unroll
        for (int q = 0; q < 2; ++q) {
            const int c = wave * 2 + q, n = c >> 3, jt = c & 7, ch = g * 128 + 16 * jt + fr;
            float carry = 0.f, aprod = 1.f;
            if (PASS == 1) {
                const float* sb = SUM + ((size_t)b * 36 * 2 + n) * 2048 + ch * 2;
                const int cnt = n == 0 ? seg : (isctx ? 3 - seg : 39 - seg);
                f32x2 pv[9];
#pragma unroll
                for (int e = 0; e < 9; ++e) { const int p = fq * 9 + e; const int s2 = n == 0 ? p : (isctx ? 3 - p : (p < 4 ? 3 - p : 39 - p));
                    pv[e] = (f32x2){1.f, 0.f}; if (p < cnt) pv[e] = *(const f32x2*)(sb + (size_t)s2 * 4096); }
                float Al = 1.f, Ul = 0.f;
#pragma unroll
                for (int e = 0; e < 9; ++e) { Ul = Ul * pv[e].x + pv[e].y; Al *= pv[e].x; }
#pragma unroll
                for (int gg = 0; gg < 4; ++gg) { const float Ag = __shfl(Al, gg * 16 + fr), Ug = __shfl(Ul, gg * 16 + fr); carry = carry * Ag + Ug; }
                __builtin_amdgcn_sched_barrier(0);
            }
            float av_[4][4], uv_[4][4];
#pragma unroll
            for (int tt = 0; tt < 4; ++tt) {
                f32x4 racc = (f32x4){0.f, 0.f, 0.f, 0.f}, iacc = (f32x4){0.f, 0.f, 0.f, 0.f}; f16x8 a4[4];
#pragma unroll
                for (int ks = 0; ks < 4; ++ks) a4[ks] = *(const LAS f16x8*)(Xc + (16 * tt + fr) * 136 + 32 * ks + 8 * fq);
                __builtin_amdgcn_sched_barrier(0);
#pragma unroll
                for (int ks = 0; ks < 4; ++ks) { racc = mfma16(a4[ks], wa[q][ks], racc); iacc = mfma16(a4[ks], wx[q][ks], iacc); }
#pragma unroll
                for (int r = 0; r < 4; ++r) { const int t = 16 * tt + 4 * fq + r; const float rg = sigmoidf_(racc[r] + bav[q]), ig = sigmoidf_(iacc[r] + bxv[q]);
                    const float log_a = -8.0f * rg * sp[q]; av_[tt][r] = __expf(log_a);
                    const float y2 = 2.0f * log_a;
                    const float om = y2 > -0.125f ? -y2 * (1.0f + y2 * (0.5f + y2 * (0.16666667f + y2 * (0.041666668f + y2 * 0.0083333338f)))) : 1.0f - __expf(y2);
                    uv_[tt][r] = __builtin_amdgcn_sqrtf(om) * ig * (float)Xc[t * 136 + 16 * jt + fr]; }
                if (tt & 1) __builtin_amdgcn_sched_barrier(0);
            }
#pragma unroll
            for (int k = 0; k < 4; ++k) {
                const int tt = n ? 3 - k : k;
                float a4[4], u4[4];
#pragma unroll
                for (int r = 0; r < 4; ++r) { a4[r] = n ? av_[3 - k][r] : av_[k][r]; u4[r] = n ? uv_[3 - k][r] : uv_[k][r]; }
                float Al = 1.f, Ul = 0.f;
#pragma unroll
                for (int rr = 0; rr < 4; ++rr) { const float ar = n ? a4[3 - rr] : a4[rr], ur = n ? u4[3 - rr] : u4[rr]; Ul = Ul * ar + ur; Al *= ar; }
                float preA = 1.f, preU = 0.f, totA = 1.f, totU = 0.f;
#pragma unroll
                for (int gg = 0; gg < 4; ++gg) { const int gsrc = n ? 3 - gg : gg; const float Ag = __shfl(Al, gsrc * 16 + fr), Ug = __shfl(Ul, gsrc * 16 + fr);
                    const bool before = n ? (gsrc > fq) : (gsrc < fq);
                    if (before) { preU = preU * Ag + Ug; preA *= Ag; }
                    totU = totU * Ag + Ug; totA *= Ag; }
                float hrun = carry * preA + preU, arun = aprod * preA;
#pragma unroll
                for (int rr = 0; rr < 4; ++rr) { const float ar = n ? a4[3 - rr] : a4[rr], ur = n ? u4[3 - rr] : u4[rr]; hrun = ar * hrun + ur; arun *= ar;
                    const int e_ = (n * 64 + 16 * tt + 4 * fq + (n ? 3 - rr : rr)) * 128 + 16 * jt + fr;
                    if (PASS == 1) Hs[e_] = hrun;
                    else { ((LAS f16*)Hs)[e_] = (f16)hrun; ((LAS f16*)Hs)[16384 + e_] = (f16)arun; } }
                carry = carry * totA + totU; aprod *= totA;
            }
            if (PASS == 0 && fq == 0) { f32x2 v = {aprod, carry}; *(f32x2*)(SUM + (((size_t)b * 36 + seg) * 2 + n) * 2048 + ch * 2) = v; }
            __builtin_amdgcn_sched_barrier(0);
        }
        __syncthreads();
        if (PASS == 0) {
            f16* LH = WSP(f16, WS_LH); f16* LAC = WSP(f16, WS_LAC);
#pragma unroll
            for (int it = 0; it < 2; ++it) { const int t = (it * 512 + tid) >> 4; const size_t ro = ((size_t)(row0 + t) * 2) * BW + g * 128 + c8;
#pragma unroll
                for (int n = 0; n < 2; ++n) { *(u32x4*)(LH + ro + n * BW) = *(const LAS u32x4*)((LAS f16*)Hs + (n * 64 + t) * 128 + c8); *(u32x4*)(LAC + ro + n * BW) = *(const LAS u32x4*)((LAS f16*)Hs + 16384 + (n * 64 + t) * 128 + c8); } }
            __syncthreads();
        }
        if (PASS == 1) {
            f16* Y = WSP(f16, WS_Y) + (size_t)2 * MT * BW;
#pragma unroll
            for (int it = 0; it < 2; ++it) { const int t = (it * 512 + tid) >> 4; const int row = row0 + t;
                const f16x8 gg = *(const f16x8*)(P + (size_t)row * LDP + LG + g * 128 + c8);
                float y[8];
#pragma unroll
                for (int e = 0; e < 8; ++e) y[e] = (Hs[t * 128 + c8 + e] + Hs[(64 + t) * 128 + c8 + e]) * (float)gg[e];
                u32x4 w; w.x = pk_f16(y[0], y[1]); w.y = pk_f16(y[2], y[3]); w.z = pk_f16(y[4], y[5]); w.w = pk_f16(y[6], y[7]);
                *(u32x4*)(Y + (size_t)row * BW + g * 128 + c8) = w; }
            __syncthreads();
        }
    }
#undef LRU_UNIT
#undef LRU_ROW0
#undef LRU_SBEG
#undef LRU_SEND
#undef LRU_PREFETCH
}


__device__ __forceinline__ void lru_fix_block(Frame& F, int li, bool latent_only, int tfirst, int tlimit) {
    LAS float* cs = (LAS float*)F.lds;
    const f16* P = WSP(f16, WS_P); const float* SUM = WSP(float, WS_LSUM); const f16* LH = WSP(f16, WS_LH); const f16* LAC = WSP(f16, WS_LAC); f16* Y = WSP(f16, WS_Y) + (size_t)2 * MT * BW;
    const int tid = F.tid, c8 = (tid & 15) * 8;
    const int CH = latent_only ? 4 : 3, nch = latent_only ? 8 : 12;
#pragma unroll 1
    for (int t = tfirst + F.bid; t < tlimit; t += F.G) {
        const int g = t & 7, c = (t >> 3) % nch, b = t / (8 * nch), seg0 = latent_only ? 4 + 4 * c : 3 * c;
        if (tid < 256) { const int n = tid >> 7, ch = g * 128 + (tid & 127);
            const float* sb = SUM + ((size_t)b * 36 * 2 + n) * 2048 + ch * 2;
            const unsigned o0 = (unsigned)((((b * 36 * 2 + n) * 2048) + ch * 2) * 4);
            float carry = 0.f;
#pragma unroll
            for (int hq = 0; hq < 2; ++hq) {
                f32x2 sv[18];
#pragma unroll
                for (int qq = 0; qq < 18; ++qq) { const int q = hq * 18 + qq; const int s2 = n == 0 ? q : (q < 4 ? 3 - q : 39 - q); sv[qq] = *(const f32x2*)((const char*)SUM + (o0 + (unsigned)s2 * 16384u)); }
#pragma unroll
                for (int qq = 0; qq < 18; ++qq) { const int q = hq * 18 + qq; const int s2 = n == 0 ? q : (q < 4 ? 3 - q : 39 - q);
                    if (s2 >= seg0 && s2 < seg0 + CH) cs[((s2 - seg0) * 2 + n) * 128 + (tid & 127)] = carry;
                    carry = carry * sv[qq].x + sv[qq].y; }
            }
        }
        f16x8 Lb[2][2][5];
#define FIX_LOAD(k_, buf_) do { const int seg_ = seg0 + (k_); const int row0_ = seg_ < 4 ? ML + b * CTXL + seg_ * 64 : b * SEQ + (seg_ - 4) * 64; \
        _Pragma("unroll") for (int it_ = 0; it_ < 2; ++it_) { const int row_ = row0_ + ((it_ * 512 + tid) >> 4); const size_t ro_ = ((size_t)row_ * 2) * BW + g * 128 + c8; \
            Lb[buf_][it_][0] = *(const f16x8*)(LH + ro_); Lb[buf_][it_][1] = *(const f16x8*)(LH + ro_ + BW); Lb[buf_][it_][2] = *(const f16x8*)(LAC + ro_); Lb[buf_][it_][3] = *(const f16x8*)(LAC + ro_ + BW); \
            Lb[buf_][it_][4] = *(const f16x8*)(P + (size_t)row_ * LDP + LG + g * 128 + c8); } } while (0)
        FIX_LOAD(0, 0);
        __syncthreads();
#pragma unroll
        for (int k = 0; k < 4; ++k) if (k < CH) {
            if (k + 1 < CH) FIX_LOAD(k + 1, (k + 1) & 1);
            const int seg = seg0 + k; const int row0 = seg < 4 ? ML + b * CTXL + seg * 64 : b * SEQ + (seg - 4) * 64;
            const LAS float* cf = cs + (k * 2) * 128 + c8; const LAS float* cb = cf + 128;
#pragma unroll
            for (int it = 0; it < 2; ++it) { const int row = row0 + ((it * 512 + tid) >> 4);
                const f16x8 hf = Lb[k & 1][it][0], hb = Lb[k & 1][it][1], af = Lb[k & 1][it][2], ab = Lb[k & 1][it][3], gg = Lb[k & 1][it][4];
                float y[8];
#pragma unroll
                for (int e = 0; e < 8; ++e) y[e] = ((float)hf[e] + (float)af[e] * cf[e] + (float)hb[e] + (float)ab[e] * cb[e]) * (float)gg[e];
                u32x4 w; w.x = pk_f16(y[0], y[1]); w.y = pk_f16(y[2], y[3]); w.z = pk_f16(y[4], y[5]); w.w = pk_f16(y[6], y[7]);
                *(u32x4*)(Y + (size_t)row * BW + g * 128 + c8) = w; }
        }
#undef FIX_LOAD
        __syncthreads();
    }
}

__device__ __forceinline__ void na_item(Frame& F, int li, bool lat, int b, int rr, int hpair, int& staged_hp) {
    constexpr int KB = 34816, VB = 36864, BUF = KB + VB;
    const int lane = F.lane, wave = F.wave, fr = lane & 15, fq = lane >> 4, tid = F.tid;
    const int i = wave & 3, hs = wave >> 2, h = hpair * 2 + hs;
    const f16* P = WSP(f16, WS_P); f16* Y = WSP(f16, WS_Y) + (size_t)1 * MT * BW;
    LAS float* rtab = (LAS float*)(F.lds + 2 * BUF);
    if (staged_hp != hpair) { staged_hp = hpair; for (int i_ = tid; i_ < 2 * 465; i_ += 512) rtab[i_] = inp(17)[((size_t)li * 8 + hpair * 2) * 465 + i_]; }
    const LAS float* rpb = rtab + hs * 465;
    const int q0row = lat ? b * SEQ + rr * 64 + 16 * i : ML + b * CTXL + rr * 64 + 16 * i;
    f16x8 qf[4];
#pragma unroll
    for (int ks = 0; ks < 4; ++ks) qf[ks] = *(const f16x8*)(P + (size_t)(q0row + fr) * LDP + NQ + h * 128 + 32 * ks + 8 * fq);
    f32x4 oacc[8];
#pragma unroll
    for (int dt = 0; dt < 8; ++dt) oacc[dt] = (f32x4){0.f, 0.f, 0.f, 0.f};
    float m_run = -INFINITY, l_run = 0.f;
    const int c0 = min(max(16 * i - 8, 0), 32), rs = min(max(rr - 4, 0), 24), qc = 16 * i + fr, cs = min(max(qc - 8, 0), 48);
    const int nstep = lat ? 12 : 4, nwin = lat ? 8 : 0;
#define NA_ROWBASE(st) ((st) < nwin ? b * SEQ + (rs + (st)) * 64 : ML + b * CTXL + ((st) - nwin) * 64)
    f16x8 preA[8], preB[8];
    const __amdgpu_buffer_rsrc_t rsP = __builtin_amdgcn_make_buffer_rsrc((void*)P, 0, 0x7ffff000, 0x00020000);
    const unsigned na_vo = (unsigned)(((tid >> 4) * LDP + (tid & 15) * 8) * 2);
#define NA_LOAD(pre, st) do { const unsigned so_ = (unsigned)__builtin_amdgcn_readfirstlane(NA_ROWBASE(st)) * (unsigned)(LDP * 2) + (unsigned)(hpair * 2 * 128 * 2); _Pragma("unroll") for (int it_ = 0; it_ < 8; ++it_) \
        pre[it_] = __builtin_bit_cast(f16x8, __builtin_amdgcn_raw_buffer_load_b128(rsP, na_vo, so_ + (unsigned)((32 * (it_ & 1) * LDP + ((it_ >> 2) ? NV : NK) + ((it_ >> 1) & 1) * 128) * 2), 0)); } while (0)
#define NA_STORE(pre, buf) do { _Pragma("unroll") for (int it_ = 0; it_ < 8; ++it_) { const int id_ = it_ * 512 + tid, rem_ = id_ & 2047, hs_ = rem_ >> 10, key_ = (rem_ >> 4) & 63, ch_ = rem_ & 15; \
        LAS f16* d_ = (LAS f16*)(F.lds + (buf) * BUF + ((id_ >> 11) ? KB + (hs_ * 64 + key_) * 288 : (hs_ * 64 + key_) * 272)) + ch_ * 8; *(LAS f16x8*)d_ = pre[it_]; } } while (0)
    NA_LOAD(preA, 0); NA_LOAD(preB, 1); NA_STORE(preA, 0);
    __syncthreads();
#pragma unroll 1
    for (int st2 = 0; st2 < nstep; st2 += 2) {
#pragma unroll
      for (int par = 0; par < 2; ++par) {
        const int st = st2 + par, cur = par;
        const bool win = st < nwin;
        float bv[8];
        { const LAS float* rrow = rpb + min(rs + st - rr + 7, 14) * 31;
#pragma unroll
            for (int nt = 0; nt < 2; ++nt)
#pragma unroll
                for (int r = 0; r < 4; ++r) { const int kc = c0 + 16 * nt + 4 * fq + r; bv[nt * 4 + r] = rrow[min(max(kc - qc + 15, 0), 30)]; } }
        __builtin_amdgcn_sched_barrier(0);
        { const int stn = min(st + 2, nstep - 1); if (par == 0) NA_LOAD(preA, stn); else NA_LOAD(preB, stn); }
        __builtin_amdgcn_sched_barrier(0);
        const LAS f16* Kb = (const LAS f16*)(F.lds + cur * BUF) + hs * 64 * 136;
        const LAS f16* Vb = (const LAS f16*)(F.lds + cur * BUF + KB) + hs * 64 * 144;
        const int nsub = win ? 1 : 2;
#pragma unroll 1
        for (int sub = 0; sub < nsub; ++sub) {
            const int koff = win ? c0 : 32 * sub;
            f16x8 kf[2][4];
#pragma unroll
            for (int nt = 0; nt < 2; ++nt)
#pragma unroll
                for (int ks = 0; ks < 4; ++ks) kf[nt][ks] = *(const LAS f16x8*)(Kb + (koff + 16 * nt + fr) * 136 + 32 * ks + 8 * fq);
            f32x4 sacc[2];
#pragma unroll
            for (int nt = 0; nt < 2; ++nt) { sacc[nt] = (f32x4){0.f, 0.f, 0.f, 0.f};
#pragma unroll
                for (int ks = 0; ks < 4; ++ks) sacc[nt] = mfma16(kf[nt][ks], qf[ks], sacc[nt]); }
            float sv[8]; float bm = -INFINITY;
#pragma unroll
            for (int nt = 0; nt < 2; ++nt)
#pragma unroll
                for (int r = 0; r < 4; ++r) { const int kc = c0 + 16 * nt + 4 * fq + r; const bool valid = !win || (kc >= cs && kc < cs + 16);
                    const float x = valid ? sacc[nt][r] + (win ? bv[nt * 4 + r] : 0.f) : -INFINITY;
                    sv[nt * 4 + r] = x; bm = fmaxf(bm, x); }
            bm = fmaxf(bm, bperm_f(lane ^ 16, bm)); bm = fmaxf(bm, bperm_f(lane ^ 32, bm));
            const float m_new = fmaxf(m_run, bm), alpha = __expf(m_run - m_new);
            float ps = 0.f;
#pragma unroll
            for (int e = 0; e < 8; ++e) { sv[e] = __expf(sv[e] - m_new); ps += sv[e]; }
            ps += bperm_f(lane ^ 16, ps); ps += bperm_f(lane ^ 32, ps);
            l_run = l_run * alpha + ps; m_run = m_new;
            f16x8 pf;
#pragma unroll
            for (int e = 0; e < 8; ++e) pf[e] = (f16)sv[e];
            const LAS f16* vb = Vb + (koff + 4 * fq + (fr >> 2)) * 144 + 4 * (fr & 3);
#pragma unroll
            for (int dt = 0; dt < 8; ++dt) { oacc[dt] = oacc[dt] * alpha;
                const f16x4 alo = lds_tr4(vb + 16 * dt), ahi = lds_tr4(vb + 16 * 144 + 16 * dt);
                const f16x8 a = __builtin_shufflevector(alo, ahi, 0, 1, 2, 3, 4, 5, 6, 7);
                oacc[dt] = mfma16(a, pf, oacc[dt]); }
        }
        if (st + 1 < nstep) { if (par == 0) NA_STORE(preB, 1); else NA_STORE(preA, 0); }
        __syncthreads();
      }
    }
#undef NA_ROWBASE
#undef NA_LOAD
#undef NA_STORE
    const float inv = 1.0f / l_run;
    LAS f16* Ot = (LAS f16*)(F.lds + wave * 4352);
#pragma unroll
    for (int dt = 0; dt < 8; ++dt) { u32x2 w; w.x = pk_f16(oacc[dt][0] * inv, oacc[dt][1] * inv); w.y = pk_f16(oacc[dt][2] * inv, oacc[dt][3] * inv);
        *(LAS u32x2*)(Ot + fr * 136 + 16 * dt + 4 * fq) = w; }
    { const int row = lane >> 2, seg = lane & 3;
#pragma unroll
      for (int c = 0; c < 4; ++c) { const u32x4 w = *(const LAS u32x4*)(Ot + row * 136 + seg * 32 + c * 8);
          *(u32x4*)(Y + (size_t)(q0row + row) * BW + h * 128 + seg * 32 + c * 8) = w; } }
    __syncthreads();
}


__device__ __forceinline__ void mlstm_gate_scan(Frame& F, int li, int seq) {
    const int dir = seq & 1, h = (seq >> 1) & 3, b = seq >> 3, lane = F.lane;
    const float* G = WSP(float, WS_G); float* GS = WSP(float, WS_GS) + (size_t)seq * 36 * 320; float* GD = WSP(float, WS_GS + 3 * 512 * 1024) + seq * 36;
    const float bi_ = inp(14)[(li * 2 + dir) * 4 + h], bf_ = inp(15)[(li * 2 + dir) * 4 + h];
    float m_prev = -INFINITY;
#pragma unroll 1
    for (int j = 0; j < 36; ++j) {
        const bool isctx = j < 4; const int base = isctx ? ML + b * CTXL : b * SEQ, len = isctx ? CTXL : SEQ, off = isctx ? j * 64 : (j - 4) * 64;
        const int row = base + (dir ? len - 1 - (off + lane) : off + lane);
        const float igv = G[(size_t)row * 16 + dir * 8 + h] + bi_; const float fp = G[(size_t)row * 16 + dir * 8 + 4 + h] + bf_;
        float cum = fminf(fp, 0.f) - log1pf(expf(-fabsf(fp)));
#pragma unroll
        for (int d = 1; d < 64; d <<= 1) { const float t = bperm_f((lane - d) & 63, cum); if (lane >= d) cum += t; }
        const float a = igv - cum; float R = a;
#pragma unroll
        for (int d = 1; d < 64; d <<= 1) { const float t = bperm_f((lane - d) & 63, R); if (lane >= d) R = fmaxf(R, t); }
        R = fmaxf(R, m_prev);
        const float mrow = cum + R, m_new = __shfl(mrow, 63), cl = __shfl(cum, 63);
        float* o = GS + j * 320 + lane;
        o[0] = a; o[64] = R; o[128] = expf(m_prev - R); o[192] = expf(-mrow); o[256] = expf(cl + a - m_new);
        if (lane == 0) GD[j] = expf(cl + m_prev - m_new);
        m_prev = m_new;
    }
}


__device__ __forceinline__ void mlstm_unit5(Frame& F, int li, int unit, bool ctx_out) {
    const int vs = unit & 3, dir = (unit >> 2) & 1, h = (unit >> 3) & 3, b = unit >> 5, seq = unit >> 2;
    constexpr int QS = 0, KS = 33792, VS = 67584, SC = 78848, C16 = 88064, VEC = 130304, NVT = 5, VP = 88;
    LAS f16* Qs = (LAS f16*)(F.lds + QS); LAS f16* Ks = (LAS f16*)(F.lds + KS); LAS f16* Vs = (LAS f16*)(F.lds + VS);
    LAS f16* Sc = (LAS f16*)(F.lds + SC); LAS f16* Cs = (LAS f16*)(F.lds + C16);
    LAS float* gv = (LAS float*)(F.lds + VEC);
    LAS float* av = gv; LAS float* Rv = gv + 64; LAS float* interv = gv + 128; LAS float* eneg = gv + 192; LAS f16* w16 = (LAS f16*)(gv + 320); LAS float* misc = gv + 352;
    const f16* P = WSP(f16, WS_P); f16* HMD = WSP(f16, WS_HMD) + (size_t)dir * MT * BW;
    const float* GS = WSP(float, WS_GS) + (size_t)seq * 36 * 320; const float* GD = WSP(float, WS_GS + 3 * 512 * 1024) + seq * 36;
    const int lane = F.lane, wave = F.wave, fr = lane & 15, fq = lane >> 4, tid = F.tid;
    for (int i = tid; i < 80 * 264; i += 512) Cs[i] = (f16)0.f;
    for (int i = tid; i < 64 * 16; i += 512) Vs[(i >> 4) * VP + 64 + (i & 15)] = ((i & 15) == 0) ? (f16)1.f : (f16)0.f;
    f32x4 Cacc[NVT][2];
#pragma unroll
    for (int vt = 0; vt < NVT; ++vt)
#pragma unroll
        for (int nt = 0; nt < 2; ++nt) Cacc[vt][nt] = (f32x4){0.f, 0.f, 0.f, 0.f};
#define MROWJ(j, s) (((j) < 4 ? ML + b * CTXL : b * SEQ) + (dir ? ((j) < 4 ? CTXL : SEQ) - 1 - (((j) < 4 ? (j) * 64 : ((j) - 4) * 64) + (s)) : ((j) < 4 ? (j) * 64 : ((j) - 4) * 64) + (s)))
    f16x8 qreg[4], kreg[4], vreg; float greg = 0.f, dreg = 0.f;
#define ML_PREFETCH(j) do { \
        _Pragma("unroll") for (int it = 0; it < 4; ++it) { const int i_ = it * 512 + tid, s_ = i_ >> 5, c8_ = i_ & 31; const size_t ro_ = (size_t)MROWJ(j, s_) * LDP + h * 256 + c8_ * 8; \
            qreg[it] = *(const f16x8*)(P + ro_ + PQ); kreg[it] = *(const f16x8*)(P + ro_ + PK); } \
        vreg = *(const f16x8*)(P + (size_t)MROWJ(j, tid >> 3) * LDP + PV + h * 256 + vs * 64 + (tid & 7) * 8); \
        if (tid < 320) greg = GS[(j) * 320 + tid]; \
        if (tid == 320) dreg = GD[j]; } while (0)
    ML_PREFETCH(0);
    __syncthreads();
#pragma unroll 1
    for (int j = 0; j < 36; ++j) {
        const bool isctx = j < 4;
#pragma unroll
        for (int it = 0; it < 4; ++it) { const int i = it * 512 + tid, s = i >> 5, c8 = i & 31;
            *(LAS f16x8*)(Qs + s * 264 + c8 * 8) = qreg[it]; *(LAS f16x8*)(Ks + s * 264 + c8 * 8) = kreg[it]; }
        *(LAS f16x8*)(Vs + (tid >> 3) * VP + (tid & 7) * 8) = vreg;
        if (tid < 320) { gv[tid] = greg; if (tid >= 256) w16[tid - 256] = (f16)greg; }
        if (tid == 320) misc[0] = dreg;
        __syncthreads();
        if (j + 1 < 36) ML_PREFETCH(j + 1);
        const bool need_out = !isctx || ctx_out;
        f32x4 nacc[NVT];
        if (need_out) {
            if (wave >= 4) {
                const int i = wave - 4; f32x4 sacc[4];
#pragma unroll
                for (int st = 0; st < 4; ++st) sacc[st] = (f32x4){0.f, 0.f, 0.f, 0.f};
#pragma unroll
                for (int ks = 0; ks < 8; ++ks) {
                    const f16x8 qa = *(const LAS f16x8*)(Qs + (16 * i + fr) * 264 + 32 * ks + 8 * fq); f16x8 kb[4];
#pragma unroll
                    for (int st = 0; st < 4; ++st) kb[st] = *(const LAS f16x8*)(Ks + (16 * st + fr) * 264 + 32 * ks + 8 * fq);
                    __builtin_amdgcn_sched_barrier(0);
#pragma unroll
                    for (int st = 0; st < 4; ++st) sacc[st] = mfma16(qa, kb[st], sacc[st]);
                    __builtin_amdgcn_sched_barrier(0); }
                const f32x4 Rt = *(const LAS f32x4*)(Rv + 16 * i + 4 * fq);
#pragma unroll
                for (int st = 0; st < 4; ++st) { const int sidx = 16 * st + fr; const float as = av[sidx];
#pragma unroll
                    for (int r = 0; r < 4; ++r) { const int t = 16 * i + 4 * fq + r; const float e = __expf(fminf(as - Rt[r], 0.f)); const float msk = sidx <= t ? 1.f : 0.f;
                        Sc[t * 72 + sidx] = (f16)(sacc[st][r] * msk * e); } }
            } else {
                const int i = wave;
#pragma unroll
                for (int vt = 0; vt < NVT; ++vt) nacc[vt] = (f32x4){0.f, 0.f, 0.f, 0.f};
#pragma unroll
                for (int ks = 0; ks < 8; ++ks) {
                    const f16x8 qa = *(const LAS f16x8*)(Qs + (16 * i + fr) * 264 + 32 * ks + 8 * fq); f16x8 cb[NVT];
#pragma unroll
                    for (int vt = 0; vt < NVT; ++vt) cb[vt] = *(const LAS f16x8*)(Cs + (16 * vt + fr) * 264 + 32 * ks + 8 * fq);
                    __builtin_amdgcn_sched_barrier(0);
#pragma unroll
                    for (int vt = 0; vt < NVT; ++vt) nacc[vt] = mfma16(qa, cb[vt], nacc[vt]);
                    __builtin_amdgcn_sched_barrier(0); }
#pragma unroll
                for (int r = 0; r < 4; ++r) { const float sc_ = interv[16 * i + 4 * fq + r];
#pragma unroll
                    for (int vt = 0; vt < NVT; ++vt) nacc[vt][r] *= sc_; }
            }
        }
        __syncthreads();
        f16x8 vf[2][NVT];
#pragma unroll
        for (int k2 = 0; k2 < 2; ++k2)
#pragma unroll
            for (int vt = 0; vt < NVT; ++vt) { const LAS f16* p = Vs + (32 * k2 + 8 * fq + (fr >> 2)) * VP + 16 * vt + 4 * (fr & 3);
                const f16x4 lo = lds_tr4(p), hi = lds_tr4(p + 4 * VP); vf[k2][vt] = __builtin_shufflevector(lo, hi, 0, 1, 2, 3, 4, 5, 6, 7); }
        if (need_out && wave < 4) {
            const int i = wave;
#pragma unroll
            for (int k2 = 0; k2 < 2; ++k2) { const f16x8 a = *(const LAS f16x8*)(Sc + (16 * i + fr) * 72 + 32 * k2 + 8 * fq);
#pragma unroll
                for (int vt = 0; vt < NVT; ++vt) nacc[vt] = mfma16(a, vf[k2][vt], nacc[vt]); }
#pragma unroll
            for (int r = 0; r < 4; ++r) { const int t = 16 * i + 4 * fq + r; const float dn = __shfl(nacc[4][r], lane & 48); const float inv = __builtin_amdgcn_rcpf(fmaxf(fabsf(dn), eneg[t]));
                f16* hp = HMD + (size_t)MROWJ(j, t) * BW + h * 256 + vs * 64 + fr;
                hp[0] = (f16)(nacc[0][r] * inv); hp[16] = (f16)(nacc[1][r] * inv); hp[32] = (f16)(nacc[2][r] * inv); hp[48] = (f16)(nacc[3][r] * inv); }
        }
        { const float decay = misc[0];
#pragma unroll
          for (int vt = 0; vt < NVT; ++vt)
#pragma unroll
              for (int nt = 0; nt < 2; ++nt) Cacc[vt][nt] = Cacc[vt][nt] * decay;
#pragma unroll
          for (int k2 = 0; k2 < 2; ++k2) { const f16x8 wf = *(const LAS f16x8*)(w16 + 32 * k2 + 8 * fq);
#pragma unroll
              for (int nt = 0; nt < 2; ++nt) { const LAS f16* p = Ks + (32 * k2 + 8 * fq + (fr >> 2)) * 264 + 32 * wave + 16 * nt + 4 * (fr & 3);
                  const f16x4 lo = lds_tr4(p), hi = lds_tr4(p + 4 * 264); const f16x8 bk = __builtin_shufflevector(lo, hi, 0, 1, 2, 3, 4, 5, 6, 7);
#pragma unroll
                  for (int vt = 0; vt < NVT; ++vt) Cacc[vt][nt] = mfma16(vf[k2][vt] * wf, bk, Cacc[vt][nt]); } }
#pragma unroll
          for (int vt = 0; vt < NVT; ++vt)
#pragma unroll
              for (int nt = 0; nt < 2; ++nt)
#pragma unroll
                  for (int r = 0; r < 4; ++r) Cs[(16 * vt + 4 * fq + r) * 264 + 32 * wave + 16 * nt + fr] = (f16)Cacc[vt][nt][r]; }
        __syncthreads();
    }
#undef MROWJ
#undef ML_PREFETCH
}

__device__ __forceinline__ void phase_finish(int li_v) {
    Frame F = make_frame(); const int li = UNI(li_v); const int M = li == DEPTH - 1 ? ML : MT;
    const int gw = F.bid * 8 + F.wave, NGW = F.G * 8;
    const f16* P = WSP(f16, WS_P); const f16* HMD = WSP(f16, WS_HMD); const float* HL = WSP(float, WS_PART); f16* Y = WSP(f16, WS_Y);
    const float* gn = inp(16) + (size_t)li * BW;
    for (int row = gw; row < M; row += NGW) {
#pragma unroll
        for (int hh = 0; hh < 4; ++hh) { const int c = hh * 256 + 4 * F.lane;
            const f16x4 a = *(const f16x4*)(HMD + (size_t)row * BW + c), bq = *(const f16x4*)(HMD + ((size_t)MT + row) * BW + c);
            const f32x4 s = (f32x4){(float)a[0] + (float)bq[0], (float)a[1] + (float)bq[1], (float)a[2] + (float)bq[2], (float)a[3] + (float)bq[3]}; const float ss = wave_sum((s.x * s.x + s.y * s.y) + (s.z * s.z + s.w * s.w), F.lane);
            const float rstd = rsqrtf(ss * (1.0f / 256.0f) + EPS);
            const f16x4 og = *(const f16x4*)(P + (size_t)row * LDP + PO + c); const f32x4 g = *(const f32x4*)(gn + c);
            u32x2 w; w.x = pk_f16((float)og[0] * s.x * rstd * g.x, (float)og[1] * s.y * rstd * g.y); w.y = pk_f16((float)og[2] * s.z * rstd * g.z, (float)og[3] * s.w * rstd * g.w);
            *(u32x2*)(Y + (size_t)row * BW + c) = w; }
    }
}

constexpr int REP_MIX = 1, REP_L1 = 1, REP_NA = 1, REP_ML = 1; constexpr int REP_GATE = 1, REP_RES = 1, REP_BAR = 0; constexpr int REP_PRO = 1, REP_G1 = 1, REP_G3 = 1, REP_ADALN = 1, REP_LRU0 = 1, REP_FIN = 1;
constexpr int NPL = 13, PH_FINAL = 1 + DEPTH * NPL, NPHASE = PH_FINAL + 1;
__device__ __forceinline__ void ph_gemm_swiglu(int li_v, int which_v) {
    Frame F = make_frame(); const int li = UNI(li_v), which = UNI(which_v);
    unsigned char* wl = F.ws + WS_W + (size_t)li * WL_SIZE; const int M = (which == 1 && li == DEPTH - 1) ? ML : MT;
    pg8::Gemm g{WSP(f16, WS_H), (const f16*)(wl + (which ? WL_W3 : WL_W1)), M, 2 * DFF, D, D}; pg8::StaticOrder S; S.init(M, 2 * DFF, F.G, F.bid);
    EpiSwiGLU E{WSP(f16, WS_P)}; pg8::gemm_phase<EpiSwiGLU, pg8::StaticOrder, true, true>(F.lds, g, S, E, F.tid);
}
__device__ __forceinline__ void ph_gemm_resid(int li_v, int which_v, float cmul = 1.0f) {
    Frame F = make_frame(); const int li = UNI(li_v), which = UNI(which_v);
    unsigned char* wl = F.ws + WS_W + (size_t)li * WL_SIZE;
    const float* modl = WSP(float, WS_MOD) + (size_t)li * 5 * NMODC + (2 + 3 * which) * D;
    const f16* A = which == 1 ? WSP(f16, WS_MH) : WSP(f16, WS_P); const f16* Bt = (const f16*)(wl + (which == 0 ? WL_W2 : which == 1 ? WL_WOUT : WL_W4));
    const int K = which == 1 ? D : DFF;
    pg8::Gemm g{A, Bt, ML, D, K, K}; pg8::StaticOrder S; S.init(ML, D, F.G, F.bid);
    const bool first = li == 0 && which == 0;
    EpiResid E{WSP(f16, WS_X), modl, which == 1 ? 0 : 1, first ? inp(0) : nullptr}; pg8::gemm_phase<EpiResid, pg8::StaticOrder, true, true>(F.lds, g, S, E, F.tid);
}
__device__ __forceinline__ void ph_gemm_resid_ctx(int li_v, int which_v) {
    Frame F = make_frame(); const int li = UNI(li_v), which = UNI(which_v);
    if (which >= 1 && li == DEPTH - 1) return;
    unsigned char* wl = F.ws + WS_W + (size_t)li * WL_SIZE;
    const float* modl = WSP(float, WS_MOD) + (size_t)li * 5 * NMODC + (2 + 3 * which) * D;
    const f16* A = which == 1 ? WSP(f16, WS_MH) : WSP(f16, WS_P); const f16* Bt = (const f16*)(wl + (which == 0 ? WL_W2 : which == 1 ? WL_WOUT : WL_W4));
    const int K = which == 1 ? D : DFF;
    pg8::Gemm g{A, Bt, MT, D, K / 4, K}; pg8::CtxSplitOrder S{F.bid, F.G};
    EpiResidPart E{WSP(float, WS_PART), modl, which == 1 ? 1.0f : 0.5f}; pg8::gemm_phase<EpiResidPart, pg8::CtxSplitOrder, false, true>(F.lds, g, S, E, F.tid);
}
__device__ __forceinline__ void ph_gemm_proj(int li_v) {
    Frame F = make_frame(); const int li = UNI(li_v);
    unsigned char* wl = F.ws + WS_W + (size_t)li * WL_SIZE;
    pg8::Gemm g{WSP(f16, WS_H), (const f16*)(wl + WL_WIN), MT, NPIN, D, D};
    EpiProj E{WSP(f16, WS_P), WSP(float, WS_G), WSP(float, WS_ROPE)};
    if (li == DEPTH - 1) { pg8::ProjLastOrder S{F.G, F.bid}; pg8::gemm_phase<EpiProj, pg8::ProjLastOrder, true, true>(F.lds, g, S, E, F.tid); }
    else { pg8::StaticOrder S; S.init(MT, NPIN, F.G, F.bid); pg8::gemm_phase<EpiProj, pg8::StaticOrder, true, true>(F.lds, g, S, E, F.tid); }
}
template <int MODE, int BR> __device__ __forceinline__ void ph_gemm_gate(int li_v) {
    Frame F = make_frame(); const int li = UNI(li_v);
    unsigned char* wl = F.ws + WS_W + (size_t)li * WL_SIZE; const int M = li == DEPTH - 1 ? ML : MT;
    const f16* Y = WSP(f16, WS_Y) + (size_t)BR * MT * BW; const f16* wbr = (const f16*)(wl + WL_WBR) + (size_t)BR * D * BW; const f16* gate = WSP(f16, WS_P) + GX + BR * D;
    pg8::Gemm g{Y, wbr, M, D, BW, BW}; pg8::StaticOrder S; S.init(M, D, F.G, F.bid);
    EpiGate<MODE> E{gate, WSP(f16, WS_MH)}; pg8::gemm_phase<EpiGate<MODE>, pg8::StaticOrder, true, true>(F.lds, g, S, E, F.tid);
}
__device__ __forceinline__ void phase_lru_p0(int li_v) {
    Frame F = make_frame(); const int li = UNI(li_v);
    if (F.G >= 64) {
        if (F.bid < 4) mlstm_gate_scan(F, li, F.bid * 8 + F.wave);
        else if (F.bid >= 8) { F.bid -= 8; F.G -= 8; lru_block<0>(F, li, false); }
    } else { if (F.bid * 8 + F.wave < 32) mlstm_gate_scan(F, li, F.bid * 8 + F.wave); __syncthreads(); lru_block<0>(F, li, false); }
}
#ifndef MIXSEL
#define MIXSEL 7
#endif
__device__ __forceinline__ void ph_mix_mlstm(int li_v) {
    Frame F = make_frame(); const int li = UNI(li_v); const bool last = li == DEPTH - 1; const int half = F.G >> 1;
    if (F.bid >= half) return;
    for (int rep = 0; rep < REP_ML; ++rep) for (int u = F.bid; u < 128; u += half) { mlstm_unit5(F, li, u, !last); __syncthreads(); }
}
__device__ __forceinline__ void ph_mix_na(int li_v) {
    Frame F = make_frame(); const int li = UNI(li_v); const bool last = li == DEPTH - 1; const int half = F.G >> 1;
    if (F.bid < half) return;
    F.bid -= half; F.G -= half;
    int staged_hp = -1;
    for (int rep = 0; rep < REP_NA; ++rep) { const int nna = last ? 512 : 576;
      for (int it = F.bid; it < nna; it += F.G) { const bool lat = it < 512; const int x = lat ? it : it - 512;
          const int hp = x & 3, rr = lat ? (x >> 2) & 31 : (x >> 2) & 3, b = lat ? x >> 7 : x >> 4;
          na_item(F, li, lat, b, rr, hp, staged_hp); }
      __syncthreads(); }
}
__device__ __forceinline__ void ph_mix_lru(int li_v) {
    Frame F = make_frame(); const int li = UNI(li_v); const bool last = li == DEPTH - 1; const int half = F.G >> 1;
    const int total = last ? 4 * 8 * 8 : 4 * 12 * 8, nu = total;
    if (F.bid < half) { F.G = half; for (int rep = 0; rep < REP_L1; ++rep) lru_fix_block(F, li, last, nu, total); }
    else { F.bid -= half; F.G -= half; for (int rep = 0; rep < REP_L1; ++rep) lru_fix_block(F, li, last, 0, nu); }
}
__device__ __forceinline__ void ph_mixers(int li_v) { ph_mix_mlstm(li_v); __syncthreads(); ph_mix_na(li_v); __syncthreads(); ph_mix_lru(li_v); }

__global__ void __launch_bounds__(512, 2) mega_fwd(Args args) {
    LAS unsigned char* lds = (LAS unsigned char*)lds_raw;
    const int tid = threadIdx.x;
    volatile LAS unsigned* MISC = (volatile LAS unsigned*)(lds + LDS_MISC);
    if (tid < 64) MISC[tid] = 0u;
    __syncthreads();
    unsigned* barw = (unsigned*)(args.ws + WS_CTL) + 4096;
    XcdBarrier bar; bar.bar = barw; bar.x = 0; bar.st = nullptr;
    const int lo = args.ph_lo, hi = args.ph_hi;
    if (hi - lo > 1) bar = xcd_barrier_post(barw, MISC + 8);
#define IN(k) (lo <= (k) && (k) < hi && ((PHSEL >> ((k) == 0 ? 16 : (k) == PH_FINAL ? 17 : ((k) - 1) % NPL)) & 1))
#if TPROBE
    volatile LAS unsigned long long* TACC = (volatile LAS unsigned long long*)(lds + LDS_MISC + 128);
    const bool tprobe = blockIdx.x == 0 && tid == 0;
    if (tprobe) { TACC[0] = 0ull; TACC[1] = 0ull; }
#define TBEG() do { if (tprobe) TACC[2] = __builtin_amdgcn_s_memrealtime(); } while (0)
#define TEND(g) do { if (tprobe) TACC[g] = TACC[g] + (__builtin_amdgcn_s_memrealtime() - TACC[2]); } while (0)
#else
#define TBEG() do {} while (0)
#define TEND(g) do {} while (0)
#endif
#define SEAM(k) do { if (lo <= (k) && (k) + 1 < hi) { TBEG(); xcd_barrier(bar); TEND(1); } } while (0)
    if (IN(0)) for (int rep = 0; rep < REP_PRO; ++rep) { phase_prologue(); __syncthreads(); }
    SEAM(0);
#pragma unroll 1
    for (int li = 0; li < DEPTH; ++li) {
        const int p0 = 1 + li * NPL;
        if (IN(p0 + 0)) phase_adaln(li, 0);
        SEAM(p0 + 0); for (int rep = 0; rep < REP_BAR; ++rep) SEAM(p0 + 0);
        TBEG();
        if (IN(p0 + 1)) { ph_gemm_swiglu(li, 0); __syncthreads(); ph_convert_idle(36 * 44, 6, li == 0 ? CS1 : CT1); }
        if (IN(p0 + 1)) TEND(0);
        SEAM(p0 + 1);
        TBEG();
        if (IN(p0 + 2)) { ph_gemm_resid(li, 0); ph_gemm_resid_ctx(li, 0); __syncthreads(); ph_convert_idle(128, 3, li == 0 ? CS2 : CT2); }
        if (IN(p0 + 2)) TEND(0);
        SEAM(p0 + 2);
        if (IN(p0 + 3)) phase_adaln(li, 1);
        SEAM(p0 + 3);
        TBEG();
        if (IN(p0 + 4)) { ph_gemm_proj(li); __syncthreads(); if (li == 0) ph_convert_idle(36 * 61, 6, CS3); }
        if (IN(p0 + 4)) TEND(0);
        SEAM(p0 + 4);
        if (IN(p0 + 5)) for (int rep = 0; rep < REP_LRU0; ++rep) { phase_lru_p0(li); __syncthreads(); }
        SEAM(p0 + 5);
        if (IN(p0 + 6)) for (int rep = 0; rep < REP_MIX; ++rep) { ph_mixers(li); __syncthreads(); if (li == 0) ph_convert_idle(384, CSM_Q, CSM); }
        SEAM(p0 + 6);
        TBEG();
        if (IN(p0 + 7)) { phase_finish(li); __syncthreads(); ph_gemm_gate<0, 1>(li); ph_gemm_gate<1, 2>(li); __syncthreads(); if (li == 0) ph_convert_idle(288, 6, CS4); }
        if (IN(p0 + 7)) TEND(0);
        SEAM(p0 + 7);
        TBEG();
        if (IN(p0 + 8)) { ph_gemm_gate<2, 0>(li); __syncthreads(); if (li == 0) ph_convert_idle(288, 3, CS5); }
        if (IN(p0 + 8)) TEND(0);
        SEAM(p0 + 8);
        TBEG();
        if (IN(p0 + 9)) { ph_gemm_resid(li, 1); ph_gemm_resid_ctx(li, 1); __syncthreads(); if (li == 0) ph_convert_idle(128, 3, CS6); }
        if (IN(p0 + 9)) TEND(0);
        SEAM(p0 + 9);
        if (IN(p0 + 10)) phase_adaln(li, 2);
        SEAM(p0 + 10);
        TBEG();
        if (IN(p0 + 11)) { ph_gemm_swiglu(li, 1); __syncthreads(); if (li == 0) ph_convert_idle(36 * 44, 6, CS7); else ph_convert_idle(32 * 44, 6, CO_W3END); }
        if (IN(p0 + 11)) TEND(0);
        SEAM(p0 + 11);
        TBEG();
        if (IN(p0 + 12)) { ph_gemm_resid(li, 2); ph_gemm_resid_ctx(li, 2); __syncthreads(); if (li == 0) ph_convert_idle(128, 3, CS8); }
        if (IN(p0 + 12)) TEND(0);
        SEAM(p0 + 12);
    }
#if TPROBE
    if (tprobe) { float* tp = (float*)(args.ws + WS_CTL) + 2048; tp[0] = (float)TACC[0] * 1e-8f; tp[1] = (float)TACC[1] * 1e-8f; __builtin_amdgcn_fence(__ATOMIC_RELEASE, "agent"); }
    __syncthreads(); xcd_barrier(bar);
#endif
    if (IN(PH_FINAL)) phase_final();
#undef IN
#undef SEAM
}

extern "C" void kernel_launch(void* const* d_in, const int* in_sizes, int n_in, void* d_out, int out_size, void* d_ws, size_t ws_size, hipStream_t stream) {
    static int grid = 0;
    if (grid == 0) {
        if (n_in != 28 || ws_size < WS_END) { fprintf(stderr, "kernel_launch: unexpected n_in %d or ws_size %zu (< %zu)\n", n_in, ws_size, (size_t)WS_END); grid = -1; return; }
        int dev = 0, cus = 0, per_cu = 0;
        if (hipGetDevice(&dev) != hipSuccess || hipDeviceGetAttribute(&cus, hipDeviceAttributeMultiprocessorCount, dev) != hipSuccess) { grid = -1; return; }
        if (hipFuncSetAttribute((const void*)mega_fwd, hipFuncAttributeMaxDynamicSharedMemorySize, LDS_BYTES) != hipSuccess) { fprintf(stderr, "kernel_launch: hipFuncSetAttribute failed\n"); grid = -1; return; }
        if (hipOccupancyMaxActiveBlocksPerMultiprocessor(&per_cu, (const void*)mega_fwd, 512, LDS_BYTES) != hipSuccess || per_cu < 1) fprintf(stderr, "kernel_launch: occupancy query says %d\n", per_cu);
        (void)hipGetLastError();
        grid = cus;
    }
    if (grid < 0) return;
    (void)hipMemsetAsync((char*)d_ws + WS_CTL + 16384, 0, 16384, stream);
    Args a{};
    for (int i = 0; i < 28; ++i) a.in[i] = (const float*)d_in[i];
    a.out = (float*)d_out; a.ws = (unsigned char*)d_ws;
#if MK_ONE_LAUNCH
    a.ph_lo = 0; a.ph_hi = NPHASE;
    hipLaunchKernelGGL(mega_fwd, dim3(grid), dim3(512), LDS_BYTES, stream, a);
#else
    for (int p = 0; p < NPHASE; ++p) { a.ph_lo = p; a.ph_hi = p + 1; hipLaunchKernelGGL(mega_fwd, dim3(grid), dim3(512), LDS_BYTES, stream, a); }
#endif
}
```
